# Optimizing an MI355X kernel written in HIP

```python
import jax, jax.numpy as jnp
from jax import lax
import numpy as np

D_MODEL = 2048
BATCH = 4
SEQ = 2048
DEPTH = 2

N_HEADS = 16
HEAD_DIM = D_MODEL // N_HEADS
D_ATTN = N_HEADS * HEAD_DIM
D_FF = ((8 * D_MODEL // 3 + 255) // 256) * 256
N_EXPERTS = 8
TOP_K = 2
D_FF_EXPERT = 7 * D_MODEL // 2
Q_BLOCK = 128
RMS_EPS = 1e-6
N_A_LAYERS = DEPTH // 2
N_B_LAYERS = DEPTH - N_A_LAYERS
N_DENSE = (DEPTH + 1) // 2
N_MOE = DEPTH // 2

kernel_name = "yoco_stickbreak_fox_moe_hybrid"


def rms_norm(x, g):
    xf = x.astype(jnp.float32)
    y = xf * lax.rsqrt(jnp.mean(xf * xf, axis=-1, keepdims=True) + RMS_EPS)
    return (y * g.astype(jnp.float32)).astype(x.dtype)


def split_heads(t):
    b, s, _ = t.shape
    return t.reshape(b, s, N_HEADS, HEAD_DIM).transpose(0, 2, 1, 3)


def merge_heads(t):
    b, h, s, d = t.shape
    return t.transpose(0, 2, 1, 3).reshape(b, s, h * d)


def stick_breaking_attention(q, k, v):
    seq = q.shape[2]
    scale = HEAD_DIM ** -0.5
    outs = []
    for i in range(seq // Q_BLOCK):
        q0, end = i * Q_BLOCK, (i + 1) * Q_BLOCK
        qb = q[:, :, q0:end]
        kb = k[:, :, :end]
        vb = v[:, :, :end]
        z = jnp.einsum('bhqd,bhkd->bhqk', qb, kb).astype(jnp.float32) * scale
        qpos = q0 + jnp.arange(Q_BLOCK)
        kpos = jnp.arange(end)
        mask = kpos[None, :] < qpos[:, None]
        log_1m = jnp.where(mask, jax.nn.log_sigmoid(-z), 0.0)
        suffix = lax.cumsum(log_1m, axis=3, reverse=True) - log_1m
        w = jnp.where(mask, jnp.exp(jax.nn.log_sigmoid(z) + suffix), 0.0)
        outs.append(jnp.einsum('bhqk,bhkd->bhqd', w.astype(vb.dtype), vb))
    return jnp.concatenate(outs, axis=2)


def forgetting_attention(q, k, v, cum_log_f):
    seq = q.shape[2]
    scale = HEAD_DIM ** -0.5
    outs = []
    for i in range(seq // Q_BLOCK):
        q0, end = i * Q_BLOCK, (i + 1) * Q_BLOCK
        qb = q[:, :, q0:end]
        kb = k[:, :, :end]
        vb = v[:, :, :end]
        z = jnp.einsum('bhqd,bhkd->bhqk', qb, kb).astype(jnp.float32) * scale
        z = z + cum_log_f[:, :, q0:end, None] - cum_log_f[:, :, None, :end]
        qpos = q0 + jnp.arange(Q_BLOCK)
        kpos = jnp.arange(end)
        mask = kpos[None, :] <= qpos[:, None]
        p = jax.nn.softmax(jnp.where(mask, z, -jnp.inf), axis=-1)
        outs.append(jnp.einsum('bhqk,bhkd->bhqd', p.astype(vb.dtype), vb))
    return jnp.concatenate(outs, axis=2)


def swiglu(x, w_gu, w_down):
    gu = x @ w_gu
    g, u = jnp.split(gu, 2, axis=-1)
    return (jax.nn.silu(g) * u) @ w_down


def moe_swiglu(x, w_router, w_gu, w_down):
    b, s, d = x.shape
    xt = x.reshape(b * s, d)
    logits = (xt @ w_router).astype(jnp.float32)
    top_vals, top_idx = lax.top_k(logits, TOP_K)
    top_w = jax.nn.softmax(top_vals, axis=-1)
    gates = jnp.sum(jax.nn.one_hot(top_idx, N_EXPERTS, dtype=jnp.float32)
                    * top_w[..., None], axis=1)
    y = jnp.zeros((b * s, d), jnp.float32)
    for e in range(N_EXPERTS):
        y = y + gates[:, e:e + 1] * swiglu(xt, w_gu[e], w_down[e]).astype(jnp.float32)
    return y.astype(x.dtype).reshape(b, s, d)


def setup_inputs(seed: int = 0) -> dict:
    key = jax.random.key(seed)
    ks = jax.random.split(key, 16)
    f32 = jnp.float32

    def nrm(k, shape, fan_in):
        return jax.random.normal(k, shape, f32) * (fan_in ** -0.5)

    def gain(k, shape):
        return 1.0 + 0.02 * jax.random.normal(k, shape, f32)

    return {
        "x": jax.random.normal(ks[0], (BATCH, SEQ, D_MODEL), f32),
        "norm_mix": gain(ks[1], (DEPTH, D_MODEL)),
        "norm_ffn": gain(ks[2], (DEPTH, D_MODEL)),
        "w_qkv_a": nrm(ks[3], (N_A_LAYERS, D_MODEL, 3 * D_ATTN), D_MODEL),
        "w_o_a": nrm(ks[4], (N_A_LAYERS, D_ATTN, D_MODEL), D_ATTN),
        "norm_kv": gain(ks[5], (D_MODEL,)),
        "w_kvf_b": nrm(ks[6], (D_MODEL, 2 * D_ATTN + N_HEADS), D_MODEL),
        "b_f": jax.random.uniform(ks[7], (N_HEADS,), f32, 1.0, 4.0),
        "w_q_b": nrm(ks[8], (N_B_LAYERS, D_MODEL, D_ATTN), D_MODEL),
        "w_o_b": nrm(ks[9], (N_B_LAYERS, D_ATTN, D_MODEL), D_ATTN),
        "w_gu_dense": nrm(ks[10], (N_DENSE, D_MODEL, 2 * D_FF), D_MODEL),
        "w_down_dense": nrm(ks[11], (N_DENSE, D_FF, D_MODEL), D_FF),
        "w_router": nrm(ks[12], (N_MOE, D_MODEL, N_EXPERTS), D_MODEL),
        "w_gu_exp": nrm(ks[13], (N_MOE, N_EXPERTS, D_MODEL, 2 * D_FF_EXPERT), D_MODEL),
        "w_down_exp": nrm(ks[14], (N_MOE, N_EXPERTS, D_FF_EXPERT, D_MODEL), D_FF_EXPERT),
        "norm_final": gain(ks[15], (D_MODEL,)),
    }


def reference(x, norm_mix, norm_ffn, w_qkv_a, w_o_a, norm_kv, w_kvf_b, b_f, w_q_b, w_o_b,
              w_gu_dense, w_down_dense, w_router, w_gu_exp, w_down_exp, norm_final):
    h = x
    k_s = v_s = cum_log_f = None
    for layer in range(DEPTH):
        hn = rms_norm(h, norm_mix[layer])
        if layer < N_A_LAYERS:
            q, k, v = jnp.split(hn @ w_qkv_a[layer], 3, axis=-1)
            o = stick_breaking_attention(split_heads(q), split_heads(k), split_heads(v))
            h = h + merge_heads(o) @ w_o_a[layer]
        else:
            if layer == N_A_LAYERS:
                kvf = rms_norm(h, norm_kv) @ w_kvf_b
                k_s = split_heads(kvf[..., :D_ATTN])
                v_s = split_heads(kvf[..., D_ATTN:2 * D_ATTN])
                f_logit = kvf[..., 2 * D_ATTN:].astype(jnp.float32) + b_f.astype(jnp.float32)
                log_f = jax.nn.log_sigmoid(f_logit)
                cum_log_f = jnp.cumsum(log_f, axis=1).transpose(0, 2, 1)
            j = layer - N_A_LAYERS
            q = split_heads(hn @ w_q_b[j])
            o = forgetting_attention(q, k_s, v_s, cum_log_f)
            h = h + merge_heads(o) @ w_o_b[j]
        hn = rms_norm(h, norm_ffn[layer])
        if layer % 2 == 0:
            h = h + swiglu(hn, w_gu_dense[layer // 2], w_down_dense[layer // 2])
        else:
            i = layer // 2
            h = h + moe_swiglu(hn, w_router[i], w_gu_exp[i], w_down_exp[i])
    return rms_norm(h, norm_final)
```

```cpp
#include <hip/hip_runtime.h>
#include <cstdio>
#include <cstdint>
namespace pg8 {
#define PG8_LAS __attribute__((address_space(3)))
typedef unsigned short bf16_t;
typedef short bf16x8 __attribute__((ext_vector_type(8)));
typedef float f32x4 __attribute__((ext_vector_type(4)));
typedef float f32x2 __attribute__((ext_vector_type(2)));
typedef unsigned u32x4 __attribute__((ext_vector_type(4)));
typedef short s16x4 __attribute__((ext_vector_type(4)));
typedef unsigned u32x2 __attribute__((ext_vector_type(2)));
constexpr int BM = 256, BK = 64, HALF = 128, HTB = HALF * BK * 2  , STAGE_BYTES = 8 * HTB, NXCD = 8, WGM = 8;

__host__ __device__ __forceinline__ int lds_byte(int r, int c) { const int st = (r >> 4) * 2 + (c >> 5), rr = r & 15, cc = c & 31, ob = rr * 64 + cc * 2; return st * 1024 + (ob ^ (((ob >> 9) & 1) << 5)); }
__host__ __device__ __forceinline__ void stage_rc(int b, int& R, int& C) { const int st = b / 1024, sb = b % 1024, swz = sb ^ (((sb >> 9) & 1) << 5); R = (st >> 1) * 16 + swz / 64; C = (st & 1) * 32 + (swz % 64) / 2; }
__host__ __device__ __forceinline__ int perm32(int rho) { const int n = rho >> 4, i = rho & 15; return 8 * (i >> 2) + 4 * n + (i & 3); }

struct Unit { int pm, pn, crow; size_t bofs, aofs; };
struct Gemm { const bf16_t* A; const bf16_t* Bm; int K, Np, Kloop; };

struct StaticOrder {
    int nM, nN, nwg, G, c;
    __device__ void init(int M, int N, int G_, int c_) { nM = M / BM; nN = N / BM; nwg = nM * nN; G = G_; c = c_; }
    __device__ __forceinline__ bool next(int i, Unit& u) const {
        const long L = (long)i * G + c; if (L >= nwg) return false;
        int wgid = (int)L; { const int q = nwg / NXCD, r = nwg % NXCD, xcd = wgid % NXCD, off = wgid / NXCD; wgid = (xcd < r ? xcd * (q + 1) : r * (q + 1) + (xcd - r) * q) + off; }
        const int nig = WGM * nN, gid = wgid / nig, fm = gid * WGM, gsz = (nM - fm) < WGM ? (nM - fm) : WGM;
        u.pm = fm + ((wgid % nig) % gsz); u.pn = (wgid % nig) / gsz; u.bofs = (size_t)u.pn * 512; u.crow = u.pm; u.aofs = 0; return true;
    }
};
struct MoeOrder {
    int nM, nN, nwg, G, c; const int* tileExp; size_t estride;
    __device__ void init(int nM_, int nN_, int G_, int c_, const int* te, int K_) { nM = nM_; nN = nN_; nwg = nM * nN; G = G_; c = c_; tileExp = te; estride = (size_t)K_ * nN_ * 512; }
    __device__ __forceinline__ bool next(int i, Unit& u) const {
        const long L = (long)i * G + c; if (L >= nwg) return false;
        int wgid = (int)L; { const int q = nwg / NXCD, r = nwg % NXCD, xcd = wgid % NXCD, off = wgid / NXCD; wgid = (xcd < r ? xcd * (q + 1) : r * (q + 1) + (xcd - r) * q) + off; }
        const int nig = WGM * nN, gid = wgid / nig, fm = gid * WGM, gsz = (nM - fm) < WGM ? (nM - fm) : WGM;
        u.pm = fm + ((wgid % nig) % gsz); u.pn = (wgid % nig) / gsz;
        const int e = __builtin_amdgcn_readfirstlane(tileExp[u.pm]); u.bofs = (size_t)e * estride + (size_t)u.pn * 512; u.crow = u.pm; u.aofs = 0; return true;
    }
};

struct MoeTailOrder {
    int tail0, nN, nwg, G, c; const int* tileExp; size_t estride; int Np;
    __device__ void init(int tail0_, int ntail, int nN_, int G_, int c_, const int* te, int K_, int Np_) { tail0 = tail0_; nN = nN_; nwg = ntail * nN_ * 8; G = G_; c = c_; tileExp = te; estride = (size_t)K_ * nN_ * 512; Np = Np_; }
    __device__ __forceinline__ bool next(int i, Unit& u) const {
        const long L = (long)i * G + c; if (L >= nwg) return false;
        const int kq = (int)L & 7, r = (int)L >> 3, pn = r % nN, tl = r / nN;
        u.pm = tail0 + tl; u.pn = pn; u.crow = kq * 8 + tl; u.aofs = (size_t)kq * 896 * 2;
        const int e = __builtin_amdgcn_readfirstlane(tileExp[u.pm]); u.bofs = (size_t)e * estride + (size_t)pn * 512 + (size_t)kq * 896 * Np * 2; return true;
    }
};

__device__ __forceinline__ unsigned cvt_pk_bf16(float lo, float hi) { unsigned r; asm volatile("v_cvt_pk_bf16_f32 %0, %1, %2" : "=v"(r) : "v"(lo), "v"(hi)); return r; }

struct EpiBf16Split {
    static constexpr bool PERM = true, ROWSCALE = true;
    bf16_t* O; int ldc; int split_cols; size_t split_stride; float scale; int scale_t; float gscale;
    const float* ssq; const PG8_LAS float* tab; float* rstd_out;
    __device__ __forceinline__ void operator()(const f32x4 (&acc)[2][2][4][2], const Unit& u, int wr, int wc, int fr, int fq) const {
        const int row0 = u.crow * BM + wr * 64 + fr; int colt = u.pn * BM; bf16_t* base = O;
        float sc = gscale; { const int t = colt / split_cols; base += (size_t)t * split_stride; colt -= t * split_cols; if (t == scale_t) sc *= scale; }
        const int col0 = colt + wc * 32 + 8 * fq;
#pragma unroll
        for (int ai = 0; ai < 2; ++ai)
#pragma unroll
            for (int m = 0; m < 4; ++m) { bf16_t* rowp = base + (size_t)(row0 + ai * HALF + m * 16) * ldc + col0;
#pragma unroll
                for (int bj = 0; bj < 2; ++bj) { const float sr = ssq ? sc * tab[ai * HALF + wr * 64 + m * 16 + fr] : sc; f32x4 v0 = acc[ai][bj][m][0] * sr, v1 = acc[ai][bj][m][1] * sr;
                    u32x4 w; w.x = cvt_pk_bf16(v0[0], v0[1]); w.y = cvt_pk_bf16(v0[2], v0[3]); w.z = cvt_pk_bf16(v1[0], v1[1]); w.w = cvt_pk_bf16(v1[2], v1[3]);
                    *(u32x4*)(rowp + bj * HALF) = w; } }
    }
};
struct EpiResBf16 {
    static constexpr bool PERM = true, ROWSCALE = false;
    bf16_t* O; int ldc; const float* basef; const bf16_t* baseh; float* ssq;
    __device__ __forceinline__ void operator()(const f32x4 (&acc)[2][2][4][2], const Unit& u, int wr, int wc, int fr, int fq) const {
        const int row0 = u.crow * BM + wr * 64 + fr, col0 = u.pn * BM + wc * 32 + 8 * fq;
#pragma unroll
        for (int ai = 0; ai < 2; ++ai)
#pragma unroll
            for (int m = 0; m < 4; ++m) { const size_t off = (size_t)(row0 + ai * HALF + m * 16) * ldc + col0; float sq = 0.f;
#pragma unroll
                for (int bj = 0; bj < 2; ++bj) { f32x4 v0 = acc[ai][bj][m][0], v1 = acc[ai][bj][m][1];
                    if (basef) { v0 += *(const f32x4*)(basef + off + bj * HALF); v1 += *(const f32x4*)(basef + off + bj * HALF + 4); }
                    else { const u32x4 b = *(const u32x4*)(baseh + off + bj * HALF);
                        v0 += (f32x4){__uint_as_float(b.x << 16), __uint_as_float(b.x & 0xffff0000u), __uint_as_float(b.y << 16), __uint_as_float(b.y & 0xffff0000u)};
                        v1 += (f32x4){__uint_as_float(b.z << 16), __uint_as_float(b.z & 0xffff0000u), __uint_as_float(b.w << 16), __uint_as_float(b.w & 0xffff0000u)}; }
                    u32x4 w; w.x = cvt_pk_bf16(v0[0], v0[1]); w.y = cvt_pk_bf16(v0[2], v0[3]); w.z = cvt_pk_bf16(v1[0], v1[1]); w.w = cvt_pk_bf16(v1[2], v1[3]);
                    *(u32x4*)(O + off + bj * HALF) = w;
                    if (ssq) {
                        const f32x4 r0 = {__uint_as_float(w.x << 16), __uint_as_float(w.x & 0xffff0000u), __uint_as_float(w.y << 16), __uint_as_float(w.y & 0xffff0000u)};
                        const f32x4 r1 = {__uint_as_float(w.z << 16), __uint_as_float(w.z & 0xffff0000u), __uint_as_float(w.w << 16), __uint_as_float(w.w & 0xffff0000u)};
                        sq += ((r0[0] * r0[0] + r0[1] * r0[1]) + (r0[2] * r0[2] + r0[3] * r0[3])) + ((r1[0] * r1[0] + r1[1] * r1[1]) + (r1[2] * r1[2] + r1[3] * r1[3])); } }
                if (ssq) { sq += __shfl_xor(sq, 16); sq += __shfl_xor(sq, 32); if (fq == 0) ssq[(size_t)(row0 + ai * HALF + m * 16) * 32 + 4 * u.pn + wc] = sq; } }
    }
};
struct EpiF32 {
    static constexpr bool PERM = false, ROWSCALE = false;
    float* C; int ldc; const float* base;
    __device__ __forceinline__ void operator()(const f32x4 (&acc)[2][2][4][2], const Unit& u, int wr, int wc, int fr, int fq) const {
        const int row0 = u.crow * BM + wr * 64 + fr, col0 = u.pn * BM + wc * 32 + 4 * fq;
#pragma unroll
        for (int ai = 0; ai < 2; ++ai)
#pragma unroll
            for (int m = 0; m < 4; ++m) { const size_t off = (size_t)(row0 + ai * HALF + m * 16) * ldc + col0;
#pragma unroll
                for (int bj = 0; bj < 2; ++bj)
#pragma unroll
                    for (int n = 0; n < 2; ++n) { f32x4 v = acc[ai][bj][m][n]; if (base) v += *(const f32x4*)(base + off + bj * HALF + n * 16); *(f32x4*)(C + off + bj * HALF + n * 16) = v; } }
    }
};
struct EpiSwiGLU {
    static constexpr bool PERM = true, ROWSCALE = true;
    bf16_t* O; int ldc; const float* ssq; const PG8_LAS float* tab; float* rstd_out;
    __device__ __forceinline__ static float act(float g, float u) { return g * __builtin_amdgcn_rcpf(1.0f + __builtin_amdgcn_exp2f(g * -1.4426950408889634f)) * u; }
    __device__ __forceinline__ void operator()(const f32x4 (&acc)[2][2][4][2], const Unit& u, int wr, int wc, int fr, int fq) const {
        const int row0 = u.crow * BM + wr * 64 + fr, col0 = u.pn * HALF + wc * 32 + 8 * fq;
#pragma unroll
        for (int ai = 0; ai < 2; ++ai)
#pragma unroll
            for (int m = 0; m < 4; ++m) { bf16_t* rowp = O + (size_t)(row0 + ai * HALF + m * 16) * ldc + col0;
                const float sr = ssq ? tab[ai * HALF + wr * 64 + m * 16 + fr] : 1.0f;
                const f32x4 g0 = acc[ai][0][m][0] * sr, g1 = acc[ai][0][m][1] * sr, u0 = acc[ai][1][m][0] * sr, u1 = acc[ai][1][m][1] * sr;
                u32x4 w; w.x = cvt_pk_bf16(act(g0[0], u0[0]), act(g0[1], u0[1])); w.y = cvt_pk_bf16(act(g0[2], u0[2]), act(g0[3], u0[3]));
                w.z = cvt_pk_bf16(act(g1[0], u1[0]), act(g1[1], u1[1])); w.w = cvt_pk_bf16(act(g1[2], u1[2]), act(g1[3], u1[3]));
                *(u32x4*)rowp = w; }
    }
};
template <class Epi> __device__ __forceinline__ void rowscale_prepare(const Epi& E, const Unit& u, int tid) {
    if (E.ssq) { const int row = tid >> 1, half = tid & 1; const f32x4* p = (const f32x4*)(E.ssq + ((size_t)u.pm * BM + row) * 32 + 16 * half);
        const f32x4 a = p[0], b = p[1], c = p[2], d = p[3]; float s = ((a[0] + a[1]) + (a[2] + a[3])) + ((b[0] + b[1]) + (b[2] + b[3])) + ((c[0] + c[1]) + (c[2] + c[3])) + ((d[0] + d[1]) + (d[2] + d[3]));
        s += __shfl_xor(s, 1); const float r = 1.0f / sqrtf(s * (1.0f / 2048.0f) + 1e-6f);
        if (half == 0) { ((PG8_LAS float*)E.tab)[row] = r; if (E.rstd_out && u.pn == 0) E.rstd_out[(size_t)u.pm * BM + row] = r; } }
}

struct NoBg { static constexpr bool ON = false; };
template <class Epi, class Sched, class BG = NoBg, bool ALIGN_EPI = true>
__device__ __forceinline__ void gemm_phase(PG8_LAS unsigned char* lds, const Gemm g, const Sched& S, const Epi& E, BG& bg) {
    constexpr bool HB = BG::ON;
    const int tid = threadIdx.x, wid = __builtin_amdgcn_readfirstlane(tid >> 6), lane = tid & 63, wr = wid >> 2, wc = wid & 3, fr = lane & 15, fq = lane >> 4;
    const int K = g.K, nt = g.Kloop / BK;
    unsigned voffA[2], voffB[2];
#pragma unroll
    for (int i = 0; i < 2; ++i) { int R, C; stage_rc(tid * 16 + i * 8192, R, C); voffA[i] = (unsigned)(R * K + C) * 2u;
        const int kk = 4 * wid + 32 * i + (lane >> 4), ch = (lane & 15) ^ (((kk & 3) << 2) | ((kk >> 2) & 3)); voffB[i] = (unsigned)(kk * g.Np + 8 * ch) * 2u; }
    const size_t kstep = (size_t)(BK * 2);
    const size_t hstep = (size_t)HALF * K * 2;
    const size_t tstep = 2 * hstep;
    const size_t kstepB = (size_t)BK * g.Np * 2, hstepB = 256;
    const unsigned ldsw = (unsigned)wid * 1024u;
    const int aoff = lds_byte(wr * 64 + fr, fq * 8);
    int bo[2][2];
    { const int q = fr >> 2, p = fr & 3;
#pragma unroll
      for (int n = 0; n < 2; ++n)
#pragma unroll
        for (int t = 0; t < 2; ++t) bo[n][t] = (int)(unsigned)(size_t)lds + 4 * HTB + 256 * (8 * fq + 4 * t + q) + 16 * (((wc ^ q) << 2) | ((n ^ (fq & 1)) << 1) | ((p >> 1) ^ t)) + 8 * (p & 1); }
#define PG8_SA(b, h) (((b) * 2 + (h)) * HTB)
#define PG8_SB(b, h) ((4 + (b) * 2 + (h)) * HTB)
#define PG8_STAGE(bufoff, gbase, voff) do { _Pragma("unroll") for (int _i = 0; _i < 2; ++_i) \
        __builtin_amdgcn_global_load_lds((const unsigned*)((const char*)(gbase) + (voff)[_i]), (PG8_LAS unsigned*)(lds + (bufoff) + ldsw + _i * 8192), 16, 0, 0); } while (0)
#define PG8_LDA(dst, b, h) do { _Pragma("unroll") for (int m = 0; m < 4; ++m) _Pragma("unroll") for (int k = 0; k < 2; ++k) dst[m][k] = *(const PG8_LAS bf16x8*)(lds + PG8_SA(b, h) + aoff + m * 2048 + k * 1024); } while (0)
#define PG8_TR(dst, addr, off) asm volatile("ds_read_b64_tr_b16 %0, %1 offset:%2" : "=&v"(dst) : "v"(addr), "i"(off) : "memory")
#define PG8_LDB(dst, b, h) do { _Pragma("unroll") for (int n = 0; n < 2; ++n) _Pragma("unroll") for (int k = 0; k < 2; ++k) { s16x4 t0_, t1_; \
        PG8_TR(t0_, bo[n][0], ((b) * 2 + (h)) * HTB + k * 8192); PG8_TR(t1_, bo[n][1], ((b) * 2 + (h)) * HTB + k * 8192); \
        dst[n][k] = (bf16x8){t0_[0], t0_[1], t0_[2], t0_[3], t1_[0], t1_[1], t1_[2], t1_[3]}; } } while (0)
#define PG8_MMA(ai, bj, At, Bt) do { __builtin_amdgcn_s_setprio(1); _Pragma("unroll") for (int m = 0; m < 4; ++m) _Pragma("unroll") for (int n = 0; n < 2; ++n) _Pragma("unroll") for (int k = 0; k < 2; ++k) \
        acc[ai][bj][m][n] = __builtin_amdgcn_mfma_f32_16x16x32_bf16(Bt[n][k], At[m][k], acc[ai][bj][m][n], 0, 0, 0); __builtin_amdgcn_s_setprio(0); } while (0)
#define PG8_WAIT_V(n) asm volatile("s_waitcnt vmcnt(" #n ")" ::: "memory")
#define PG8_WAIT_L(n) asm volatile("s_waitcnt lgkmcnt(" #n ")" ::: "memory")
#define PG8_BAR __builtin_amdgcn_s_barrier()
#define PG8_SCHED __builtin_amdgcn_sched_barrier(0)
    Unit cur, nxt; int ui = 0;
    if (!S.next(0, cur)) return;
    f32x4 acc[2][2][4][2];
#pragma unroll
    for (int a = 0; a < 2; ++a)
#pragma unroll
        for (int b = 0; b < 2; ++b)
#pragma unroll
            for (int m = 0; m < 4; ++m)
#pragma unroll
                for (int n = 0; n < 2; ++n) acc[a][b][m][n] = (f32x4){0.f, 0.f, 0.f, 0.f};
    bf16x8 At[4][2], B0[2][2], B1[2][2];
    const char* cA = (const char*)g.A + (size_t)cur.pm * tstep + cur.aofs; const char* cB = (const char*)g.Bm + cur.bofs;
    PG8_STAGE(PG8_SB(0, 0), cB, voffB); PG8_STAGE(PG8_SB(0, 1), cB + hstepB, voffB); PG8_STAGE(PG8_SA(0, 0), cA, voffA); PG8_STAGE(PG8_SA(0, 1), cA + hstep, voffA);
    if (wr == 1) PG8_BAR;
    PG8_WAIT_V(2); PG8_BAR;
    PG8_STAGE(PG8_SB(1, 0), cB + kstepB, voffB); PG8_STAGE(PG8_SA(1, 0), cA + kstep, voffA); PG8_STAGE(PG8_SB(1, 1), cB + hstepB + kstepB, voffB);
    PG8_WAIT_V(6); PG8_BAR;
    for (;;) {
        const bool has_next = S.next(ui + 1, nxt);
        const char* nA = has_next ? (const char*)g.A + (size_t)nxt.pm * tstep + nxt.aofs : cA; const char* nB = has_next ? (const char*)g.Bm + nxt.bofs : cB;
        for (int t = 0; t < nt; t += 2) {
            const bool last = (t == nt - 2);
            const char* a1 = cA + (size_t)(t + 1) * kstep;
            const char* a2 = last ? nA : cA + (size_t)(t + 2) * kstep; const char* b2 = last ? nB : cB + (size_t)(t + 2) * kstepB;
            const char* a3 = a2 + kstep; const char* b3 = b2 + kstepB;
            PG8_LDB(B0, 0, 0); PG8_LDB(B1, 0, 1); PG8_SCHED; PG8_LDA(At, 0, 0); PG8_STAGE(PG8_SA(1, 1), a1 + hstep, voffA);
            PG8_WAIT_V(8); PG8_WAIT_L(0); PG8_BAR; PG8_MMA(0, 0, At, B0); PG8_MMA(0, 1, At, B1); PG8_BAR; PG8_SCHED;
            PG8_LDA(At, 0, 1); PG8_STAGE(PG8_SB(0, 0), b2, voffB); PG8_STAGE(PG8_SB(0, 1), b2 + hstepB, voffB); PG8_STAGE(PG8_SA(0, 0), a2, voffA);
            PG8_WAIT_V(8); PG8_WAIT_L(0); PG8_BAR; PG8_MMA(1, 0, At, B0); PG8_MMA(1, 1, At, B1); PG8_BAR; PG8_SCHED;
            PG8_LDB(B0, 1, 0); PG8_LDB(B1, 1, 1); PG8_SCHED; PG8_LDA(At, 1, 0); PG8_STAGE(PG8_SA(0, 1), a2 + hstep, voffA);
            PG8_WAIT_V(8); PG8_WAIT_L(0); PG8_BAR; PG8_MMA(0, 0, At, B0); PG8_MMA(0, 1, At, B1); PG8_BAR; PG8_SCHED;
            PG8_LDA(At, 1, 1); PG8_STAGE(PG8_SB(1, 0), b3, voffB); PG8_STAGE(PG8_SB(1, 1), b3 + hstepB, voffB); PG8_STAGE(PG8_SA(1, 0), a3, voffA);
            PG8_WAIT_V(8); PG8_WAIT_L(0); PG8_BAR; PG8_MMA(1, 0, At, B0); PG8_MMA(1, 1, At, B1); PG8_BAR; PG8_SCHED;
        }
        if constexpr (ALIGN_EPI) { if (wr == 0) PG8_BAR; }
        if constexpr (Epi::ROWSCALE) { rowscale_prepare(E, cur, tid); asm volatile("s_waitcnt lgkmcnt(0)" ::: "memory"); PG8_BAR; asm volatile("" ::: "memory"); }
        if constexpr (HB) {
            typename BG::Burst bb; f32x4 xb[16];
            (void)bg.burst_begin(bb);
#pragma unroll
            for (int i = 0; i < 16; ++i) xb[i] = bg.burst_load(bb, i);
            asm volatile("" ::: "memory");
            E(acc, cur, wr, wc, fr, fq);
            asm volatile("" ::: "memory");
            const typename BG::gain16 gg = bg.burst_gains(bb);
#pragma unroll
            for (int i = 0; i < 16; ++i) bg.burst_store(bb, i, xb[i], gg[i]);
        } else
        E(acc, cur, wr, wc, fr, fq);
        if (!has_next) break;
#pragma unroll
        for (int a = 0; a < 2; ++a)
#pragma unroll
            for (int b = 0; b < 2; ++b)
#pragma unroll
                for (int m = 0; m < 4; ++m)
#pragma unroll
                    for (int n = 0; n < 2; ++n) acc[a][b][m][n] = (f32x4){0.f, 0.f, 0.f, 0.f};
        cur = nxt; cA = nA; cB = nB; ++ui;
        if constexpr (ALIGN_EPI) { if (wr == 1) PG8_BAR; }
    }
    PG8_WAIT_V(0);
    if constexpr (!ALIGN_EPI) { if (wr == 0) PG8_BAR; }
    PG8_BAR;
#undef PG8_SA
#undef PG8_SB
#undef PG8_STAGE
#undef PG8_LDA
#undef PG8_LDB
#undef PG8_TR
#undef PG8_MMA
#undef PG8_WAIT_V
#undef PG8_WAIT_L
#undef PG8_BAR
#undef PG8_SCHED
}
typedef int i32x8 __attribute__((ext_vector_type(8)));
struct StaticOrder8 : StaticOrder {
    size_t tstride;
    __device__ void init8(int M, int N, int G_, int c_, int Kbytes) { init(M, N, G_, c_); tstride = (size_t)256 * Kbytes; }
    __device__ __forceinline__ bool next(int i, Unit& u) const { if (!StaticOrder::next(i, u)) return false; u.bofs = (size_t)u.pn * tstride; return true; }
};
struct MoeOrder8 {
    int nM, nN, nwg, G, c; const int* tileExp; size_t estride, tstride;
    __device__ void init(int nM_, int nN_, int G_, int c_, const int* te, int Kbytes) { nM = nM_; nN = nN_; nwg = nM * nN; G = G_; c = c_; tileExp = te; tstride = (size_t)256 * Kbytes; estride = (size_t)nN_ * tstride; }
    __device__ __forceinline__ bool next(int i, Unit& u) const {
        const long L = (long)i * G + c; if (L >= nwg) return false;
        int wgid = (int)L; { const int q = nwg / NXCD, r = nwg % NXCD, xcd = wgid % NXCD, off = wgid / NXCD; wgid = (xcd < r ? xcd * (q + 1) : r * (q + 1) + (xcd - r) * q) + off; }
        const int nig = WGM * nN, gid = wgid / nig, fm = gid * WGM, gsz = (nM - fm) < WGM ? (nM - fm) : WGM;
        u.pm = fm + ((wgid % nig) % gsz); u.pn = (wgid % nig) / gsz; u.crow = u.pm; u.aofs = 0;
        const int e = __builtin_amdgcn_readfirstlane(tileExp[u.pm]); u.bofs = (size_t)e * estride + (size_t)u.pn * tstride; return true;
    }
};
struct MoeTailOrder8 {
    int tail0, nN, nwg, G, c; const int* tileExp; size_t estride, tstride;
    __device__ void init(int tail0_, int ntail, int nN_, int G_, int c_, const int* te, int Kbytes) { tail0 = tail0_; nN = nN_; nwg = ntail * nN_ * 7; G = G_; c = c_; tileExp = te; tstride = (size_t)256 * Kbytes; estride = (size_t)nN_ * tstride; }
    __device__ __forceinline__ bool next(int i, Unit& u) const {
        const long L = (long)i * G + c; if (L >= nwg) return false;
        const int kq = (int)L % 7, r = (int)L / 7, pn = r % nN, tl = r / nN;
        u.pm = tail0 + tl; u.pn = pn; u.crow = kq * 8 + tl; u.aofs = (size_t)kq * 1024;
        const int e = __builtin_amdgcn_readfirstlane(tileExp[u.pm]); u.bofs = (size_t)e * estride + (size_t)pn * tstride + (size_t)kq * 1024; return true;
    }
};
__device__ __forceinline__ unsigned pk4_fp8(float a, float b, float c, float d) {
    a = __builtin_amdgcn_fmed3f(a, -448.f, 448.f); b = __builtin_amdgcn_fmed3f(b, -448.f, 448.f); c = __builtin_amdgcn_fmed3f(c, -448.f, 448.f); d = __builtin_amdgcn_fmed3f(d, -448.f, 448.f);
    int w = __builtin_amdgcn_cvt_pk_fp8_f32(a, b, 0, false); w = __builtin_amdgcn_cvt_pk_fp8_f32(c, d, w, true); return (unsigned)w; }
struct EpiSwiGLU8 {
    static constexpr bool PERM = true;
    unsigned char* O; int ldc; float sin, sout;
    __device__ __forceinline__ float act(float g, float u) const { g *= sin; return g * __builtin_amdgcn_rcpf(1.0f + __builtin_amdgcn_exp2f(g * -1.4426950408889634f)) * (u * (sin * sout)); }
    __device__ __forceinline__ void operator()(const f32x4 (&acc)[2][2][4][2], const Unit& u, int wr, int wc, int fr, int fq) const {
        const int row0 = u.crow * BM + wr * 64 + fr, col0 = u.pn * HALF + wc * 32 + 8 * fq;
#pragma unroll
        for (int ai = 0; ai < 2; ++ai)
#pragma unroll
            for (int m = 0; m < 4; ++m) { unsigned char* rowp = O + (size_t)(row0 + ai * HALF + m * 16) * ldc + col0;
                const f32x4 g0 = acc[ai][0][m][0], g1 = acc[ai][0][m][1], u0 = acc[ai][1][m][0], u1 = acc[ai][1][m][1];
                u32x2 w; w.x = pk4_fp8(act(g0[0], u0[0]), act(g0[1], u0[1]), act(g0[2], u0[2]), act(g0[3], u0[3])); w.y = pk4_fp8(act(g1[0], u1[0]), act(g1[1], u1[1]), act(g1[2], u1[2]), act(g1[3], u1[3]));
                *(u32x2*)rowp = w; }
    }
};
struct EpiF32s {
    static constexpr bool PERM = false;
    float* C; int ldc; float scale;
    __device__ __forceinline__ void operator()(const f32x4 (&acc)[2][2][4][2], const Unit& u, int wr, int wc, int fr, int fq) const {
        const int row0 = u.crow * BM + wr * 64 + fr, col0 = u.pn * BM + wc * 32 + 4 * fq;
#pragma unroll
        for (int ai = 0; ai < 2; ++ai)
#pragma unroll
            for (int m = 0; m < 4; ++m) { const size_t off = (size_t)(row0 + ai * HALF + m * 16) * ldc + col0;
#pragma unroll
                for (int bj = 0; bj < 2; ++bj)
#pragma unroll
                    for (int n = 0; n < 2; ++n) *(f32x4*)(C + off + bj * HALF + n * 16) = acc[ai][bj][m][n] * scale; }
    }
};
template <class Epi, class Sched, bool ALIGN_EPI = true>
__device__ __forceinline__ void gemm_phase_f8(PG8_LAS unsigned char* lds, const Gemm g, const Sched& S, const Epi& E) {
    int tid = threadIdx.x; asm volatile("" : "+v"(tid));
    const int wid = __builtin_amdgcn_readfirstlane(tid >> 6), lane = tid & 63, wr = wid >> 2, wc = wid & 3, fr = lane & 15, fq = lane >> 4;
    const int K = g.K; int nt = g.Kloop / BK; asm volatile("" : "+s"(nt));
    unsigned voffA[2], voffB[2];
#pragma unroll
    for (int i = 0; i < 2; ++i) { int R, C; stage_rc(tid * 16 + i * 8192, R, C); const int Rb = Epi::PERM ? ((R & ~31) + perm32(R & 31)) : R;
        voffA[i] = (unsigned)(R * K + C) * 2u; voffB[i] = (unsigned)(Rb * K + C) * 2u; }
    const size_t kstep = (size_t)(BK * 2);
    const size_t hstep = (size_t)HALF * K * 2;
    const size_t tstep = 2 * hstep;
    const unsigned ldsb = (unsigned)(size_t)lds + (unsigned)wid * 1024u;
    const int aoff = lds_byte(wr * 64 + fr, (fq >> 1) * 32 + (fq & 1) * 16), boff = lds_byte(wc * 32 + fr, (fq >> 1) * 32 + (fq & 1) * 16);
#define PG8_SA(b, h) (((b) * 2 + (h)) * HTB)
#define PG8_SB(b, h) ((4 + (b) * 2 + (h)) * HTB)
#define PG8_GLDS(off32, base64, ldsaddr) do { unsigned keep_; asm volatile("s_mov_b32 %0, m0\n\ts_mov_b32 m0, %3\n\ts_nop 1\n\tglobal_load_lds_dwordx4 %1, %2\n\ts_mov_b32 m0, %0" \
        : "=&s"(keep_) : "v"(off32), "s"(base64), "s"(ldsaddr) : "memory"); } while (0)
#define PG8_STAGE(bufoff, gbase, voff) do { _Pragma("unroll") for (int _i = 0; _i < 2; ++_i) PG8_GLDS((voff)[_i], (const char*)(gbase), ldsb + (unsigned)((bufoff) + _i * 8192)); } while (0)
#define PG8_LDA(dst, b, h) do { _Pragma("unroll") for (int m = 0; m < 4; ++m) { const u32x4 lo_ = *(const PG8_LAS u32x4*)(lds + PG8_SA(b, h) + aoff + m * 2048), hi_ = *(const PG8_LAS u32x4*)(lds + PG8_SA(b, h) + aoff + m * 2048 + 16); \
        dst[m] = (i32x8){(int)lo_[0], (int)lo_[1], (int)lo_[2], (int)lo_[3], (int)hi_[0], (int)hi_[1], (int)hi_[2], (int)hi_[3]}; } } while (0)
#define PG8_LDB(dst, b, h) do { _Pragma("unroll") for (int n = 0; n < 2; ++n) { const u32x4 lo_ = *(const PG8_LAS u32x4*)(lds + PG8_SB(b, h) + boff + n * 2048), hi_ = *(const PG8_LAS u32x4*)(lds + PG8_SB(b, h) + boff + n * 2048 + 16); \
        dst[n] = (i32x8){(int)lo_[0], (int)lo_[1], (int)lo_[2], (int)lo_[3], (int)hi_[0], (int)hi_[1], (int)hi_[2], (int)hi_[3]}; } } while (0)
#define PG8_MMA(ai, bj, At, Bt) do { __builtin_amdgcn_s_setprio(1); _Pragma("unroll") for (int m = 0; m < 4; ++m) _Pragma("unroll") for (int n = 0; n < 2; ++n) \
        asm volatile("v_mfma_f32_16x16x128_f8f6f4 %0, %1, %2, %0" : "+v"(acc[ai][bj][m][n]) : "v"(Bt[n]), "v"(At[m])); __builtin_amdgcn_s_setprio(0); } while (0)
#define PG8_WAIT_V(n) asm volatile("s_waitcnt vmcnt(" #n ")" ::: "memory")
#define PG8_WAIT_L(n) asm volatile("s_waitcnt lgkmcnt(" #n ")" ::: "memory")
#define PG8_BAR __builtin_amdgcn_s_barrier()
#define PG8_SCHED __builtin_amdgcn_sched_barrier(0)
    Unit cur, nxt; int ui = 0;
    if (!S.next(0, cur)) return;
    f32x4 acc[2][2][4][2];
#pragma unroll
    for (int a = 0; a < 2; ++a)
#pragma unroll
        for (int b = 0; b < 2; ++b)
#pragma unroll
            for (int m = 0; m < 4; ++m)
#pragma unroll
                for (int n = 0; n < 2; ++n) acc[a][b][m][n] = (f32x4){0.f, 0.f, 0.f, 0.f};
    i32x8 At[4], B0[2], B1[2];
    const char* cA = (const char*)g.A + (size_t)cur.pm * tstep + cur.aofs; const char* cB = (const char*)g.Bm + cur.bofs;
    PG8_STAGE(PG8_SB(0, 0), cB, voffB); PG8_STAGE(PG8_SB(0, 1), cB + hstep, voffB); PG8_STAGE(PG8_SA(0, 0), cA, voffA); PG8_STAGE(PG8_SA(0, 1), cA + hstep, voffA);
    if (wr == 1) PG8_BAR;
    PG8_WAIT_V(2); PG8_BAR;
    PG8_STAGE(PG8_SB(1, 0), cB + kstep, voffB); PG8_STAGE(PG8_SA(1, 0), cA + kstep, voffA); PG8_STAGE(PG8_SB(1, 1), cB + hstep + kstep, voffB);
    PG8_WAIT_V(6); PG8_BAR;
    for (;;) {
        const bool has_next = S.next(ui + 1, nxt);
        const char* nA = has_next ? (const char*)g.A + (size_t)nxt.pm * tstep + nxt.aofs : cA; const char* nB = has_next ? (const char*)g.Bm + nxt.bofs : cB;
        for (int t = 0; t < nt; t += 2) {
            const bool last = (t == nt - 2);
            const char* a1 = cA + (size_t)(t + 1) * kstep;
            const char* a2 = last ? nA : cA + (size_t)(t + 2) * kstep; const char* b2 = last ? nB : cB + (size_t)(t + 2) * kstep;
            const char* a3 = a2 + kstep; const char* b3 = b2 + kstep;
            PG8_LDB(B0, 0, 0); PG8_LDB(B1, 0, 1); PG8_SCHED; PG8_LDA(At, 0, 0); PG8_STAGE(PG8_SA(1, 1), a1 + hstep, voffA);
            PG8_WAIT_V(8); PG8_WAIT_L(0); PG8_BAR; PG8_MMA(0, 0, At, B0); PG8_MMA(0, 1, At, B1); PG8_BAR; PG8_SCHED;
            PG8_LDA(At, 0, 1); PG8_STAGE(PG8_SB(0, 0), b2, voffB); PG8_STAGE(PG8_SB(0, 1), b2 + hstep, voffB); PG8_STAGE(PG8_SA(0, 0), a2, voffA);
            PG8_WAIT_V(8); PG8_WAIT_L(0); PG8_BAR; PG8_MMA(1, 0, At, B0); PG8_MMA(1, 1, At, B1); PG8_BAR; PG8_SCHED;
            PG8_LDB(B0, 1, 0); PG8_LDB(B1, 1, 1); PG8_SCHED; PG8_LDA(At, 1, 0); PG8_STAGE(PG8_SA(0, 1), a2 + hstep, voffA);
            PG8_WAIT_V(8); PG8_WAIT_L(0); PG8_BAR; PG8_MMA(0, 0, At, B0); PG8_MMA(0, 1, At, B1); PG8_BAR; PG8_SCHED;
            PG8_LDA(At, 1, 1); PG8_STAGE(PG8_SB(1, 0), b3, voffB); PG8_STAGE(PG8_SB(1, 1), b3 + hstep, voffB); PG8_STAGE(PG8_SA(1, 0), a3, voffA);
            PG8_WAIT_V(8); PG8_WAIT_L(0); PG8_BAR; PG8_MMA(1, 0, At, B0); PG8_MMA(1, 1, At, B1); PG8_BAR; PG8_SCHED;
        }
        asm volatile("s_nop 15\n\ts_nop 15" ::: "memory");
        if constexpr (ALIGN_EPI) { if (wr == 0) PG8_BAR; }
        E(acc, cur, wr, wc, fr, fq);
        if (!has_next) break;
#pragma unroll
        for (int a = 0; a < 2; ++a)
#pragma unroll
            for (int b = 0; b < 2; ++b)
#pragma unroll
                for (int m = 0; m < 4; ++m)
#pragma unroll
                    for (int n = 0; n < 2; ++n) acc[a][b][m][n] = (f32x4){0.f, 0.f, 0.f, 0.f};
        cur = nxt; cA = nA; cB = nB; ++ui;
        if constexpr (ALIGN_EPI) { if (wr == 1) PG8_BAR; }
    }
    PG8_WAIT_V(0);
    if constexpr (!ALIGN_EPI) { if (wr == 0) PG8_BAR; }
    PG8_BAR;
#undef PG8_SA
#undef PG8_SB
#undef PG8_STAGE
#undef PG8_GLDS
#undef PG8_LDA
#undef PG8_LDB
#undef PG8_MMA
#undef PG8_WAIT_V
#undef PG8_WAIT_L
#undef PG8_BAR
#undef PG8_SCHED
}
}
namespace att {
#define ATT_LAS __attribute__((address_space(3)))
typedef unsigned short bf16_t;
typedef short bf16x8 __attribute__((ext_vector_type(8)));
typedef short s16x4 __attribute__((ext_vector_type(4)));
typedef float f32x16 __attribute__((ext_vector_type(16)));
typedef float f32x4 __attribute__((ext_vector_type(4)));
typedef unsigned u32x4 __attribute__((ext_vector_type(4)));
constexpr int S = 2048, PITCH = 2048, D = 128, NW = 8, QBLK = 32, KVBLK = 64, QB = NW * QBLK;
constexpr int SHM_V = KVBLK * D * 2, SHM_K = KVBLK * D * 2;
constexpr int NKB = 4, NVB = 5;
constexpr int OFF_V = 0, OFF_K = NVB * SHM_V, OFF_WS = NVB * SHM_V + NKB * SHM_K, OFF_BIAS = OFF_WS + NW * 64 * 4, OFF_SCAN = OFF_BIAS + S * 4, LDS_BYTES = OFF_SCAN + 64;
#define KSWZ(row, colB) ((row) * 256 + ((colB) ^ (((row) & 7) << 4)))
#define SBAR() __builtin_amdgcn_sched_barrier(0)
__device__ __forceinline__ int v_st(int k, int c) { const int kk = (k & ~0xC) | ((k & 4) << 1) | ((k & 8) >> 1); return ((kk >> 3) * 4 + (c >> 5)) * 512 + ((kk & 7) * 32 + (c & 31)) * 2; }
__device__ __forceinline__ int v_rd_base(int lane) { return ((lane & 3) << 3) | (((lane >> 2) & 3) << 6) | (((lane >> 4) & 1) << 5) | (((lane >> 5) & 1) << 8); }
constexpr int v_rd_off(int d0, int ks, int half) { return d0 * 512 + ks * 4096 + half * 2048; }
__device__ __forceinline__ int crow(int r, int hi) { return (r & 3) + 8 * (r >> 2) + 4 * hi; }
__device__ __forceinline__ unsigned cvtpk(float lo, float hi) { unsigned r; asm volatile("v_cvt_pk_bf16_f32 %0, %1, %2" : "=v"(r) : "v"(lo), "v"(hi)); return r; }

__device__ __forceinline__ void qkt(f32x16& p0, f32x16& p1, const ATT_LAS char* Kt, int r32, int hi, const bf16x8* qr) {
    p0 = f32x16{}; p1 = f32x16{};
    const ATT_LAS char* kb[4];
#pragma unroll
    for (int dd = 0; dd < 4; ++dd) kb[dd] = Kt + KSWZ(r32, (dd * 16 + hi * 8) * 2);
#pragma unroll
    for (int d0 = 0; d0 < 8; ++d0) { const ATT_LAS char* a = kb[d0 & 3] + (d0 >> 2) * 128;
        bf16x8 b0 = *reinterpret_cast<const ATT_LAS bf16x8*>(a);
        bf16x8 b1 = *reinterpret_cast<const ATT_LAS bf16x8*>(a + 32 * 256);
        p0 = __builtin_amdgcn_mfma_f32_32x32x16_bf16(b0, qr[d0], p0, 0, 0, 0);
        p1 = __builtin_amdgcn_mfma_f32_32x32x16_bf16(b1, qr[d0], p1, 0, 0, 0); }
}
__device__ __forceinline__ void pv_tile(f32x16* o, int vb0, bf16x8 pa0, bf16x8 pa1, bf16x8 pa2, bf16x8 pa3) {
#define TRRD(dst, off) asm volatile("ds_read_b64_tr_b16 %0, %1 offset:%2" : "=&v"(dst) : "v"(vb0), "i"(off) : "memory")
#define PV_D0(d0) do { s16x4 l0, l1, l2, l3, h0, h1, h2, h3; constexpr int b_ = v_rd_off(d0, 0, 0); \
        TRRD(l0, b_); TRRD(h0, b_ + 2048); TRRD(l1, b_ + 4096); TRRD(h1, b_ + 6144); TRRD(l2, b_ + 8192); TRRD(h2, b_ + 10240); TRRD(l3, b_ + 12288); TRRD(h3, b_ + 14336); \
        asm volatile("s_waitcnt lgkmcnt(0)" ::: "memory"); SBAR(); \
        o[d0] = __builtin_amdgcn_mfma_f32_32x32x16_bf16(pa0, (bf16x8){l0[0], l0[1], l0[2], l0[3], h0[0], h0[1], h0[2], h0[3]}, o[d0], 0, 0, 0);   \
        o[d0] = __builtin_amdgcn_mfma_f32_32x32x16_bf16(pa1, (bf16x8){l1[0], l1[1], l1[2], l1[3], h1[0], h1[1], h1[2], h1[3]}, o[d0], 0, 0, 0);   \
        o[d0] = __builtin_amdgcn_mfma_f32_32x32x16_bf16(pa2, (bf16x8){l2[0], l2[1], l2[2], l2[3], h2[0], h2[1], h2[2], h2[3]}, o[d0], 0, 0, 0);   \
        o[d0] = __builtin_amdgcn_mfma_f32_32x32x16_bf16(pa3, (bf16x8){l3[0], l3[1], l3[2], l3[3], h3[0], h3[1], h3[2], h3[3]}, o[d0], 0, 0, 0); } while (0)
    PV_D0(0); PV_D0(1); PV_D0(2); PV_D0(3);
#undef PV_D0
#undef TRRD
}
#define ATT_PK4(P, B_, OUT) do { unsigned a0 = cvtpk(P[B_+0], P[B_+1]), a1 = cvtpk(P[B_+2], P[B_+3]);                          \
        unsigned b0 = cvtpk(P[B_+4], P[B_+5]), b1 = cvtpk(P[B_+6], P[B_+7]);                                             \
        auto r0 = __builtin_amdgcn_permlane32_swap(a0, b0, false, false); auto r1 = __builtin_amdgcn_permlane32_swap(a1, b1, false, false); \
        u32x4 w = {r0[0], r1[0], r0[1], r1[1]}; OUT = *reinterpret_cast<bf16x8*>(&w); } while (0)

constexpr int OFF_STAGE = OFF_SCAN + 64, STAGE_PER_WAVE = 0;
template <bool FOX, class BG, int NH = 1>
__device__ __forceinline__ void attn_block(ATT_LAS char* lds, const bf16_t* Qg, const bf16_t* Kg, const bf16_t* Vg, bf16_t* Og, int b, int h, int qb, BG& bg) {
    int tid = threadIdx.x; asm volatile("" : "+v"(tid));
    const int wid = __builtin_amdgcn_readfirstlane(tid >> 6), lane = tid & 63, r32 = lane & 31, hi = lane >> 5;
    const size_t hb = (size_t)b * S * PITCH + (size_t)h * D;
    const bf16_t* Qp = Qg + hb; const bf16_t* Kp = Kg + hb; const bf16_t* Vp = Vg + hb; bf16_t* Op = Og + hb;
    const int P0 = qb * QB, qlo = P0 + wid * QBLK, NT = 4 * (qb + 1);
    bf16x8 qr[8];
#pragma unroll
    for (int d0 = 0; d0 < 8; ++d0) qr[d0] = *(const bf16x8*)(Qp + (size_t)(qlo + r32) * PITCH + d0 * 16 + hi * 8);
    unsigned koff[2], voff[2];
#pragma unroll
    for (int i = 0; i < 2; ++i) { const int j = 2 * wid + i;
        { const int row = 4 * j + (lane >> 4), c = (lane & 15) ^ (row & 7); koff[i] = (unsigned)(row * PITCH + 8 * c) * 2u; }
        { const int sub = 2 * j + (lane >> 5), kk = 8 * (sub >> 2) + ((lane & 31) >> 2), c = 32 * (sub & 3) + 8 * (lane & 3), k = (kk & ~0xC) | ((kk & 4) << 1) | ((kk & 8) >> 1); voff[i] = (unsigned)(k * PITCH + c) * 2u; } }
    ATT_LAS char* V_lds = lds + OFF_V; ATT_LAS char* K_lds = lds + OFF_K;
    ATT_LAS float* wsf = (ATT_LAS float*)(lds + OFF_WS) + wid * 64; ATT_LAS float* li_l = wsf; ATT_LAS float* al_l = wsf + 32;
    const ATT_LAS float* biasL = (const ATT_LAS float*)(lds + OFF_BIAS);
    const int vbase = (int)(unsigned)(size_t)V_lds + v_rd_base(lane);
    float m_reg = -1e30f, l_reg = 0.f, R2 = 0.f; f32x16 o[4] = {};
    typename BG::Burst bbC, bbP; bg.burst_begin_n(bbC, 0); bbP = bbC; bool isC = false, isP = false; f32x4 hv[4] = {};
    typename BG::Burst bbD; bg.burst_begin_n(bbD, 0); bool isD = false; f32x4 hw[4] = {};
#define TILEJ(t) (FOX ? (t) : (NT - 1 - (t)))
#define LOADT(j, st) do { const char* kt_ = (const char*)(Kp + (size_t)(j) * KVBLK * PITCH); const char* vt_ = (const char*)(Vp + (size_t)(j) * KVBLK * PITCH); const int ks_ = (st) & 3, vs_ = (st) % NVB; \
        _Pragma("unroll") for (int i_ = 0; i_ < 2; ++i_) { \
            __builtin_amdgcn_global_load_lds((const unsigned*)(kt_ + koff[i_]), (ATT_LAS unsigned*)(K_lds + ks_ * SHM_K + (2 * wid + i_) * 1024), 16, 0, 0); \
            __builtin_amdgcn_global_load_lds((const unsigned*)(vt_ + voff[i_]), (ATT_LAS unsigned*)(V_lds + vs_ * SHM_V + (2 * wid + i_) * 1024), 16, 0, 0); } } while (0)
    static_assert(!BG::ON || BG::REG, "register-staged hosting only");
    const bool stag = wid >= 4; bool dpend = false; int dvs = 0; bf16x8 pa0 = {}, pa1 = {}, pa2 = {}, pa3 = {};
    LOADT(TILEJ(0), 0); LOADT(TILEJ(1), 1); asm volatile("s_waitcnt vmcnt(0)" ::: "memory"); __syncthreads();
    for (int t = 0; t < NT; ++t) {
        if ((t & 1) == 0 && t + 2 < NT) { LOADT(TILEJ(t + 2), t + 2); LOADT(TILEJ(t + 3), t + 3); }
        bbP = bbC; isP = isC; isC = bg.live;
        if (isC) { bg.burst_begin_n(bbC, 4);
            if constexpr (BG::REG) {
#pragma unroll
                for (int i = 0; i < 4; ++i) hv[i] = bg.burst_ld(bbC, i);
                if constexpr (NH == 2) { isD = bg.live; if (isD) { bg.burst_begin_n(bbD, 4);
#pragma unroll
                    for (int i = 0; i < 4; ++i) hw[i] = bg.burst_ld(bbD, i); } }
            } else {
#pragma unroll
            for (int i = 0; i < 4; ++i) bg.burst_dma(bbC, i, (ATT_LAS unsigned char*)(lds + OFF_STAGE + wid * STAGE_PER_WAVE + (t & 1) * 4096 + i * 1024)); } }
        if (dpend && (t & 1) == 0) { pv_tile(o, vbase + dvs * SHM_V, pa0, pa1, pa2, pa3); dpend = false; }
        const int bufi = t & 3, vsl = t % NVB, kb = TILEJ(t) * KVBLK;
        if (kb <= qlo + QBLK - 1) {
            f32x16 p0, p1;
            qkt(p0, p1, K_lds + bufi * SHM_K, r32, hi, qr);
            const int dq = qlo + r32 - kb - 4 * hi;
            if constexpr (FOX) {
                const ATT_LAS float* bp = biasL + kb + 4 * hi;
#pragma unroll
                for (int i = 0; i < 4; ++i) { const f32x4 b0 = *(const ATT_LAS f32x4*)(bp + 8 * i), b1 = *(const ATT_LAS f32x4*)(bp + 32 + 8 * i);
#pragma unroll
                    for (int j = 0; j < 4; ++j) { p0[4 * i + j] += b0[j]; p1[4 * i + j] += b1[j]; } }
                if (kb + KVBLK - 1 > qlo) {
                    const float NEG = -__builtin_inff();
#pragma unroll
                    for (int r = 0; r < 16; ++r) { const int c = (r & 3) + 8 * (r >> 2); if (c > dq) p0[r] = NEG; if (c + 32 > dq) p1[r] = NEG; }
                }
                float pmax = p0[0];
#pragma unroll
                for (int r = 1; r < 16; ++r) pmax = fmaxf(pmax, p0[r]);
#pragma unroll
                for (int r = 0; r < 16; ++r) pmax = fmaxf(pmax, p1[r]);
                { auto rr = __builtin_amdgcn_permlane32_swap(__float_as_uint(pmax), __float_as_uint(pmax), false, false); pmax = fmaxf(__uint_as_float(rr[0]), __uint_as_float(rr[1])); }
                const float mn = fmaxf(m_reg, pmax), alpha = __builtin_amdgcn_exp2f(m_reg - mn); m_reg = mn;
                float ps = 0.f;
#pragma unroll
                for (int r = 0; r < 16; ++r) { p0[r] = __builtin_amdgcn_exp2f(p0[r] - mn); p1[r] = __builtin_amdgcn_exp2f(p1[r] - mn); ps += p0[r] + p1[r]; }
                { auto rr = __builtin_amdgcn_permlane32_swap(__float_as_uint(ps), __float_as_uint(ps), false, false); ps = __uint_as_float(rr[0]) + __uint_as_float(rr[1]); }
                l_reg = l_reg * alpha + ps;
                if (__any(alpha < 1.f)) { if (hi == 0) al_l[r32] = alpha; asm volatile("s_waitcnt lgkmcnt(0)" ::: "memory");
#pragma unroll
                    for (int r = 0; r < 16; ++r) { const float a = al_l[crow(r, hi)];
#pragma unroll
                        for (int d_ = 0; d_ < 4; ++d_) o[d_][r] *= a; }
                    asm volatile("s_waitcnt lgkmcnt(0)" ::: "memory"); }
            } else {
                const bool MSK = (kb + KVBLK - 1 >= qlo);
                f32x16 l0, l1;
#pragma unroll
                for (int r = 0; r < 16; ++r) {
                    const float y0 = p0[r], y1 = p1[r];
                    float L0 = -(fmaxf(y0, 0.f) + __builtin_amdgcn_logf(1.0f + __builtin_amdgcn_exp2f(-__builtin_fabsf(y0))));
                    float L1 = -(fmaxf(y1, 0.f) + __builtin_amdgcn_logf(1.0f + __builtin_amdgcn_exp2f(-__builtin_fabsf(y1))));
                    if (MSK) { const int c = (r & 3) + 8 * (r >> 2); if (!(c < dq)) L0 = 0.f; if (!(c + 32 < dq)) L1 = 0.f; }
                    l0[r] = L0; l1[r] = L1;
                }
                float T[8], HO[8];
#pragma unroll
                for (int i = 0; i < 8; ++i) { const float g = (i < 4) ? ((l0[4 * i] + l0[4 * i + 1]) + (l0[4 * i + 2] + l0[4 * i + 3])) : ((l1[4 * i - 16] + l1[4 * i - 15]) + (l1[4 * i - 14] + l1[4 * i - 13]));
                    auto rr = __builtin_amdgcn_permlane32_swap(__float_as_uint(g), __float_as_uint(g), false, false);
                    const float glo = __uint_as_float(rr[0]), ghi = __uint_as_float(rr[1]); T[i] = glo + ghi; HO[i] = hi ? 0.f : ghi; }
                float run = R2;
#pragma unroll
                for (int i = 7; i >= 0; --i) {
                    const float off = run + HO[i];
                    if (i < 4) { float s3 = l0[4 * i + 3] + off, s2 = l0[4 * i + 2] + s3, s1 = l0[4 * i + 1] + s2, s0 = l0[4 * i] + s1;
                        p0[4 * i + 3] = __builtin_amdgcn_exp2f(p0[4 * i + 3] + s3); p0[4 * i + 2] = __builtin_amdgcn_exp2f(p0[4 * i + 2] + s2);
                        p0[4 * i + 1] = __builtin_amdgcn_exp2f(p0[4 * i + 1] + s1); p0[4 * i] = __builtin_amdgcn_exp2f(p0[4 * i] + s0); }
                    else { const int q = 4 * i - 16; float s3 = l1[q + 3] + off, s2 = l1[q + 2] + s3, s1 = l1[q + 1] + s2, s0 = l1[q] + s1;
                        p1[q + 3] = __builtin_amdgcn_exp2f(p1[q + 3] + s3); p1[q + 2] = __builtin_amdgcn_exp2f(p1[q + 2] + s2);
                        p1[q + 1] = __builtin_amdgcn_exp2f(p1[q + 1] + s1); p1[q] = __builtin_amdgcn_exp2f(p1[q] + s0); }
                    run += T[i];
                }
                R2 = run;
                if (MSK) {
#pragma unroll
                    for (int r = 0; r < 16; ++r) { const int c = (r & 3) + 8 * (r >> 2); if (!(c < dq)) p0[r] = 0.f; if (!(c + 32 < dq)) p1[r] = 0.f; }
                }
            }
            ATT_PK4(p0, 0, pa0); ATT_PK4(p0, 8, pa1); ATT_PK4(p1, 0, pa2); ATT_PK4(p1, 8, pa3);
            if (stag && (t & 1)) { dpend = true; dvs = vsl; } else pv_tile(o, vbase + vsl * SHM_V, pa0, pa1, pa2, pa3);
        }
        asm volatile("s_waitcnt vmcnt(0)" ::: "memory");
        if constexpr (BG::REG) { if (isC) { bg.burst_finish_regs(bbC, hv, (ATT_LAS unsigned char*)(lds + OFF_STAGE + wid * STAGE_PER_WAVE)); if constexpr (NH == 2) { if (isD) bg.burst_finish_regs(bbD, hw, (ATT_LAS unsigned char*)(lds + OFF_STAGE + wid * STAGE_PER_WAVE + 4096)); isD = false; } } }
        else
        if (t > 0 && isP) { if (isC) asm volatile("s_waitcnt vmcnt(%0)" :: "n"(BG::HOST_VMCNT) : "memory"); else asm volatile("s_waitcnt vmcnt(0)" ::: "memory");
            bg.burst_finish4(bbP, (ATT_LAS unsigned char*)(lds + OFF_STAGE + wid * STAGE_PER_WAVE + ((t - 1) & 1) * 4096)); }
        if (t & 1) { asm volatile("s_waitcnt lgkmcnt(0)" ::: "memory"); __builtin_amdgcn_s_barrier(); asm volatile("" ::: "memory"); }
    }
    if (dpend) { pv_tile(o, vbase + dvs * SHM_V, pa0, pa1, pa2, pa3); dpend = false; }
    if constexpr (!BG::REG) if (isC) { asm volatile("s_waitcnt vmcnt(0)" ::: "memory"); bg.burst_finish4(bbC, (ATT_LAS unsigned char*)(lds + OFF_STAGE + wid * STAGE_PER_WAVE + ((NT - 1) & 1) * 4096)); }
    if (0) {
    }
    float rli[16];
    if constexpr (FOX) {
        if (hi == 0) li_l[r32] = l_reg; asm volatile("s_waitcnt lgkmcnt(0)" ::: "memory");
#pragma unroll
        for (int r = 0; r < 16; ++r) rli[r] = __builtin_amdgcn_rcpf(li_l[crow(r, hi)]);
        asm volatile("s_waitcnt lgkmcnt(0)" ::: "memory");
    } else {
#pragma unroll
        for (int r = 0; r < 16; ++r) rli[r] = 1.f;
    }
    bf16_t* Ow = Op + (size_t)qlo * PITCH;
#pragma unroll
    for (int r = 0; r < 16; ++r) { const int orow = crow(r, hi);
#pragma unroll
        for (int d0 = 0; d0 < 4; ++d0) { const float v = o[d0][r] * rli[r]; const float vn = __shfl_xor(v, 1);
            if ((r32 & 1) == 0) *(unsigned*)(Ow + (size_t)orow * PITCH + d0 * 32 + r32) = cvtpk(v, vn); } }
#undef TILEJ
#undef LOADT
#undef WRITET
}
}
#ifndef MK_ONE_LAUNCH
#define MK_ONE_LAUNCH 1
#endif
constexpr bool ONE_LAUNCH = (MK_ONE_LAUNCH != 0);
constexpr int NWAVES = 8, NTHR = NWAVES * 64;
constexpr int BATCH = 4, SEQ = 2048, DM = 2048, NH = 16, HD = 128, T = BATCH * SEQ;
constexpr int FF = 5632, NE = 8, FFX = 7168;
constexpr float RMS_EPS = 1e-6f;
constexpr float QSCALE = 0.08838834764831845f * 1.4426950408889634f;
constexpr int MAXTILES = 72;
constexpr int NPHASES = 16;
constexpr size_t MiB = 1u << 20;
constexpr size_t WS_CTL = 0, CTL_ZERO_BYTES = 1 * MiB;
constexpr size_t WS_WQKV = 2 * MiB;
constexpr size_t WS_WOA  = 26 * MiB;
constexpr size_t WS_WGU  = 34 * MiB;
constexpr size_t WS_WDN  = 78 * MiB;
constexpr size_t WS_WKVQ = 100 * MiB;
constexpr size_t WS_WF   = 124 * MiB;
constexpr size_t WS_WOB  = 125 * MiB;
constexpr size_t WS_WGUX = 134 * MiB;
constexpr size_t WS_WDNX = 582 * MiB;
constexpr size_t WS_A    = 806 * MiB;
constexpr size_t WS_Q    = 838 * MiB, WS_K = 870 * MiB, WS_V = 902 * MiB;
constexpr size_t WS_O    = 934 * MiB;
constexpr size_t WS_H1   = 966 * MiB;
constexpr size_t WS_ACT  = 1030 * MiB;
constexpr size_t WS_H2   = 1118 * MiB;
constexpr size_t WS_H3   = 1182 * MiB;
constexpr size_t WS_AS   = 1246 * MiB;
constexpr size_t WS_ACT2 = 1318 * MiB;
constexpr size_t WS_Y    = 1570 * MiB;
constexpr size_t WS_FP   = 1714 * MiB;
constexpr size_t WS_TOK  = 1716 * MiB;
constexpr size_t WS_CNT  = 1717 * MiB;
constexpr size_t WS_TAB  = 1718 * MiB;
constexpr size_t WS_YP   = 1720 * MiB;
constexpr size_t WS_SSQ1 = 1848 * MiB, WS_SSQ2 = 1850 * MiB, WS_RSTD = 1852 * MiB;
constexpr size_t WS_END  = 1854 * MiB;
constexpr int CW_BAR = 4096;
constexpr int RING_OFF = 0, RING_BYTES = 131072;
constexpr int LDS_BYTES = 163840;
constexpr int LDSCTL_OFF = LDS_BYTES - 2048, MISC_OFF = LDSCTL_OFF + 320;

#define GAS __attribute__((address_space(1)))
#define LAS __attribute__((address_space(3)))
typedef unsigned short bf16;
typedef unsigned v4u __attribute__((ext_vector_type(4)));
typedef unsigned v2u __attribute__((ext_vector_type(2)));
typedef float f32x4 __attribute__((ext_vector_type(4)));
typedef short bf16x8 __attribute__((ext_vector_type(8)));
typedef GAS unsigned gu32;
#define RLX_AGENT __ATOMIC_RELAXED, __HIP_MEMORY_SCOPE_AGENT
#define LDS_WAIT() asm volatile("s_waitcnt lgkmcnt(0)" ::: "memory")
#define VM_WAIT() asm volatile("s_waitcnt vmcnt(0)" ::: "memory")
__device__ __forceinline__ unsigned cvtpk2(float lo, float hi) { unsigned r; asm volatile("v_cvt_pk_bf16_f32 %0, %1, %2" : "=v"(r) : "v"(lo), "v"(hi)); return r; }

#define XB_TMO      128
#define XB_XCNT(j)  (256  + 64 * (j))
#define XB_XSUB(j)  (1280 + 64 * (j))
#define XB_XGEN(j)  (2304 + 64 * (j))
#define XB_TOP      3328
#define XB_TOPGEN   3392
#define XCD_BAR_WORDS 3456
#define XB_SPIN_CAP (1u << 18)
__device__ __forceinline__ unsigned xb_ld(unsigned* p)              { return __hip_atomic_load(p, __ATOMIC_RELAXED, __HIP_MEMORY_SCOPE_AGENT); }
__device__ __forceinline__ unsigned xb_add(unsigned* p, unsigned v) { return __hip_atomic_fetch_add(p, v, __ATOMIC_RELAXED, __HIP_MEMORY_SCOPE_AGENT); }
__device__ __forceinline__ unsigned xb_xcc_id() { return (unsigned)__builtin_amdgcn_s_getreg((3 << 11) | 20) & 0xFu; }
#define XB_SPIN(cond, bar) do { unsigned _sp = 0; while (cond) { __builtin_amdgcn_s_sleep(1); \
    if ((++_sp & 255u) == 0u) { if (xb_ld(&(bar)[XB_TMO])) break; if (_sp > XB_SPIN_CAP) { atomicAdd(&(bar)[XB_TMO], 1u); break; } } } } while (0)
struct XcdBarrier { unsigned* bar; unsigned x; volatile LAS unsigned* st; };
__device__ __forceinline__ XcdBarrier xcd_barrier_post(unsigned* bar, volatile LAS unsigned* st) {
    XcdBarrier b; b.bar = bar; b.x = xb_xcc_id(); b.st = st;
    if (threadIdx.x == 0) (void)xb_add(&bar[XB_XCNT(b.x)], 1u);
    return b;
}
__device__ __forceinline__ void xcd_barrier_complete(unsigned* bar, unsigned x, unsigned& nloc, unsigned& nx) {
    const unsigned G = gridDim.x * gridDim.y * gridDim.z;
    unsigned sum, cnt, mine, sp = 0u;
    for (;;) {
        sum = 0u; cnt = 0u; mine = 0u;
#pragma unroll
        for (unsigned j = 0; j < 16; ++j) { const unsigned c = xb_ld(&bar[XB_XCNT(j)]); sum += c; cnt += (c > 0u) ? 1u : 0u; mine = (j == x) ? c : mine; }
        if (sum == G) break;
        __builtin_amdgcn_s_sleep(1);
        if ((++sp & 255u) == 0u) { if (xb_ld(&bar[XB_TMO])) break; if (sp > XB_SPIN_CAP) { atomicAdd(&bar[XB_TMO], 1u); break; } }
    }
    nloc = mine > 0u ? mine : 1u; nx = cnt > 0u ? cnt : 1u;
}
__device__ __forceinline__ void xcd_barrier(const XcdBarrier& b) {
    asm volatile("s_waitcnt vmcnt(0)" ::: "memory");
    __syncthreads();
    if (threadIdx.x == 0) {
        unsigned* bar = b.bar;
        __builtin_amdgcn_s_waitcnt(0);
        unsigned nloc = b.st[0], nx = b.st[1];
        if (nloc == 0u) { xcd_barrier_complete(bar, b.x, nloc, nx); b.st[0] = nloc; b.st[1] = nx; }
        const unsigned old = xb_add(&bar[XB_XSUB(b.x)], 1u);
        const unsigned gen = old / nloc;
        if (old + 1u == (gen + 1u) * nloc) {
            __builtin_amdgcn_fence(__ATOMIC_RELEASE, "agent");
            asm volatile("s_waitcnt vmcnt(0)" ::: "memory");
            const unsigned og = xb_add(&bar[XB_TOP], 1u);
            const unsigned tg = og / nx;
            if (og + 1u == (tg + 1u) * nx) xb_add(&bar[XB_TOPGEN], 1u);
            else XB_SPIN(xb_ld(&bar[XB_TOPGEN]) == tg, bar);
            __builtin_amdgcn_fence(__ATOMIC_ACQUIRE, "agent");
            xb_add(&bar[XB_XGEN(b.x)], 1u);
            asm volatile("s_waitcnt vmcnt(0)" ::: "memory");
        } else {
            XB_SPIN(xb_ld(&bar[XB_XGEN(b.x)]) == gen, bar);
            __builtin_amdgcn_fence(__ATOMIC_ACQUIRE, "agent");
            asm volatile("s_waitcnt vmcnt(0)" ::: "memory");
        }
    }
    __syncthreads();
}

__device__ __forceinline__ float wave_sum(float v) {
#pragma unroll
    for (int o = 1; o < 64; o <<= 1) v += __shfl_xor(v, o);
    return v;
}

constexpr int CT_M0 = 0, CT_M1 = CT_M0 + 64 * 24, CT_M2 = CT_M1 + 64 * 8, CT_M3 = CT_M2 + 64 * 44, CT_M4 = CT_M3 + 176 * 8, CT_M5 = CT_M4 + 64 * 16, CT_M6 = CT_M5 + 64 * 8, CT_M7 = CT_M6 + 64 * 8,
              CT_M8 = CT_M7 + 8 * 64 * 56, CT_END = CT_M8 + 8 * 224 * 8;
static_assert(CT_END == 51328, "task count");
struct CDesc { const float* src; const float* gain; unsigned dst_off; int K, N, nblk, Np, dcol0, mode, F, base, pad; };
static_assert(sizeof(CDesc) == 56 || sizeof(CDesc) == 64, "CDesc");
constexpr int CDESC_OFF = LDSCTL_OFF + 1024;
__device__ __forceinline__ unsigned udiv_small(unsigned a, unsigned b) {
    unsigned q = (unsigned)__builtin_amdgcn_readfirstlane((int)(unsigned)((float)a * __builtin_amdgcn_rcpf((float)b))); if (q * b > a) --q; if ((q + 1) * b <= a) ++q; return q; }
#define CAS __attribute__((address_space(4)))
struct ConvJob { const GAS char* sp; const CAS float* gp; unsigned dp; unsigned sstride, dstride; };
__device__ __forceinline__ unsigned conv_slane(int mode, unsigned foff, int lane) {
    const int l = (mode == 2) ? (lane & 31) : lane;
    const unsigned pf = 32u * (l >> 3) + 4u * (2u * (l & 3) + ((l >> 2) & 1));
    return (mode == 0) ? 16u * lane : (4u * pf + ((mode == 2 && lane >= 32) ? foff : 0u));
}
__device__ __forceinline__ v2u conv_pack(f32x4 v, float g) { v2u o; o.x = cvtpk2(v.x * g, v.y * g); o.y = cvtpk2(v.z * g, v.w * g); return o; }
struct ConvStream {
    static constexpr bool ON = true, REG = false; static constexpr int HOST_VMCNT = 8;
    const LAS CDesc* tabL; unsigned char* ws; ConvJob j; int task, tstep, tend, rows_left; unsigned slane; int lane; bool live;
    __device__ __forceinline__ void decode(int t) {
        const int m = (t >= CT_M1) + (t >= CT_M2) + (t >= CT_M3) + (t >= CT_M4) + (t >= CT_M5) + (t >= CT_M6) + (t >= CT_M7) + (t >= CT_M8);
        const LAS CDesc* d = tabL + m;
#define RFL(x) __builtin_amdgcn_readfirstlane(x)
        const int K = RFL(d->K), N = RFL(d->N), nblk = RFL(d->nblk), Np = RFL(d->Np), mode = RFL(d->mode), F = RFL(d->F), base = RFL(d->base), dcol0 = RFL(d->dcol0); const unsigned dst_off = (unsigned)RFL((int)d->dst_off);
        const LAS unsigned* dw = (const LAS unsigned*)d;
        const GAS float* srcp = (const GAS float*)(((unsigned long long)(unsigned)RFL((int)dw[1]) << 32) | (unsigned)RFL((int)dw[0]));
        const CAS float* gn = (const CAS float*)(((unsigned long long)(unsigned)RFL((int)dw[3]) << 32) | (unsigned)RFL((int)dw[2]));
#undef RFL
        const unsigned r = (unsigned)(t - base), per = (unsigned)((K >> 5) * nblk), e = udiv_small(r, per), r2 = r - e * per, rc = udiv_small(r2, (unsigned)nblk), blk = r2 - rc * nblk;
        const size_t row0 = (size_t)e * K + (size_t)rc * 32; const unsigned sc = (mode == 2) ? blk * 128u : blk * 256u;
        j.sp = (const GAS char*)(srcp + row0 * N + sc); j.dp = dst_off + (unsigned)((row0 * Np + dcol0 + blk * 256u) * 2u);
        j.gp = gn ? gn + rc * 32 : nullptr; j.sstride = (unsigned)N * 4u; j.dstride = (unsigned)Np * 2u;
        slane = conv_slane(mode, (unsigned)F * 4u, lane); rows_left = 32;
    }
    __device__ __forceinline__ void start(const LAS CDesc* tabL_, unsigned char* ws_, int t0, int tstep_, int tend_, int lane_) { tabL = tabL_; ws = ws_; task = t0; tstep = tstep_; tend = tend_; lane = lane_; live = t0 < tend_;
        decode(live ? t0 : tend_ - 1); }
    __device__ __forceinline__ void advance() {
        if (rows_left > 1) { --rows_left; j.sp += j.sstride; j.dp += j.dstride; if (j.gp) ++j.gp; }
        else if (task + tstep < tend) { task += tstep; decode(task); }
        else live = false;
    }
    struct Burst { const GAS char* sp; const CAS float* gp; unsigned dp, sstride, dstride, slane; };
    __device__ __forceinline__ bool burst_begin(Burst& b) {
        b.sp = j.sp; b.gp = j.gp; b.dp = j.dp; b.sstride = j.sstride; b.dstride = j.dstride; b.slane = slane; const bool was = live;
        if (rows_left > 16) { rows_left -= 16; j.sp += 16 * j.sstride; j.dp += 16 * j.dstride; if (j.gp) j.gp += 16; }
        else if (task + tstep < tend) { task += tstep; decode(task); }
        else live = false;
        return was;
    }
    __device__ __forceinline__ bool burst_begin_n(Burst& b, int R) {
        b.sp = j.sp; b.gp = j.gp; b.dp = j.dp; b.sstride = j.sstride; b.dstride = j.dstride; b.slane = slane; const bool was = live;
        if (rows_left > R) { rows_left -= R; j.sp += R * j.sstride; j.dp += R * j.dstride; if (j.gp) j.gp += R; }
        else if (task + tstep < tend) { task += tstep; decode(task); }
        else live = false;
        return was;
    }
    __device__ __forceinline__ void burst_dma(const Burst& b, int i, LAS unsigned char* dst) const {
        __builtin_amdgcn_global_load_lds((const GAS unsigned*)(b.sp + (size_t)i * b.sstride + b.slane), (LAS unsigned*)dst, 16, 0, 0); }
    __device__ __forceinline__ void burst_finish4(const Burst& b, LAS unsigned char* src) const {
        typedef float gain4 __attribute__((ext_vector_type(4)));
        gain4 g = {1.f, 1.f, 1.f, 1.f}; if (b.gp) g = *(const CAS gain4*)b.gp;
#pragma unroll
        for (int i = 0; i < 4; ++i) { const f32x4 v = *(const LAS f32x4*)(src + i * 1024 + 16 * lane); store(b.dp + (unsigned)i * b.dstride, conv_pack(v, g[i])); }
    }
    __device__ __forceinline__ f32x4 burst_load(const Burst& b, int i) const { return __builtin_nontemporal_load((const GAS f32x4*)(b.sp + (size_t)i * b.sstride + b.slane)); }
    typedef float gain16 __attribute__((ext_vector_type(16)));
    __device__ __forceinline__ gain16 burst_gains(const Burst& b) const { gain16 g;
#pragma unroll
        for (int i = 0; i < 16; ++i) g[i] = 1.0f;
        if (b.gp) g = *(const CAS gain16*)b.gp;
        return g; }
    __device__ __forceinline__ void burst_store(const Burst& b, int i, f32x4 v, float g) const { store(b.dp + (unsigned)i * b.dstride, conv_pack(v, g)); }
    __device__ __forceinline__ f32x4 load() const { return __builtin_nontemporal_load((const GAS f32x4*)(j.sp + slane)); }
    __device__ __forceinline__ void load_asm(f32x4& x) const { const unsigned long long p = (unsigned long long)j.sp;
        const unsigned long long ps = ((unsigned long long)(unsigned)__builtin_amdgcn_readfirstlane((int)(unsigned)(p >> 32)) << 32) | (unsigned)__builtin_amdgcn_readfirstlane((int)(unsigned)p);
        asm volatile("s_nop 4\n\tglobal_load_dwordx4 %0, %1, %2 nt" : "=&v"(x) : "v"(slane), "s"(ps) : "memory"); }
    __device__ __forceinline__ float gain() const { return j.gp ? *j.gp : 1.0f; }
    __device__ __forceinline__ void store(unsigned dp, v2u y) const { *(GAS v2u*)((GAS unsigned char*)ws + (dp + 8u * (unsigned)lane)) = y; }
};
__device__ __forceinline__ void conv_drain(ConvStream& s) {
    while (s.live) {
        f32x4 v[8]; unsigned dp[8]; float g[8]; bool ok[8];
#pragma unroll
        for (int i = 0; i < 8; ++i) { ok[i] = s.live; v[i] = s.load(); dp[i] = s.j.dp; g[i] = s.gain(); s.advance(); }
#pragma unroll
        for (int i = 0; i < 8; ++i) if (ok[i]) s.store(dp[i], conv_pack(v[i], g[i]));
    }
}
__device__ __forceinline__ unsigned cvt4_fp8(float a, float b, float c, float d) { int w = __builtin_amdgcn_cvt_pk_fp8_f32(a, b, 0, false); w = __builtin_amdgcn_cvt_pk_fp8_f32(c, d, w, true); return (unsigned)w; }
__device__ __forceinline__ void conv8_task(const float* src, int K, int N, unsigned char* dst, const float* gain, int F, float scale, int t, int lane) {
    const int nstrip = N / 32, nkc = K / 512, per = nstrip * nkc;
    const int e = t / per, r = t - e * per, kc = r / nstrip, strip = r - kc * nstrip;
    src += (size_t)e * K * N; dst += (size_t)e * N * K;
    const int n = strip * 32 + 4 * (lane & 7), q = lane >> 3;
    int drow = n; if (F > 0) drow = (n < F) ? ((n >> 7) * 256 + (n & 127)) : (((n - F) >> 7) * 256 + 128 + ((n - F) & 127));
#pragma unroll 1
    for (int step = 0; step < 4; ++step) {
        const int k0 = kc * 512 + step * 128 + 16 * q;
        f32x4 v[16];
#pragma unroll
        for (int i = 0; i < 16; ++i) v[i] = __builtin_nontemporal_load((const f32x4*)(src + (size_t)(k0 + i) * N + n));
        float g[16];
#pragma unroll
        for (int i = 0; i < 4; ++i) { f32x4 gv = {scale, scale, scale, scale}; if (gain) gv = *(const f32x4*)(gain + k0 + 4 * i) * scale; g[4 * i] = gv.x; g[4 * i + 1] = gv.y; g[4 * i + 2] = gv.z; g[4 * i + 3] = gv.w; }
#pragma unroll
        for (int j = 0; j < 4; ++j) { v4u o;
            o.x = cvt4_fp8(v[0][j] * g[0], v[1][j] * g[1], v[2][j] * g[2], v[3][j] * g[3]); o.y = cvt4_fp8(v[4][j] * g[4], v[5][j] * g[5], v[6][j] * g[6], v[7][j] * g[7]);
            o.z = cvt4_fp8(v[8][j] * g[8], v[9][j] * g[9], v[10][j] * g[10], v[11][j] * g[11]); o.w = cvt4_fp8(v[12][j] * g[12], v[13][j] * g[13], v[14][j] * g[14], v[15][j] * g[15]);
            *(v4u*)(dst + (size_t)(drow + j) * K + k0) = o; }
    }
}
template <bool REG_, bool DIRECT_ = false> struct Conv8StreamT {
    static constexpr bool ON = true, REG = REG_; static constexpr int HOST_VMCNT = 4;
    struct Burst { const GAS char* sp; GAS unsigned char* dp; unsigned doff; };
    const float* src; unsigned char* dst; int task, tstep, tend, step; int lane; bool live; float scale;
    const GAS char* sp; GAS unsigned char* dp; unsigned doff;
    static constexpr int K = DM, N = 2 * FFX, F = FFX, NSTRIP = N / 32, PER = NSTRIP * (K / 512);
    __device__ __forceinline__ void decode(int t) {
        const int e = t / PER, r = t - e * PER, kc = r / NSTRIP, strip = r - kc * NSTRIP;
        const int n0 = strip * 32, k0 = kc * 512;
        sp = (const GAS char*)(src + ((size_t)e * K + k0) * N + n0); dp = (GAS unsigned char*)dst + (size_t)e * N * K + k0;
        const int n = DIRECT_ ? n0 + 4 * (lane & 7) : n0 + (lane & 31); const int drow = (n < F) ? ((n >> 7) * 256 + (n & 127)) : (((n - F) >> 7) * 256 + 128 + ((n - F) & 127));
        doff = DIRECT_ ? (unsigned)drow * (unsigned)K + 4u * (unsigned)(lane >> 3) : (unsigned)drow * (unsigned)K + 16u * (unsigned)(lane >> 5); step = 0;
    }
    __device__ __forceinline__ void start(const float* src_, unsigned char* dst_, float scale_, int t0, int tstep_, int tend_, int lane_) { src = src_; dst = dst_; scale = scale_; task = t0; tstep = tstep_; tend = tend_; lane = lane_;
        live = t0 < tend_; decode(live ? t0 : tend_ - 1); }
    __device__ __forceinline__ bool burst_begin_n(Burst& b, int R) {
        b.sp = sp; b.dp = dp; b.doff = doff; const bool was = live; if (R == 0) return was;
        if (step < 15) { ++step; sp += (size_t)32 * N * 4; dp += 32; }
        else if (task + tstep < tend) { task += tstep; decode(task); }
        else live = false;
        return was;
    }
    __device__ __forceinline__ void burst_dma(const Burst& b, int i, LAS unsigned char* dstl) const {
        __builtin_amdgcn_global_load_lds((const GAS unsigned*)(b.sp + ((size_t)((lane >> 3) + 8 * i) * N + 4 * (lane & 7)) * 4), (LAS unsigned*)dstl, 16, 0, 0); }
    __device__ __forceinline__ f32x4 burst_ld(const Burst& b, int i) const {
        const int row = DIRECT_ ? 4 * (lane >> 3) + i : (lane >> 3) + 8 * i;
        return __builtin_nontemporal_load((const GAS f32x4*)(b.sp + ((size_t)row * N + 4 * (lane & 7)) * 4)); }
    __device__ __forceinline__ void burst_finish_regs(const Burst& b, const f32x4 (&hv)[4], LAS unsigned char* stl) const {
        if constexpr (DIRECT_) {
#pragma unroll
            for (int j = 0; j < 4; ++j) *(GAS unsigned*)(b.dp + b.doff + (size_t)j * K) = cvt4_fp8(hv[0][j] * scale, hv[1][j] * scale, hv[2][j] * scale, hv[3][j] * scale);
            return; }
#pragma unroll
        for (int i = 0; i < 4; ++i) *(LAS f32x4*)(stl + i * 1024 + 16 * lane) = hv[i];
        asm volatile("s_waitcnt lgkmcnt(0)" ::: "memory");
        burst_finish4(b, stl);
        asm volatile("s_waitcnt lgkmcnt(0)" ::: "memory");
    }
    __device__ __forceinline__ void burst_finish4(const Burst& b, LAS unsigned char* srcl) const {
        const LAS float* p = (const LAS float*)srcl + 16 * (lane >> 5) * 32 + (lane & 31);
        float v[16];
#pragma unroll
        for (int j = 0; j < 16; ++j) v[j] = p[j * 32] * scale;
        v4u o; o.x = cvt4_fp8(v[0], v[1], v[2], v[3]); o.y = cvt4_fp8(v[4], v[5], v[6], v[7]); o.z = cvt4_fp8(v[8], v[9], v[10], v[11]); o.w = cvt4_fp8(v[12], v[13], v[14], v[15]);
        *(GAS v4u*)(b.dp + b.doff) = o;
    }
};
template <class S8> __device__ __forceinline__ void conv8_drain(S8& s) {
    while (s.live) { conv8_task(s.src, S8::K, S8::N, s.dst, nullptr, S8::F, s.scale, s.task, s.lane);
        if (s.task + s.tstep < s.tend) s.task += s.tstep; else s.live = false; }
}
typedef Conv8StreamT<false> Conv8Stream; typedef Conv8StreamT<true> Conv8StreamR; typedef Conv8StreamT<true, true> Conv8StreamD;
constexpr float SC_WGU = 64.f, SC_ACT = 8.f, SC_WDN = 128.f;
#define BF4_TO_F4(w_) ((f32x4){__uint_as_float((w_).x << 16), __uint_as_float((w_).x & 0xffff0000u), __uint_as_float((w_).y << 16), __uint_as_float((w_).y & 0xffff0000u)})
__device__ __forceinline__ void rms_rowh_to_bf16(const bf16* xrow, bf16* orow, int lane) {
    const v2u* xr = (const v2u*)xrow + lane;
    f32x4 v[8]; float s = 0.f;
#pragma unroll
    for (int j = 0; j < 8; ++j) { const v2u w = xr[64 * j]; v[j] = BF4_TO_F4(w); s += (v[j].x * v[j].x + v[j].y * v[j].y) + (v[j].z * v[j].z + v[j].w * v[j].w); }
    const float rstd = 1.0f / sqrtf(wave_sum(s) * (1.f / DM) + RMS_EPS);
    v2u* o8 = (v2u*)orow + lane;
#pragma unroll
    for (int j = 0; j < 8; ++j) { v2u w; w.x = cvtpk2(v[j].x * rstd, v[j].y * rstd); w.y = cvtpk2(v[j].z * rstd, v[j].w * rstd); o8[64 * j] = w; }
}
__device__ __forceinline__ void rms_row_to_bf16(const float* xrow, bf16* orow, int lane) {
    const f32x4* xr = (const f32x4*)xrow + lane;
    f32x4 v[8]; float s = 0.f;
#pragma unroll
    for (int j = 0; j < 8; ++j) { v[j] = xr[64 * j]; s += (v[j].x * v[j].x + v[j].y * v[j].y) + (v[j].z * v[j].z + v[j].w * v[j].w); }
    const float rstd = 1.0f / sqrtf(wave_sum(s) * (1.f / DM) + RMS_EPS);
    v2u* o8 = (v2u*)orow + lane;
#pragma unroll
    for (int j = 0; j < 8; ++j) { v2u w; w.x = cvtpk2(v[j].x * rstd, v[j].y * rstd); w.y = cvtpk2(v[j].z * rstd, v[j].w * rstd); o8[64 * j] = w; }
}
struct Args { const float* in[16]; float* out; unsigned char* ws; int ph_lo, ph_hi; };
enum { I_X = 0, I_NMIX, I_NFFN, I_WQKVA, I_WOA, I_NKV, I_WKVF, I_BF, I_WQB, I_WOB, I_WGU, I_WDN, I_WR, I_WGUX, I_WDNX, I_NFIN };

__global__ void __launch_bounds__(NTHR, 2) yoco_fwd(Args args) {
    extern __shared__ __attribute__((aligned(16))) unsigned char lds_raw[];
    LAS unsigned char* lds = (LAS unsigned char*)lds_raw;
    volatile LAS unsigned* MISC = (volatile LAS unsigned*)(lds + MISC_OFF);
    const int tid = threadIdx.x, lane = tid & 63, wave = __builtin_amdgcn_readfirstlane(tid >> 6);
    const int G = gridDim.x; const int bx = blockIdx.x; const int vcu = (G % 8 == 0) ? (bx % 8) * (G / 8) + bx / 8 : bx;
    const int gw = vcu * NWAVES + wave, NGW = G * NWAVES;
    unsigned char* ws = args.ws;
    gu32* ctl = (gu32*)(ws + WS_CTL);
    for (int u = tid; u < (LDS_BYTES - LDSCTL_OFF) / 4; u += NTHR) ((LAS unsigned*)(lds + LDSCTL_OFF))[u] = 0u;
    __syncthreads();
    if (tid == 0) {
        const float* nmix = args.in[I_NMIX]; const float* nffn = args.in[I_NFFN]; const float* nkv = args.in[I_NKV]; const float* nul = nullptr;
#define CD_SET(i_, SRC_, GAIN_, DST_, K_, N_, NBLK_, NP_, DCOL0_, MODE_, F_, BASE_) { LAS CDesc* d_ = (LAS CDesc*)(lds + CDESC_OFF) + (i_); d_->src = (SRC_); d_->gain = (GAIN_); d_->dst_off = (unsigned)(DST_); \
            d_->K = (K_); d_->N = (N_); d_->nblk = (NBLK_); d_->Np = (NP_); d_->dcol0 = (DCOL0_); d_->mode = (MODE_); d_->F = (F_); d_->base = (BASE_); d_->pad = 0; }
        CD_SET(0, args.in[I_WQKVA], nmix,        WS_WQKV, 2048, 6144,    24, 6144,    0,    1, 0,   CT_M0)
        CD_SET(1, args.in[I_WOA],   nul,         WS_WOA,  2048, 2048,    8,  2048,    0,    1, 0,   CT_M1)
        CD_SET(2, args.in[I_WGU],   nffn,        WS_WGU,  2048, 2 * FF,  44, 2 * FF,  0,    2, FF,  CT_M2)
        CD_SET(3, args.in[I_WDN],   nul,         WS_WDN,  FF,   2048,    8,  2048,    0,    1, 0,   CT_M3)
        CD_SET(4, args.in[I_WKVF],  nkv,         WS_WKVQ, 2048, 4112,    16, 6144,    2048, 1, 0,   CT_M4)
        CD_SET(5, args.in[I_WQB],   nmix + 2048, WS_WKVQ, 2048, 2048,    8,  6144,    0,    1, 0,   CT_M5)
        CD_SET(6, args.in[I_WOB],   nul,         WS_WOB,  2048, 2048,    8,  2048,    0,    1, 0,   CT_M6)
        CD_SET(7, args.in[I_WGUX],  nffn + 2048, WS_WGUX, 2048, 2 * FFX, 56, 2 * FFX, 0,    2, FFX, CT_M7)
        CD_SET(8, args.in[I_WDNX],  nul,         WS_WDNX, FFX,  2048,    8,  2048,    0,    0, 0,   CT_M8)
#undef CD_SET
    }
    __syncthreads();
    XcdBarrier bar; bar.bar = (unsigned*)(ctl + CW_BAR); bar.x = 0; bar.st = nullptr;
    if (ONE_LAUNCH) bar = xcd_barrier_post((unsigned*)(ctl + CW_BAR), MISC + 8);
    const int lo = args.ph_lo, hi = args.ph_hi;
#define IN(k) (lo <= (k) && (k) < hi)
#define SEAM(k) do { if (IN(k) && IN((k) + 1)) xcd_barrier(bar); } while (0)

    bf16* const wA = (bf16*)(ws + WS_A); bf16* const wQ = (bf16*)(ws + WS_Q); bf16* const wK = (bf16*)(ws + WS_K); bf16* const wV = (bf16*)(ws + WS_V); bf16* const wO = (bf16*)(ws + WS_O);
    bf16* const H1 = (bf16*)(ws + WS_H1); bf16* const H2 = (bf16*)(ws + WS_H2); bf16* const H3 = (bf16*)(ws + WS_H3);
    int* const tokE = (int*)(ws + WS_TOK); float* const tokG = (float*)(ws + WS_TOK + 65536); int* const tokR = (int*)(ws + WS_TOK + 2 * 65536); int* const tokS = (int*)(ws + WS_TOK + 3 * 65536);
    int* const cntG = (int*)(ws + WS_CNT); int* const tab = (int*)(ws + WS_TAB);
    constexpr int CL_P0A_LO = CT_M0, CL_P0A_HI = CT_M1;
    constexpr int CL_P1_LO = CT_M1, CL_P1_HI = CT_M7;
    constexpr int CL_P2_LO = CT_M3, CL_P2_HI = CT_M7;
    constexpr int CL_P9_LO = CT_M7, CL_P9_HI = CT_M7;
    constexpr int CL_P13_LO = CT_M8, CL_P13_HI = CT_END;
    constexpr int NTG = 8 * (2 * FFX / 32) * (DM / 512), NTD = 8 * (DM / 32) * (FFX / 512), NCV = 16, NCV13 = 32, X5 = 2048, HH2 = 4096, HH9 = 8192;
    const bool cvsplit = (G >= 128); const int GW = G - NCV, GW13 = G - NCV13; const bool cvb = cvsplit && (bx >= GW), cvb13 = cvsplit && (bx >= GW13);
    const LAS CDesc* tabL = (const LAS CDesc*)(lds + CDESC_OFF);

    if (IN(0)) {
        const float* nmix = args.in[I_NMIX]; const float* nffn = args.in[I_NFFN]; const float* nkv = args.in[I_NKV];
        {   ConvStream cs; cs.start(tabL, ws, CL_P0A_LO + gw, NGW, CL_P0A_HI, lane); conv_drain(cs); }
        {
            const int n0 = cvsplit ? NTG - X5 - HH2 - HH9 : NTG + NTD;
            for (int t = gw; t < n0; t += NGW) {
                if (t < NTG) conv8_task(args.in[I_WGUX], DM, 2 * FFX, ws + WS_WGUX, nullptr, FFX, SC_WGU, t, lane);
                else conv8_task(args.in[I_WDNX], FFX, DM, ws + WS_WDNX, nullptr, 0, SC_WDN, t - NTG, lane); }
        }
        {
            const float* wkvf = args.in[I_WKVF]; bf16* WF = (bf16*)(ws + WS_WF);
            for (int idx = (vcu * NTHR + tid); idx < 16 * 2048; idx += G * NTHR) { const int k = idx >> 4, j = idx & 15;
                const float v = wkvf[(size_t)k * 4112 + 4096 + j] * nkv[k]; WF[j * 2048 + k] = (bf16)(cvtpk2(v, 0.f) & 0xffffu); }
        }
        for (int m = gw; m < T; m += NGW) rms_row_to_bf16(args.in[I_X] + (size_t)m * DM, wA + (size_t)m * DM, lane);
    }
    SEAM(0);
    if (IN(1)) {
        pg8::Gemm g{wA, (const bf16*)(ws + WS_WQKV), DM, 3 * DM, DM}; pg8::StaticOrder S; S.init(T, 3 * DM, G, bx);
        pg8::EpiBf16Split E{wQ, DM, DM, (size_t)(WS_K - WS_Q) / 2, QSCALE, 0, 1.0f, nullptr, nullptr, nullptr};
        ConvStream bg; bg.start(tabL, ws, CL_P1_LO + gw, NGW, CL_P1_HI, lane);
        pg8::gemm_phase<pg8::EpiBf16Split, pg8::StaticOrder, ConvStream>(lds + RING_OFF, g, S, E, bg); conv_drain(bg);
    }
    SEAM(1);
    if (IN(2)) {
        Conv8StreamD bgA; { const int lo8 = cvsplit ? NTG - X5 - HH2 - HH9 : NTG; bgA.start(args.in[I_WGUX], ws + WS_WGUX, SC_WGU, lo8 + gw, NGW, lo8 + (cvsplit ? HH2 : 0), lane); }
        for (int it = vcu; it < 256; it += G) { const int bh = it >> 2, x = it & 3, b = bh >> 4, h = bh & 15;
            for (int pass = 0; pass < 2; ++pass) att::attn_block<false, Conv8StreamD>((LAS char*)lds, wQ, wK, wV, wO, b, h, pass ? x : 7 - x, bgA); }
        conv8_drain(bgA);
    }
    SEAM(2);
    if (IN(3)) {
        pg8::Gemm g{wO, (const bf16*)(ws + WS_WOA), DM, DM, DM}; pg8::StaticOrder S; S.init(T, DM, G, bx);
        pg8::EpiResBf16 E{H1, DM, args.in[I_X], nullptr, (float*)(ws + WS_SSQ1)};
        pg8::NoBg nobg; pg8::gemm_phase<pg8::EpiResBf16, pg8::StaticOrder, pg8::NoBg>(lds + RING_OFF, g, S, E, nobg);
    }
    SEAM(3);
    if (IN(5)) {
        if (cvb) { const float* nffn = args.in[I_NFFN];
            for (int t = NTG - X5 + (bx - GW) * NWAVES + wave; t < NTG; t += NCV * NWAVES) conv8_task(args.in[I_WGUX], DM, 2 * FFX, ws + WS_WGUX, nullptr, FFX, SC_WGU, t, lane);
        } else {
        const int Gw = cvsplit ? GW : G;
        pg8::Gemm g{H1, (const bf16*)(ws + WS_WGU), DM, 2 * FF, DM}; pg8::StaticOrder S; S.init(T, 2 * FF, Gw, bx);
        pg8::EpiSwiGLU E{(bf16*)(ws + WS_ACT), FF, (const float*)(ws + WS_SSQ1), (const LAS float*)(lds + RING_BYTES), nullptr};
        pg8::NoBg nobg; pg8::gemm_phase<pg8::EpiSwiGLU, pg8::StaticOrder, pg8::NoBg>(lds + RING_OFF, g, S, E, nobg);
        }
    }
    SEAM(5);
    if (IN(6)) {
        pg8::Gemm g{(const bf16*)(ws + WS_ACT), (const bf16*)(ws + WS_WDN), FF, DM, FF}; pg8::StaticOrder S; S.init(T, DM, G, bx);
        pg8::EpiResBf16 E{H2, DM, nullptr, H1, (float*)(ws + WS_SSQ2)};
        pg8::NoBg nobg; pg8::gemm_phase<pg8::EpiResBf16, pg8::StaticOrder, pg8::NoBg>(lds + RING_OFF, g, S, E, nobg);
    }
    SEAM(6);
    if (IN(8)) {
        {   const bf16* WF = (const bf16*)(ws + WS_WF); float* FP = (float*)(ws + WS_FP); const int fr = lane & 15, fq = lane >> 4;
            for (int task = gw; task < 2048; task += NGW) { const int rt = task >> 2, kq = task & 3;
                const bf16* Ap = H2 + (size_t)(16 * rt + fr) * DM + 512 * kq + 8 * fq; const bf16* Bp = WF + (size_t)fr * DM + 512 * kq + 8 * fq;
                f32x4 acc = {0.f, 0.f, 0.f, 0.f};
#pragma unroll
                for (int s = 0; s < 16; ++s) { const bf16x8 a = *(const bf16x8*)(Ap + 32 * s), bb = *(const bf16x8*)(Bp + 32 * s); acc = __builtin_amdgcn_mfma_f32_16x16x32_bf16(bb, a, acc, 0, 0, 0); }
                *(f32x4*)(FP + ((size_t)kq * T + 16 * rt + fr) * 16 + 4 * fq) = acc; }
        }
        pg8::Gemm g{H2, (const bf16*)(ws + WS_WKVQ), DM, 3 * DM, DM}; pg8::StaticOrder S; S.init(T, 3 * DM, G, bx);
        pg8::EpiBf16Split E{wQ, DM, DM, (size_t)(WS_K - WS_Q) / 2, QSCALE, 0, 1.0f, (const float*)(ws + WS_SSQ2), (const LAS float*)(lds + RING_BYTES), (float*)(ws + WS_RSTD)};
        pg8::NoBg nobg; pg8::gemm_phase<pg8::EpiBf16Split, pg8::StaticOrder, pg8::NoBg>(lds + RING_OFF, g, S, E, nobg);
    }
    SEAM(8);
    if (IN(9)) {
        Conv8StreamD bgA; { const int lo8 = cvsplit ? NTG - X5 - HH9 : NTG; bgA.start(args.in[I_WGUX], ws + WS_WGUX, SC_WGU, lo8 + gw, NGW, lo8 + (cvsplit ? HH9 : 0), lane); }
        const float* FP = (const float*)(ws + WS_FP); const float* bfp = args.in[I_BF];
        LAS float* biasL = (LAS float*)(lds + att::OFF_BIAS); LAS float* scanL = (LAS float*)(lds + att::OFF_SCAN);
        for (int it = vcu; it < 256; it += G) { const int bh = it >> 2, x = it & 3, b = bh >> 4, h = bh & 15;
            {
                float c[4]; float run = 0.f; const float bfh = bfp[h];
#pragma unroll
                for (int j = 0; j < 4; ++j) { const size_t row = (size_t)b * SEQ + 4 * tid + j; float f = 0.f;
#pragma unroll
                    for (int kq = 0; kq < 4; ++kq) f += FP[((size_t)kq * T + row) * 16 + h];
                    f = bfh + f * ((const float*)(ws + WS_RSTD))[row];
                    const float lf = fminf(f, 0.f) - __logf(1.0f + __expf(-fabsf(f))); run += lf; c[j] = run; }
                float incl = run;
#pragma unroll
                for (int o = 1; o < 64; o <<= 1) { const float n = __shfl_up(incl, o); if (lane >= o) incl += n; }
                if (lane == 63) scanL[wave] = incl;
                __syncthreads();
                float wpre = 0.f;
#pragma unroll
                for (int w = 0; w < 8; ++w) { const float tw = scanL[w]; if (w < wave) wpre += tw; }
                const float base = wpre + (incl - run);
#pragma unroll
                for (int j = 0; j < 4; ++j) biasL[4 * tid + j] = -(base + c[j]) * 1.4426950408889634f;
                __syncthreads();
            }
            for (int pass = 0; pass < 2; ++pass) att::attn_block<true, Conv8StreamD, 2>((LAS char*)lds, wQ, wK, wV, wO, b, h, pass ? x : 7 - x, bgA); }
        conv8_drain(bgA);
    }
    SEAM(9);
    if (IN(10)) {
        pg8::Gemm g{wO, (const bf16*)(ws + WS_WOB), DM, DM, DM}; pg8::StaticOrder S; S.init(T, DM, G, bx);
        pg8::EpiResBf16 E{H3, DM, nullptr, H2, nullptr};
        pg8::NoBg nobg; pg8::gemm_phase<pg8::EpiResBf16, pg8::StaticOrder, pg8::NoBg>(lds + RING_OFF, g, S, E, nobg);
    }
    SEAM(10);
    if (IN(11)) {
        LAS float* wrL = (LAS float*)lds;
        LAS int* eL = (LAS int*)(lds + 65536);
        const float* wr = args.in[I_WR]; const float* gn = args.in[I_NFFN] + 2048;
        for (int idx = tid; idx < 8 * 2048; idx += NTHR) { const int c = idx >> 3, e = idx & 7; wrL[e * 2048 + c] = wr[idx]; }
        __syncthreads();
        for (int g = vcu; g < 256; g += G) {
            for (int i = 0; i < 4; ++i) { const int tl = 4 * wave + i, token = 32 * g + tl;
                const v2u* xr = (const v2u*)(H3 + (size_t)token * DM) + lane;
                f32x4 v[8]; float s = 0.f;
#pragma unroll
                for (int j = 0; j < 8; ++j) { const v2u w_ = xr[64 * j]; v[j] = BF4_TO_F4(w_); s += (v[j].x * v[j].x + v[j].y * v[j].y) + (v[j].z * v[j].z + v[j].w * v[j].w); }
                const float rstd = 1.0f / sqrtf(wave_sum(s) * (1.f / DM) + RMS_EPS);
                unsigned* o4 = (unsigned*)((unsigned char*)wA + (size_t)token * DM) + lane;
#pragma unroll
                for (int j = 0; j < 8; ++j) { v[j] = v[j] * rstd * ((const f32x4*)gn)[lane + 64 * j]; o4[64 * j] = pg8::pk4_fp8(v[j].x, v[j].y, v[j].z, v[j].w); }
                float lg[8];
#pragma unroll
                for (int e = 0; e < 8; ++e) { float a = 0.f;
#pragma unroll
                    for (int j = 0; j < 8; ++j) { const f32x4 w4 = *(const LAS f32x4*)(wrL + e * 2048 + 256 * j + 4 * lane); a += (v[j].x * w4.x + v[j].y * w4.y) + (v[j].z * w4.z + v[j].w * w4.w); }
                    lg[e] = wave_sum(a); }
                int e1 = 0; float v1 = lg[0];
#pragma unroll
                for (int e = 1; e < 8; ++e) if (lg[e] > v1) { v1 = lg[e]; e1 = e; }
                int e2 = -1; float v2 = -__builtin_inff();
#pragma unroll
                for (int e = 0; e < 8; ++e) if (e != e1 && lg[e] > v2) { v2 = lg[e]; e2 = e; }
                const float g1 = 1.0f / (1.0f + __expf(v2 - v1)), g2 = 1.0f - g1;
                if (lane == 0) { eL[2 * tl] = e1; eL[2 * tl + 1] = e2; tokE[2 * token] = e1; tokE[2 * token + 1] = e2; tokG[2 * token] = g1; tokG[2 * token + 1] = g2; }
            }
            __syncthreads();
            if (tid == 0) { int cnt[8];
#pragma unroll
                for (int e = 0; e < 8; ++e) cnt[e] = 0;
                for (int q = 0; q < 64; ++q) { const int e = eL[q]; int r = 0;
#pragma unroll
                    for (int k = 0; k < 8; ++k) if (k == e) { r = cnt[k]; cnt[k] = r + 1; }
                    tokR[64 * g + q] = r; }
#pragma unroll
                for (int e = 0; e < 8; ++e) cntG[8 * g + e] = cnt[e]; }
            __syncthreads();
        }
    }
    SEAM(11);
    if (IN(12)) {
        LAS int* totL = (LAS int*)lds; LAS int* befL = totL + 8; LAS int* segL = totL + 16;
        for (int g = vcu; g < 256; g += G) {
            {   const int e = wave; int tot = 0, bef = 0;
#pragma unroll
                for (int i = 0; i < 4; ++i) { const int bb = lane + 64 * i; const int c = cntG[8 * bb + e]; tot += c; bef += (bb < g) ? c : 0; }
#pragma unroll
                for (int o = 1; o < 64; o <<= 1) { tot += __shfl_xor(tot, o); bef += __shfl_xor(bef, o); }
                if (lane == 0) { totL[e] = tot; befL[e] = bef; } }
            __syncthreads();
            if (tid == 0) { int acc = 0;
                for (int e = 0; e < 8; ++e) { segL[e] = acc * 256; acc += (totL[e] + 255) >> 8; }
                if (g == 0) { tab[0] = acc; int pm = 0; for (int e = 0; e < 8; ++e) { const int n = (totL[e] + 255) >> 8; for (int q = 0; q < n; ++q) tab[64 + pm++] = e; } } }
            __syncthreads();
            for (int i = 0; i < 4; ++i) { const int token = 32 * g + 4 * wave + i;
                const v4u* src = (const v4u*)((const unsigned char*)wA + (size_t)token * DM) + lane; v4u r4[2];
#pragma unroll
                for (int j = 0; j < 2; ++j) r4[j] = src[64 * j];
#pragma unroll
                for (int k = 0; k < 2; ++k) { const int e = tokE[2 * token + k], r = tokR[2 * token + k]; const int slot = segL[e] + befL[e] + r;
                    v4u* dst = (v4u*)(ws + WS_AS + (size_t)slot * DM) + lane;
#pragma unroll
                    for (int j = 0; j < 2; ++j) dst[64 * j] = r4[j];
                    if (lane == 0) tokS[2 * token + k] = slot; } }
            __syncthreads();
        }
    }
    SEAM(12);
    if (IN(13)) {
        if (cvb13) {
            for (int t = (bx - GW13) * NWAVES + wave; t < NTD; t += NCV13 * NWAVES) conv8_task(args.in[I_WDNX], FFX, DM, ws + WS_WDNX, nullptr, 0, SC_WDN, t, lane);
        } else {
        const int Gw = cvsplit ? GW13 : G;
        const int MT = __builtin_amdgcn_readfirstlane(tab[0]);
        pg8::Gemm g{(const bf16*)(ws + WS_AS), (const bf16*)(ws + WS_WGUX), DM / 2, 0, DM / 2}; pg8::MoeOrder8 S; S.init(MT < MAXTILES ? MT : MAXTILES, 2 * FFX / 256, Gw, bx, tab + 64, DM);
        pg8::EpiSwiGLU8 E{ws + WS_ACT2, FFX, 1.0f / SC_WGU, SC_ACT};
        pg8::gemm_phase_f8<pg8::EpiSwiGLU8, pg8::MoeOrder8>(lds + RING_OFF, g, S, E);
        }
    }
    SEAM(13);
    if (IN(14)) {
        const int MT0 = __builtin_amdgcn_readfirstlane(tab[0]); const int MT = MT0 < MAXTILES ? MT0 : MAXTILES; const int tail0 = (MT >> 5) << 5;
        {   pg8::Gemm g{(const bf16*)(ws + WS_ACT2), (const bf16*)(ws + WS_WDNX), FFX / 2, 0, FFX / 2}; pg8::MoeOrder8 S; S.init(tail0, DM / 256, G, bx, tab + 64, FFX);
            pg8::EpiBf16Split E{(bf16*)(ws + WS_Y), DM, 1 << 30, 0, 1.0f, -1, 1.0f / (SC_ACT * SC_WDN), nullptr, nullptr, nullptr};
            pg8::gemm_phase_f8<pg8::EpiBf16Split, pg8::MoeOrder8>(lds + RING_OFF, g, S, E); }
        if (MT > tail0) {
            pg8::Gemm g{(const bf16*)(ws + WS_ACT2), (const bf16*)(ws + WS_WDNX), FFX / 2, 0, 512}; pg8::MoeTailOrder8 S; S.init(tail0, MT - tail0, DM / 256, G, bx, tab + 64, FFX);
            pg8::EpiBf16Split E{(bf16*)(ws + WS_YP), DM, 1 << 30, 0, 1.0f, -1, 1.0f / (SC_ACT * SC_WDN), nullptr, nullptr, nullptr};
            pg8::gemm_phase_f8<pg8::EpiBf16Split, pg8::MoeTailOrder8>(lds + RING_OFF, g, S, E); }
    }
    SEAM(14);
    if (IN(15)) {
        const bf16* Y = (const bf16*)(ws + WS_Y); const float* nf = args.in[I_NFIN]; const int MT15 = __builtin_amdgcn_readfirstlane(tab[0]); const int tail0 = ((MT15 < MAXTILES ? MT15 : MAXTILES) >> 5) << 5;
        for (int m = gw; m < T; m += NGW) {
            const int s0 = tokS[2 * m], s1 = tokS[2 * m + 1]; const float g0 = tokG[2 * m], g1 = tokG[2 * m + 1];
            const v2u* xr = (const v2u*)(H3 + (size_t)m * DM) + lane;
            f32x4 v[8];
#pragma unroll
            for (int j = 0; j < 8; ++j) { const v2u w_ = xr[64 * j]; v[j] = BF4_TO_F4(w_); }
#pragma unroll 1
            for (int k = 0; k < 2; ++k) { const int sk = k ? s1 : s0; const float gk = k ? g1 : g0;
#define Y4(w_) ((f32x4){__uint_as_float((w_).x << 16), __uint_as_float((w_).x & 0xffff0000u), __uint_as_float((w_).y << 16), __uint_as_float((w_).y & 0xffff0000u)})
                if ((sk >> 8) < tail0) { const v2u* y = (const v2u*)(Y + (size_t)sk * DM) + lane;
#pragma unroll
                    for (int j = 0; j < 8; ++j) { const v2u w = y[64 * j]; v[j] += gk * Y4(w); } }
                else { const bf16* YP = (const bf16*)(ws + WS_YP);
#pragma unroll 1
                    for (int kq = 0; kq < 7; ++kq) { const v2u* y = (const v2u*)(YP + ((size_t)(kq * 8 + (sk >> 8) - tail0) * 256 + (sk & 255)) * DM) + lane;
#pragma unroll
                        for (int j = 0; j < 8; ++j) { const v2u w = y[64 * j]; v[j] += gk * Y4(w); } } } }
#undef Y4
            float s = 0.f;
#pragma unroll
            for (int j = 0; j < 8; ++j) s += (v[j].x * v[j].x + v[j].y * v[j].y) + (v[j].z * v[j].z + v[j].w * v[j].w);
            const float rstd = 1.0f / sqrtf(wave_sum(s) * (1.f / DM) + RMS_EPS);
            f32x4* orow = (f32x4*)(args.out + (size_t)m * DM) + lane; const f32x4* nfr = (const f32x4*)nf + lane;
#pragma unroll
            for (int j = 0; j < 8; ++j) orow[64 * j] = v[j] * rstd * nfr[64 * j];
        }
    }
#undef IN
#undef SEAM
}

extern "C" void kernel_launch(void* const* d_in, const int* in_sizes, int n_in, void* d_out, int out_size, void* d_ws, size_t ws_size, hipStream_t stream) {
    static int grid = 0;
    if (grid == 0) {
        if (n_in != 16 || out_size != T * DM || ws_size < WS_END) { fprintf(stderr, "kernel_launch: unexpected shapes (n_in %d out %d ws %zu)\n", n_in, out_size, ws_size); grid = -1; return; }
        int dev = 0, cus = 0, per_cu = 0;
        if (hipGetDevice(&dev) != hipSuccess || hipDeviceGetAttribute(&cus, hipDeviceAttributeMultiprocessorCount, dev) != hipSuccess) { grid = -1; return; }
        if (hipFuncSetAttribute((const void*)yoco_fwd, hipFuncAttributeMaxDynamicSharedMemorySize, LDS_BYTES) != hipSuccess) { fprintf(stderr, "kernel_launch: hipFuncSetAttribute failed\n"); grid = -1; return; }
        if (hipOccupancyMaxActiveBlocksPerMultiprocessor(&per_cu, (const void*)yoco_fwd, NTHR, LDS_BYTES) != hipSuccess || per_cu < 1) fprintf(stderr, "kernel_launch: occupancy query reports %d\n", per_cu);
        (void)hipGetLastError();
        grid = cus;
    }
    if (grid < 0) return;
    (void)hipMemsetAsync((char*)d_ws + WS_CTL, 0, CTL_ZERO_BYTES, stream);
    Args a{};
    for (int i = 0; i < 16; ++i) a.in[i] = (const float*)d_in[i];
    a.out = (float*)d_out; a.ws = (unsigned char*)d_ws;
    if (ONE_LAUNCH) { a.ph_lo = 0; a.ph_hi = NPHASES; hipLaunchKernelGGL(yoco_fwd, dim3(grid), dim3(NTHR), LDS_BYTES, stream, a); }
    else for (int p = 0; p < NPHASES; ++p) { a.ph_lo = p; a.ph_hi = p + 1; hipLaunchKernelGGL(yoco_fwd, dim3(grid), dim3(NTHR), LDS_BYTES, stream, a); }
}
```

```cpp
#include <hip/hip_runtime.h>
#include <cstdio>
#include <cstdint>
namespace pg8 {
#define PG8_LAS __attribute__((address_space(3)))
typedef unsigned short bf16_t;
typedef short bf16x8 __attribute__((ext_vector_type(8)));
typedef float f32x4 __attribute__((ext_vector_type(4)));
typedef float f32x2 __attribute__((ext_vector_type(2)));
typedef unsigned u32x4 __attribute__((ext_vector_type(4)));
typedef short s16x4 __attribute__((ext_vector_type(4)));
typedef unsigned u32x2 __attribute__((ext_vector_type(2)));
constexpr int BM = 256, BK = 64, HALF = 128, HTB = HALF * BK * 2  , STAGE_BYTES = 8 * HTB, NXCD = 8, WGM = 8;

__host__ __device__ __forceinline__ int lds_byte(int r, int c) { const int st = (r >> 4) * 2 + (c >> 5), rr = r & 15, cc = c & 31, ob = rr * 64 + cc * 2; return st * 1024 + (ob ^ (((ob >> 9) & 1) << 5)); }
__host__ __device__ __forceinline__ void stage_rc(int b, int& R, int& C) { const int st = b / 1024, sb = b % 1024, swz = sb ^ (((sb >> 9) & 1) << 5); R = (st >> 1) * 16 + swz / 64; C = (st & 1) * 32 + (swz % 64) / 2; }
__host__ __device__ __forceinline__ int perm32(int rho) { const int n = rho >> 4, i = rho & 15; return 8 * (i >> 2) + 4 * n + (i & 3); }

struct Unit { int pm, pn, crow; size_t bofs, aofs; };
struct Gemm { const bf16_t* A; const bf16_t* Bm; int K, Np, Kloop; };

struct StaticOrder {
    int nM, nN, nwg, G, c;
    __device__ void init(int M, int N, int G_, int c_) { nM = M / BM; nN = N / BM; nwg = nM * nN; G = G_; c = c_; }
    __device__ __forceinline__ bool next(int i, Unit& u) const {
        const long L = (long)i * G + c; if (L >= nwg) return false;
        int wgid = (int)L; { const int q = nwg / NXCD, r = nwg % NXCD, xcd = wgid % NXCD, off = wgid / NXCD; wgid = (xcd < r ? xcd * (q + 1) : r * (q + 1) + (xcd - r) * q) + off; }
        const int nig = WGM * nN, gid = wgid / nig, fm = gid * WGM, gsz = (nM - fm) < WGM ? (nM - fm) : WGM;
        u.pm = fm + ((wgid % nig) % gsz); u.pn = (wgid % nig) / gsz; u.bofs = (size_t)u.pn * 512; u.crow = u.pm; u.aofs = 0; return true;
    }
};
struct MoeOrder {
    int nM, nN, nwg, G, c; const int* tileExp; size_t estride;
    __device__ void init(int nM_, int nN_, int G_, int c_, const int* te, int K_) { nM = nM_; nN = nN_; nwg = nM * nN; G = G_; c = c_; tileExp = te; estride = (size_t)K_ * nN_ * 512; }
    __device__ __forceinline__ bool next(int i, Unit& u) const {
        const long L = (long)i * G + c; if (L >= nwg) return false;
        int wgid = (int)L; { const int q = nwg / NXCD, r = nwg % NXCD, xcd = wgid % NXCD, off = wgid / NXCD; wgid = (xcd < r ? xcd * (q + 1) : r * (q + 1) + (xcd - r) * q) + off; }
        const int nig = WGM * nN, gid = wgid / nig, fm = gid * WGM, gsz = (nM - fm) < WGM ? (nM - fm) : WGM;
        u.pm = fm + ((wgid % nig) % gsz); u.pn = (wgid % nig) / gsz;
        const int e = __builtin_amdgcn_readfirstlane(tileExp[u.pm]); u.bofs = (size_t)e * estride + (size_t)u.pn * 512; u.crow = u.pm; u.aofs = 0; return true;
    }
};

struct MoeTailOrder {
    int tail0, nN, nwg, G, c; const int* tileExp; size_t estride; int Np;
    __device__ void init(int tail0_, int ntail, int nN_, int G_, int c_, const int* te, int K_, int Np_) { tail0 = tail0_; nN = nN_; nwg = ntail * nN_ * 8; G = G_; c = c_; tileExp = te; estride = (size_t)K_ * nN_ * 512; Np = Np_; }
    __device__ __forceinline__ bool next(int i, Unit& u) const {
        const long L = (long)i * G + c; if (L >= nwg) return false;
        const int kq = (int)L & 7, r = (int)L >> 3, pn = r % nN, tl = r / nN;
        u.pm = tail0 + tl; u.pn = pn; u.crow = kq * 8 + tl; u.aofs = (size_t)kq * 896 * 2;
        const int e = __builtin_amdgcn_readfirstlane(tileExp[u.pm]); u.bofs = (size_t)e * estride + (size_t)pn * 512 + (size_t)kq * 896 * Np * 2; return true;
    }
};

__device__ __forceinline__ unsigned cvt_pk_bf16(float lo, float hi) { unsigned r; asm volatile("v_cvt_pk_bf16_f32 %0, %1, %2" : "=v"(r) : "v"(lo), "v"(hi)); return r; }

struct EpiBf16Split {
    static constexpr bool PERM = true, ROWSCALE = true;
    bf16_t* O; int ldc; int split_cols; size_t split_stride; float scale; int scale_t; float gscale;
    const float* ssq; const PG8_LAS float* tab; float* rstd_out;
    __device__ __forceinline__ void operator()(const f32x4 (&acc)[2][2][4][2], const Unit& u, int wr, int wc, int fr, int fq) const {
        const int row0 = u.crow * BM + wr * 64 + fr; int colt = u.pn * BM; bf16_t* base = O;
        float sc = gscale; { const int t = colt / split_cols; base += (size_t)t * split_stride; colt -= t * split_cols; if (t == scale_t) sc *= scale; }
        const int col0 = colt + wc * 32 + 8 * fq;
#pragma unroll
        for (int ai = 0; ai < 2; ++ai)
#pragma unroll
            for (int m = 0; m < 4; ++m) { bf16_t* rowp = base + (size_t)(row0 + ai * HALF + m * 16) * ldc + col0;
#pragma unroll
                for (int bj = 0; bj < 2; ++bj) { const float sr = ssq ? sc * tab[ai * HALF + wr * 64 + m * 16 + fr] : sc; f32x4 v0 = acc[ai][bj][m][0] * sr, v1 = acc[ai][bj][m][1] * sr;
                    u32x4 w; w.x = cvt_pk_bf16(v0[0], v0[1]); w.y = cvt_pk_bf16(v0[2], v0[3]); w.z = cvt_pk_bf16(v1[0], v1[1]); w.w = cvt_pk_bf16(v1[2], v1[3]);
                    *(u32x4*)(rowp + bj * HALF) = w; } }
    }
};
struct EpiResBf16 {
    static constexpr bool PERM = true, ROWSCALE = false;
    bf16_t* O; int ldc; const float* basef; const bf16_t* baseh; float* ssq;
    __device__ __forceinline__ void operator()(const f32x4 (&acc)[2][2][4][2], const Unit& u, int wr, int wc, int fr, int fq) const {
        const int row0 = u.crow * BM + wr * 64 + fr, col0 = u.pn * BM + wc * 32 + 8 * fq;
#pragma unroll
        for (int ai = 0; ai < 2; ++ai)
#pragma unroll
            for (int m = 0; m < 4; ++m) { const size_t off = (size_t)(row0 + ai * HALF + m * 16) * ldc + col0; float sq = 0.f;
#pragma unroll
                for (int bj = 0; bj < 2; ++bj) { f32x4 v0 = acc[ai][bj][m][0], v1 = acc[ai][bj][m][1];
                    if (basef) { v0 += *(const f32x4*)(basef + off + bj * HALF); v1 += *(const f32x4*)(basef + off + bj * HALF + 4); }
                    else { const u32x4 b = *(const u32x4*)(baseh + off + bj * HALF);
                        v0 += (f32x4){__uint_as_float(b.x << 16), __uint_as_float(b.x & 0xffff0000u), __uint_as_float(b.y << 16), __uint_as_float(b.y & 0xffff0000u)};
                        v1 += (f32x4){__uint_as_float(b.z << 16), __uint_as_float(b.z & 0xffff0000u), __uint_as_float(b.w << 16), __uint_as_float(b.w & 0xffff0000u)}; }
                    u32x4 w; w.x = cvt_pk_bf16(v0[0], v0[1]); w.y = cvt_pk_bf16(v0[2], v0[3]); w.z = cvt_pk_bf16(v1[0], v1[1]); w.w = cvt_pk_bf16(v1[2], v1[3]);
                    *(u32x4*)(O + off + bj * HALF) = w;
                    if (ssq) {
                        const f32x4 r0 = {__uint_as_float(w.x << 16), __uint_as_float(w.x & 0xffff0000u), __uint_as_float(w.y << 16), __uint_as_float(w.y & 0xffff0000u)};
                        const f32x4 r1 = {__uint_as_float(w.z << 16), __uint_as_float(w.z & 0xffff0000u), __uint_as_float(w.w << 16), __uint_as_float(w.w & 0xffff0000u)};
                        sq += ((r0[0] * r0[0] + r0[1] * r0[1]) + (r0[2] * r0[2] + r0[3] * r0[3])) + ((r1[0] * r1[0] + r1[1] * r1[1]) + (r1[2] * r1[2] + r1[3] * r1[3])); } }
                if (ssq) { sq += __shfl_xor(sq, 16); sq += __shfl_xor(sq, 32); if (fq == 0) ssq[(size_t)(row0 + ai * HALF + m * 16) * 32 + 4 * u.pn + wc] = sq; } }
    }
};
struct EpiF32 {
    static constexpr bool PERM = false, ROWSCALE = false;
    float* C; int ldc; const float* base;
    __device__ __forceinline__ void operator()(const f32x4 (&acc)[2][2][4][2], const Unit& u, int wr, int wc, int fr, int fq) const {
        const int row0 = u.crow * BM + wr * 64 + fr, col0 = u.pn * BM + wc * 32 + 4 * fq;
#pragma unroll
        for (int ai = 0; ai < 2; ++ai)
#pragma unroll
            for (int m = 0; m < 4; ++m) { const size_t off = (size_t)(row0 + ai * HALF + m * 16) * ldc + col0;
#pragma unroll
                for (int bj = 0; bj < 2; ++bj)
#pragma unroll
                    for (int n = 0; n < 2; ++n) { f32x4 v = acc[ai][bj][m][n]; if (base) v += *(const f32x4*)(base + off + bj * HALF + n * 16); *(f32x4*)(C + off + bj * HALF + n * 16) = v; } }
    }
};
struct EpiSwiGLU {
    static constexpr bool PERM = true, ROWSCALE = true;
    bf16_t* O; int ldc; const float* ssq; const PG8_LAS float* tab; float* rstd_out;
    __device__ __forceinline__ static float act(float g, float u) { return g * __builtin_amdgcn_rcpf(1.0f + __builtin_amdgcn_exp2f(g * -1.4426950408889634f)) * u; }
    __device__ __forceinline__ void operator()(const f32x4 (&acc)[2][2][4][2], const Unit& u, int wr, int wc, int fr, int fq) const {
        const int row0 = u.crow * BM + wr * 64 + fr, col0 = u.pn * HALF + wc * 32 + 8 * fq;
#pragma unroll
        for (int ai = 0; ai < 2; ++ai)
#pragma unroll
            for (int m = 0; m < 4; ++m) { bf16_t* rowp = O + (size_t)(row0 + ai * HALF + m * 16) * ldc + col0;
                const float sr = ssq ? tab[ai * HALF + wr * 64 + m * 16 + fr] : 1.0f;
                const f32x4 g0 = acc[ai][0][m][0] * sr, g1 = acc[ai][0][m][1] * sr, u0 = acc[ai][1][m][0] * sr, u1 = acc[ai][1][m][1] * sr;
                u32x4 w; w.x = cvt_pk_bf16(act(g0[0], u0[0]), act(g0[1], u0[1])); w.y = cvt_pk_bf16(act(g0[2], u0[2]), act(g0[3], u0[3]));
                w.z = cvt_pk_bf16(act(g1[0], u1[0]), act(g1[1], u1[1])); w.w = cvt_pk_bf16(act(g1[2], u1[2]), act(g1[3], u1[3]));
                *(u32x4*)rowp = w; }
    }
};
template <class Epi> __device__ __forceinline__ void rowscale_prepare(const Epi& E, const Unit& u, int tid) {
    if (E.ssq) { const int row = tid >> 1, half = tid & 1; const f32x4* p = (const f32x4*)(E.ssq + ((size_t)u.pm * BM + row) * 32 + 16 * half);
        const f32x4 a = p[0], b = p[1], c = p[2], d = p[3]; float s = ((a[0] + a[1]) + (a[2] + a[3])) + ((b[0] + b[1]) + (b[2] + b[3])) + ((c[0] + c[1]) + (c[2] + c[3])) + ((d[0] + d[1]) + (d[2] + d[3]));
        s += __shfl_xor(s, 1); const float r = 1.0f / sqrtf(s * (1.0f / 2048.0f) + 1e-6f);
        if (half == 0) { ((PG8_LAS float*)E.tab)[row] = r; if (E.rstd_out && u.pn == 0) E.rstd_out[(size_t)u.pm * BM + row] = r; } }
}

struct NoBg { static constexpr bool ON = false; };
template <class Epi, class Sched, class BG = NoBg, bool ALIGN_EPI = true>
__device__ __forceinline__ void gemm_phase(PG8_LAS unsigned char* lds, const Gemm g, const Sched& S, const Epi& E, BG& bg) {
    constexpr bool HB = BG::ON;
    const int tid = threadIdx.x, wid = __builtin_amdgcn_readfirstlane(tid >> 6), lane = tid & 63, wr = wid >> 2, wc = wid & 3, fr = lane & 15, fq = lane >> 4;
    const int K = g.K, nt = g.Kloop / BK;
    unsigned voffA[2], voffB[2];
#pragma unroll
    for (int i = 0; i < 2; ++i) { int R, C; stage_rc(tid * 16 + i * 8192, R, C); voffA[i] = (unsigned)(R * K + C) * 2u;
        const int kk = 4 * wid + 32 * i + (lane >> 4), ch = (lane & 15) ^ (((kk & 3) << 2) | ((kk >> 2) & 3)); voffB[i] = (unsigned)(kk * g.Np + 8 * ch) * 2u; }
    const size_t kstep = (size_t)(BK * 2);
    const size_t hstep = (size_t)HALF * K * 2;
    const size_t tstep = 2 * hstep;
    const size_t kstepB = (size_t)BK * g.Np * 2, hstepB = 256;
    const unsigned ldsw = (unsigned)wid * 1024u;
    const int aoff = lds_byte(wr * 64 + fr, fq * 8);
    int bo[2][2];
    { const int q = fr >> 2, p = fr & 3;
#pragma unroll
      for (int n = 0; n < 2; ++n)
#pragma unroll
        for (int t = 0; t < 2; ++t) bo[n][t] = (int)(unsigned)(size_t)lds + 4 * HTB + 256 * (8 * fq + 4 * t + q) + 16 * (((wc ^ q) << 2) | ((n ^ (fq & 1)) << 1) | ((p >> 1) ^ t)) + 8 * (p & 1); }
#define PG8_SA(b, h) (((b) * 2 + (h)) * HTB)
#define PG8_SB(b, h) ((4 + (b) * 2 + (h)) * HTB)
#define PG8_STAGE(bufoff, gbase, voff) do { _Pragma("unroll") for (int _i = 0; _i < 2; ++_i) \
        __builtin_amdgcn_global_load_lds((const unsigned*)((const char*)(gbase) + (voff)[_i]), (PG8_LAS unsigned*)(lds + (bufoff) + ldsw + _i * 8192), 16, 0, 0); } while (0)
#define PG8_LDA(dst, b, h) do { _Pragma("unroll") for (int m = 0; m < 4; ++m) _Pragma("unroll") for (int k = 0; k < 2; ++k) dst[m][k] = *(const PG8_LAS bf16x8*)(lds + PG8_SA(b, h) + aoff + m * 2048 + k * 1024); } while (0)
#define PG8_TR(dst, addr, off) asm volatile("ds_read_b64_tr_b16 %0, %1 offset:%2" : "=&v"(dst) : "v"(addr), "i"(off) : "memory")
#define PG8_LDB(dst, b, h) do { _Pragma("unroll") for (int n = 0; n < 2; ++n) _Pragma("unroll") for (int k = 0; k < 2; ++k) { s16x4 t0_, t1_; \
        PG8_TR(t0_, bo[n][0], ((b) * 2 + (h)) * HTB + k * 8192); PG8_TR(t1_, bo[n][1], ((b) * 2 + (h)) * HTB + k * 8192); \
        dst[n][k] = (bf16x8){t0_[0], t0_[1], t0_[2], t0_[3], t1_[0], t1_[1], t1_[2], t1_[3]}; } } while (0)
#define PG8_MMA(ai, bj, At, Bt) do { __builtin_amdgcn_s_setprio(1); _Pragma("unroll") for (int m = 0; m < 4; ++m) _Pragma("unroll") for (int n = 0; n < 2; ++n) _Pragma("unroll") for (int k = 0; k < 2; ++k) \
        acc[ai][bj][m][n] = __builtin_amdgcn_mfma_f32_16x16x32_bf16(Bt[n][k], At[m][k], acc[ai][bj][m][n], 0, 0, 0); __builtin_amdgcn_s_setprio(0); } while (0)
#define PG8_WAIT_V(n) asm volatile("s_waitcnt vmcnt(" #n ")" ::: "memory")
#define PG8_WAIT_L(n) asm volatile("s_waitcnt lgkmcnt(" #n ")" ::: "memory")
#define PG8_BAR __builtin_amdgcn_s_barrier()
#define PG8_SCHED __builtin_amdgcn_sched_barrier(0)
    Unit cur, nxt; int ui = 0;
    if (!S.next(0, cur)) return;
    f32x4 acc[2][2][4][2];
#pragma unroll
    for (int a = 0; a < 2; ++a)
#pragma unroll
        for (int b = 0; b < 2; ++b)
#pragma unroll
            for (int m = 0; m < 4; ++m)
#pragma unroll
                for (int n = 0; n < 2; ++n) acc[a][b][m][n] = (f32x4){0.f, 0.f, 0.f, 0.f};
    bf16x8 At[4][2], B0[2][2], B1[2][2];
    const char* cA = (const char*)g.A + (size_t)cur.pm * tstep + cur.aofs; const char* cB = (const char*)g.Bm + cur.bofs;
    PG8_STAGE(PG8_SB(0, 0), cB, voffB); PG8_STAGE(PG8_SB(0, 1), cB + hstepB, voffB); PG8_STAGE(PG8_SA(0, 0), cA, voffA); PG8_STAGE(PG8_SA(0, 1), cA + hstep, voffA);
    if (wr == 1) PG8_BAR;
    PG8_WAIT_V(2); PG8_BAR;
    PG8_STAGE(PG8_SB(1, 0), cB + kstepB, voffB); PG8_STAGE(PG8_SA(1, 0), cA + kstep, voffA); PG8_STAGE(PG8_SB(1, 1), cB + hstepB + kstepB, voffB);
    PG8_WAIT_V(6); PG8_BAR;
    asm volatile(".p2align 6" ::: "memory");
    for (;;) {
        const bool has_next = S.next(ui + 1, nxt);
        const char* nA = has_next ? (const char*)g.A + (size_t)nxt.pm * tstep + nxt.aofs : cA; const char* nB = has_next ? (const char*)g.Bm + nxt.bofs : cB;
        for (int t = 0; t < nt; t += 2) {
            const bool last = (t == nt - 2);
            const char* a1 = cA + (size_t)(t + 1) * kstep;
            const char* a2 = last ? nA : cA + (size_t)(t + 2) * kstep; const char* b2 = last ? nB : cB + (size_t)(t + 2) * kstepB;
            const char* a3 = a2 + kstep; const char* b3 = b2 + kstepB;
            PG8_LDB(B0, 0, 0); PG8_LDB(B1, 0, 1); PG8_SCHED; PG8_LDA(At, 0, 0); PG8_STAGE(PG8_SA(1, 1), a1 + hstep, voffA);
            PG8_WAIT_V(8); PG8_WAIT_L(0); PG8_BAR; PG8_MMA(0, 0, At, B0); PG8_MMA(0, 1, At, B1); PG8_BAR; PG8_SCHED;
            PG8_LDA(At, 0, 1); PG8_STAGE(PG8_SB(0, 0), b2, voffB); PG8_STAGE(PG8_SB(0, 1), b2 + hstepB, voffB); PG8_STAGE(PG8_SA(0, 0), a2, voffA);
            PG8_WAIT_V(8); PG8_WAIT_L(0); PG8_BAR; PG8_MMA(1, 0, At, B0); PG8_MMA(1, 1, At, B1); PG8_BAR; PG8_SCHED;
            PG8_LDB(B0, 1, 0); PG8_LDB(B1, 1, 1); PG8_SCHED; PG8_LDA(At, 1, 0); PG8_STAGE(PG8_SA(0, 1), a2 + hstep, voffA);
            PG8_WAIT_V(8); PG8_WAIT_L(0); PG8_BAR; PG8_MMA(0, 0, At, B0); PG8_MMA(0, 1, At, B1); PG8_BAR; PG8_SCHED;
            PG8_LDA(At, 1, 1); PG8_STAGE(PG8_SB(1, 0), b3, voffB); PG8_STAGE(PG8_SB(1, 1), b3 + hstepB, voffB); PG8_STAGE(PG8_SA(1, 0), a3, voffA);
            PG8_WAIT_V(8); PG8_WAIT_L(0); PG8_BAR; PG8_MMA(1, 0, At, B0); PG8_MMA(1, 1, At, B1); PG8_BAR; PG8_SCHED;
        }
        if constexpr (ALIGN_EPI) { if (wr == 0) PG8_BAR; }
        if constexpr (Epi::ROWSCALE) { rowscale_prepare(E, cur, tid); asm volatile("s_waitcnt lgkmcnt(0)" ::: "memory"); PG8_BAR; asm volatile("" ::: "memory"); }
        if constexpr (HB) {
            typename BG::Burst bb; f32x4 xb[16];
            (void)bg.burst_begin(bb);
#pragma unroll
            for (int i = 0; i < 16; ++i) xb[i] = bg.burst_load(bb, i);
            asm volatile("" ::: "memory");
            E(acc, cur, wr, wc, fr, fq);
            asm volatile("" ::: "memory");
            const typename BG::gain16 gg = bg.burst_gains(bb);
#pragma unroll
            for (int i = 0; i < 16; ++i) bg.burst_store(bb, i, xb[i], gg[i]);
        } else
        E(acc, cur, wr, wc, fr, fq);
        if (!has_next) break;
#pragma unroll
        for (int a = 0; a < 2; ++a)
#pragma unroll
            for (int b = 0; b < 2; ++b)
#pragma unroll
                for (int m = 0; m < 4; ++m)
#pragma unroll
                    for (int n = 0; n < 2; ++n) acc[a][b][m][n] = (f32x4){0.f, 0.f, 0.f, 0.f};
        cur = nxt; cA = nA; cB = nB; ++ui;
        if constexpr (ALIGN_EPI) { if (wr == 1) PG8_BAR; }
    }
    PG8_WAIT_V(0);
    if constexpr (!ALIGN_EPI) { if (wr == 0) PG8_BAR; }
    PG8_BAR;
#undef PG8_SA
#undef PG8_SB
#undef PG8_STAGE
#undef PG8_LDA
#undef PG8_LDB
#undef PG8_TR
#undef PG8_MMA
#undef PG8_WAIT_V
#undef PG8_WAIT_L
#undef PG8_BAR
#undef PG8_SCHED
}
typedef int i32x8 __attribute__((ext_vector_type(8)));
struct StaticOrder8 : StaticOrder {
    size_t tstride;
    __device__ void init8(int M, int N, int G_, int c_, int Kbytes) { init(M, N, G_, c_); tstride = (size_t)256 * Kbytes; }
    __device__ __forceinline__ bool next(int i, Unit& u) const { if (!StaticOrder::next(i, u)) return false; u.bofs = (size_t)u.pn * tstride; return true; }
};
struct MoeOrder8 {
    int nM, nN, nwg, G, c; const int* tileExp; size_t estride, tstride;
    __device__ void init(int nM_, int nN_, int G_, int c_, const int* te, int Kbytes) { nM = nM_; nN = nN_; nwg = nM * nN; G = G_; c = c_; tileExp = te; tstride = (size_t)256 * Kbytes; estride = (size_t)nN_ * tstride; }
    __device__ __forceinline__ bool next(int i, Unit& u) const {
        const long L = (long)i * G + c; if (L >= nwg) return false;
        int wgid = (int)L; { const int q = nwg / NXCD, r = nwg % NXCD, xcd = wgid % NXCD, off = wgid / NXCD; wgid = (xcd < r ? xcd * (q + 1) : r * (q + 1) + (xcd - r) * q) + off; }
        const int nig = WGM * nN, gid = wgid / nig, fm = gid * WGM, gsz = (nM - fm) < WGM ? (nM - fm) : WGM;
        u.pm = fm + ((wgid % nig) % gsz); u.pn = (wgid % nig) / gsz; u.crow = u.pm; u.aofs = 0;
        const int e = __builtin_amdgcn_readfirstlane(tileExp[u.pm]); u.bofs = (size_t)e * estride + (size_t)u.pn * tstride; return true;
    }
};
struct MoeTailOrder8 {
    int tail0, nN, nwg, G, c; const int* tileExp; size_t estride, tstride;
    __device__ void init(int tail0_, int ntail, int nN_, int G_, int c_, const int* te, int Kbytes) { tail0 = tail0_; nN = nN_; nwg = ntail * nN_ * 7; G = G_; c = c_; tileExp = te; tstride = (size_t)256 * Kbytes; estride = (size_t)nN_ * tstride; }
    __device__ __forceinline__ bool next(int i, Unit& u) const {
        const long L = (long)i * G + c; if (L >= nwg) return false;
        const int kq = (int)L % 7, r = (int)L / 7, pn = r % nN, tl = r / nN;
        u.pm = tail0 + tl; u.pn = pn; u.crow = kq * 8 + tl; u.aofs = (size_t)kq * 1024;
        const int e = __builtin_amdgcn_readfirstlane(tileExp[u.pm]); u.bofs = (size_t)e * estride + (size_t)pn * tstride + (size_t)kq * 1024; return true;
    }
};
__device__ __forceinline__ unsigned pk4_fp8(float a, float b, float c, float d) {
    a = __builtin_amdgcn_fmed3f(a, -448.f, 448.f); b = __builtin_amdgcn_fmed3f(b, -448.f, 448.f); c = __builtin_amdgcn_fmed3f(c, -448.f, 448.f); d = __builtin_amdgcn_fmed3f(d, -448.f, 448.f);
    int w = __builtin_amdgcn_cvt_pk_fp8_f32(a, b, 0, false); w = __builtin_amdgcn_cvt_pk_fp8_f32(c, d, w, true); return (unsigned)w; }
struct EpiSwiGLU8 {
    static constexpr bool PERM = true;
    unsigned char* O; int ldc; float sin, sout;
    __device__ __forceinline__ float act(float g, float u) const { g *= sin; return g * __builtin_amdgcn_rcpf(1.0f + __builtin_amdgcn_exp2f(g * -1.4426950408889634f)) * (u * (sin * sout)); }
    __device__ __forceinline__ void operator()(const f32x4 (&acc)[2][2][4][2], const Unit& u, int wr, int wc, int fr, int fq) const {
        const int row0 = u.crow * BM + wr * 64 + fr, col0 = u.pn * HALF + wc * 32 + 8 * fq;
#pragma unroll
        for (int ai = 0; ai < 2; ++ai)
#pragma unroll
            for (int m = 0; m < 4; ++m) { unsigned char* rowp = O + (size_t)(row0 + ai * HALF + m * 16) * ldc + col0;
                const f32x4 g0 = acc[ai][0][m][0], g1 = acc[ai][0][m][1], u0 = acc[ai][1][m][0], u1 = acc[ai][1][m][1];
                u32x2 w; w.x = pk4_fp8(act(g0[0], u0[0]), act(g0[1], u0[1]), act(g0[2], u0[2]), act(g0[3], u0[3])); w.y = pk4_fp8(act(g1[0], u1[0]), act(g1[1], u1[1]), act(g1[2], u1[2]), act(g1[3], u1[3]));
                *(u32x2*)rowp = w; }
    }
};
struct EpiF32s {
    static constexpr bool PERM = false;
    float* C; int ldc; float scale;
    __device__ __forceinline__ void operator()(const f32x4 (&acc)[2][2][4][2], const Unit& u, int wr, int wc, int fr, int fq) const {
        const int row0 = u.crow * BM + wr * 64 + fr, col0 = u.pn * BM + wc * 32 + 4 * fq;
#pragma unroll
        for (int ai = 0; ai < 2; ++ai)
#pragma unroll
            for (int m = 0; m < 4; ++m) { const size_t off = (size_t)(row0 + ai * HALF + m * 16) * ldc + col0;
#pragma unroll
                for (int bj = 0; bj < 2; ++bj)
#pragma unroll
                    for (int n = 0; n < 2; ++n) *(f32x4*)(C + off + bj * HALF + n * 16) = acc[ai][bj][m][n] * scale; }
    }
};
template <class Epi, class Sched, bool ALIGN_EPI = true>
__device__ __forceinline__ void gemm_phase_f8(PG8_LAS unsigned char* lds, const Gemm g, const Sched& S, const Epi& E) {
    int tid = threadIdx.x; asm volatile("" : "+v"(tid));
    const int wid = __builtin_amdgcn_readfirstlane(tid >> 6), lane = tid & 63, wr = wid >> 2, wc = wid & 3, fr = lane & 15, fq = lane >> 4;
    const int K = g.K; int nt = g.Kloop / BK; asm volatile("" : "+s"(nt));
    unsigned voffA[2], voffB[2];
#pragma unroll
    for (int i = 0; i < 2; ++i) { int R, C; stage_rc(tid * 16 + i * 8192, R, C); const int Rb = Epi::PERM ? ((R & ~31) + perm32(R & 31)) : R;
        voffA[i] = (unsigned)(R * K + C) * 2u; voffB[i] = (unsigned)(Rb * K + C) * 2u; }
    const size_t kstep = (size_t)(BK * 2);
    const size_t hstep = (size_t)HALF * K * 2;
    const size_t tstep = 2 * hstep;
    const unsigned ldsb = (unsigned)(size_t)lds + (unsigned)wid * 1024u;
    const int aoff = lds_byte(wr * 64 + fr, (fq >> 1) * 32 + (fq & 1) * 16), boff = lds_byte(wc * 32 + fr, (fq >> 1) * 32 + (fq & 1) * 16);
#define PG8_SA(b, h) (((b) * 2 + (h)) * HTB)
#define PG8_SB(b, h) ((4 + (b) * 2 + (h)) * HTB)
#define PG8_GLDS(off32, base64, ldsaddr) do { unsigned keep_; asm volatile("s_mov_b32 %0, m0\n\ts_mov_b32 m0, %3\n\ts_nop 1\n\tglobal_load_lds_dwordx4 %1, %2\n\ts_mov_b32 m0, %0" \
        : "=&s"(keep_) : "v"(off32), "s"(base64), "s"(ldsaddr) : "memory"); } while (0)
#define PG8_STAGE(bufoff, gbase, voff) do { _Pragma("unroll") for (int _i = 0; _i < 2; ++_i) PG8_GLDS((voff)[_i], (const char*)(gbase), ldsb + (unsigned)((bufoff) + _i * 8192)); } while (0)
#define PG8_LDA(dst, b, h) do { _Pragma("unroll") for (int m = 0; m < 4; ++m) { const u32x4 lo_ = *(const PG8_LAS u32x4*)(lds + PG8_SA(b, h) + aoff + m * 2048), hi_ = *(const PG8_LAS u32x4*)(lds + PG8_SA(b, h) + aoff + m * 2048 + 16); \
        dst[m] = (i32x8){(int)lo_[0], (int)lo_[1], (int)lo_[2], (int)lo_[3], (int)hi_[0], (int)hi_[1], (int)hi_[2], (int)hi_[3]}; } } while (0)
#define PG8_LDB(dst, b, h) do { _Pragma("unroll") for (int n = 0; n < 2; ++n) { const u32x4 lo_ = *(const PG8_LAS u32x4*)(lds + PG8_SB(b, h) + boff + n * 2048), hi_ = *(const PG8_LAS u32x4*)(lds + PG8_SB(b, h) + boff + n * 2048 + 16); \
        dst[n] = (i32x8){(int)lo_[0], (int)lo_[1], (int)lo_[2], (int)lo_[3], (int)hi_[0], (int)hi_[1], (int)hi_[2], (int)hi_[3]}; } } while (0)
#define PG8_MMA(ai, bj, At, Bt) do { __builtin_amdgcn_s_setprio(1); _Pragma("unroll") for (int m = 0; m < 4; ++m) _Pragma("unroll") for (int n = 0; n < 2; ++n) \
        asm volatile("v_mfma_f32_16x16x128_f8f6f4 %0, %1, %2, %0" : "+v"(acc[ai][bj][m][n]) : "v"(Bt[n]), "v"(At[m])); __builtin_amdgcn_s_setprio(0); } while (0)
#define PG8_WAIT_V(n) asm volatile("s_waitcnt vmcnt(" #n ")" ::: "memory")
#define PG8_WAIT_L(n) asm volatile("s_waitcnt lgkmcnt(" #n ")" ::: "memory")
#define PG8_BAR __builtin_amdgcn_s_barrier()
#define PG8_SCHED __builtin_amdgcn_sched_barrier(0)
    Unit cur, nxt; int ui = 0;
    if (!S.next(0, cur)) return;
    f32x4 acc[2][2][4][2];
#pragma unroll
    for (int a = 0; a < 2; ++a)
#pragma unroll
        for (int b = 0; b < 2; ++b)
#pragma unroll
            for (int m = 0; m < 4; ++m)
#pragma unroll
                for (int n = 0; n < 2; ++n) acc[a][b][m][n] = (f32x4){0.f, 0.f, 0.f, 0.f};
    i32x8 At[4], B0[2], B1[2];
    const char* cA = (const char*)g.A + (size_t)cur.pm * tstep + cur.aofs; const char* cB = (const char*)g.Bm + cur.bofs;
    PG8_STAGE(PG8_SB(0, 0), cB, voffB); PG8_STAGE(PG8_SB(0, 1), cB + hstep, voffB); PG8_STAGE(PG8_SA(0, 0), cA, voffA); PG8_STAGE(PG8_SA(0, 1), cA + hstep, voffA);
    if (wr == 1) PG8_BAR;
    PG8_WAIT_V(2); PG8_BAR;
    PG8_STAGE(PG8_SB(1, 0), cB + kstep, voffB); PG8_STAGE(PG8_SA(1, 0), cA + kstep, voffA); PG8_STAGE(PG8_SB(1, 1), cB + hstep + kstep, voffB);
    PG8_WAIT_V(6); PG8_BAR;
    asm volatile(".p2align 6" ::: "memory");
    for (;;) {
        const bool has_next = S.next(ui + 1, nxt);
        const char* nA = has_next ? (const char*)g.A + (size_t)nxt.pm * tstep + nxt.aofs : cA; const char* nB = has_next ? (const char*)g.Bm + nxt.bofs : cB;
        for (int t = 0; t < nt; t += 2) {
            const bool last = (t == nt - 2);
            const char* a1 = cA + (size_t)(t + 1) * kstep;
            const char* a2 = last ? nA : cA + (size_t)(t + 2) * kstep; const char* b2 = last ? nB : cB + (size_t)(t + 2) * kstep;
            const char* a3 = a2 + kstep; const char* b3 = b2 + kstep;
            PG8_LDB(B0, 0, 0); PG8_LDB(B1, 0, 1); PG8_SCHED; PG8_LDA(At, 0, 0); PG8_STAGE(PG8_SA(1, 1), a1 + hstep, voffA);
            PG8_WAIT_V(8); PG8_WAIT_L(0); PG8_BAR; PG8_MMA(0, 0, At, B0); PG8_MMA(0, 1, At, B1); PG8_BAR; PG8_SCHED;
            PG8_LDA(At, 0, 1); PG8_STAGE(PG8_SB(0, 0), b2, voffB); PG8_STAGE(PG8_SB(0, 1), b2 + hstep, voffB); PG8_STAGE(PG8_SA(0, 0), a2, voffA);
            PG8_WAIT_V(8); PG8_WAIT_L(0); PG8_BAR; PG8_MMA(1, 0, At, B0); PG8_MMA(1, 1, At, B1); PG8_BAR; PG8_SCHED;
            PG8_LDB(B0, 1, 0); PG8_LDB(B1, 1, 1); PG8_SCHED; PG8_LDA(At, 1, 0); PG8_STAGE(PG8_SA(0, 1), a2 + hstep, voffA);
            PG8_WAIT_V(8); PG8_WAIT_L(0); PG8_BAR; PG8_MMA(0, 0, At, B0); PG8_MMA(0, 1, At, B1); PG8_BAR; PG8_SCHED;
            PG8_LDA(At, 1, 1); PG8_STAGE(PG8_SB(1, 0), b3, voffB); PG8_STAGE(PG8_SB(1, 1), b3 + hstep, voffB); PG8_STAGE(PG8_SA(1, 0), a3, voffA);
            PG8_WAIT_V(8); PG8_WAIT_L(0); PG8_BAR; PG8_MMA(1, 0, At, B0); PG8_MMA(1, 1, At, B1); PG8_BAR; PG8_SCHED;
        }
        asm volatile("s_nop 15\n\ts_nop 15" ::: "memory");
        if constexpr (ALIGN_EPI) { if (wr == 0) PG8_BAR; }
        E(acc, cur, wr, wc, fr, fq);
        if (!has_next) break;
#pragma unroll
        for (int a = 0; a < 2; ++a)
#pragma unroll
            for (int b = 0; b < 2; ++b)
#pragma unroll
                for (int m = 0; m < 4; ++m)
#pragma unroll
                    for (int n = 0; n < 2; ++n) acc[a][b][m][n] = (f32x4){0.f, 0.f, 0.f, 0.f};
        cur = nxt; cA = nA; cB = nB; ++ui;
        if constexpr (ALIGN_EPI) { if (wr == 1) PG8_BAR; }
    }
    PG8_WAIT_V(0);
    if constexpr (!ALIGN_EPI) { if (wr == 0) PG8_BAR; }
    PG8_BAR;
#undef PG8_SA
#undef PG8_SB
#undef PG8_STAGE
#undef PG8_GLDS
#undef PG8_LDA
#undef PG8_LDB
#undef PG8_MMA
#undef PG8_WAIT_V
#undef PG8_WAIT_L
#undef PG8_BAR
#undef PG8_SCHED
}
}
namespace att {
#define ATT_LAS __attribute__((address_space(3)))
typedef unsigned short bf16_t;
typedef short bf16x8 __attribute__((ext_vector_type(8)));
typedef short s16x4 __attribute__((ext_vector_type(4)));
typedef float f32x16 __attribute__((ext_vector_type(16)));
typedef float f32x4 __attribute__((ext_vector_type(4)));
typedef unsigned u32x4 __attribute__((ext_vector_type(4)));
constexpr int S = 2048, PITCH = 2048, D = 128, NW = 8, QBLK = 32, KVBLK = 64, QB = NW * QBLK;
constexpr int SHM_V = KVBLK * D * 2, SHM_K = KVBLK * D * 2;
constexpr int NKB = 4;
constexpr int OFF_V = 0, OFF_K = NKB * SHM_V, OFF_WS = NKB * SHM_V + NKB * SHM_K, OFF_BIAS = OFF_WS + NW * 64 * 4, OFF_SCAN = OFF_BIAS + S * 4, LDS_BYTES = OFF_SCAN + 64;
#define KSWZ(row, colB) ((row) * 256 + ((colB) ^ (((row) & 7) << 4)))
#define SBAR() __builtin_amdgcn_sched_barrier(0)
__device__ __forceinline__ int v_st(int k, int c) { const int kk = (k & ~0xC) | ((k & 4) << 1) | ((k & 8) >> 1); return ((kk >> 3) * 4 + (c >> 5)) * 512 + ((kk & 7) * 32 + (c & 31)) * 2; }
__device__ __forceinline__ int v_rd_base(int lane) { return ((lane & 3) << 3) | (((lane >> 2) & 3) << 6) | (((lane >> 4) & 1) << 5) | (((lane >> 5) & 1) << 8); }
constexpr int v_rd_off(int d0, int ks, int half) { return d0 * 512 + ks * 4096 + half * 2048; }
__device__ __forceinline__ int crow(int r, int hi) { return (r & 3) + 8 * (r >> 2) + 4 * hi; }
__device__ __forceinline__ unsigned cvtpk(float lo, float hi) { unsigned r; asm volatile("v_cvt_pk_bf16_f32 %0, %1, %2" : "=v"(r) : "v"(lo), "v"(hi)); return r; }

__device__ __forceinline__ void qkt(f32x16& p0, f32x16& p1, const ATT_LAS char* Kt, int r32, int hi, const bf16x8* qr) {
    p0 = f32x16{}; p1 = f32x16{};
    const ATT_LAS char* kb[4];
#pragma unroll
    for (int dd = 0; dd < 4; ++dd) kb[dd] = Kt + KSWZ(r32, (dd * 16 + hi * 8) * 2);
#pragma unroll
    for (int d0 = 0; d0 < 8; ++d0) { const ATT_LAS char* a = kb[d0 & 3] + (d0 >> 2) * 128;
        bf16x8 b0 = *reinterpret_cast<const ATT_LAS bf16x8*>(a);
        bf16x8 b1 = *reinterpret_cast<const ATT_LAS bf16x8*>(a + 32 * 256);
        p0 = __builtin_amdgcn_mfma_f32_32x32x16_bf16(b0, qr[d0], p0, 0, 0, 0);
        p1 = __builtin_amdgcn_mfma_f32_32x32x16_bf16(b1, qr[d0], p1, 0, 0, 0); }
}
__device__ __forceinline__ void pv_tile(f32x16* o, int vb0, bf16x8 pa0, bf16x8 pa1, bf16x8 pa2, bf16x8 pa3) {
#define TRRD(dst, off) asm volatile("ds_read_b64_tr_b16 %0, %1 offset:%2" : "=&v"(dst) : "v"(vb0), "i"(off) : "memory")
#define PV_D0(d0) do { s16x4 l0, l1, l2, l3, h0, h1, h2, h3; constexpr int b_ = v_rd_off(d0, 0, 0); \
        TRRD(l0, b_); TRRD(h0, b_ + 2048); TRRD(l1, b_ + 4096); TRRD(h1, b_ + 6144); TRRD(l2, b_ + 8192); TRRD(h2, b_ + 10240); TRRD(l3, b_ + 12288); TRRD(h3, b_ + 14336); \
        asm volatile("s_waitcnt lgkmcnt(0)" ::: "memory"); SBAR(); \
        o[d0] = __builtin_amdgcn_mfma_f32_32x32x16_bf16(pa0, (bf16x8){l0[0], l0[1], l0[2], l0[3], h0[0], h0[1], h0[2], h0[3]}, o[d0], 0, 0, 0);   \
        o[d0] = __builtin_amdgcn_mfma_f32_32x32x16_bf16(pa1, (bf16x8){l1[0], l1[1], l1[2], l1[3], h1[0], h1[1], h1[2], h1[3]}, o[d0], 0, 0, 0);   \
        o[d0] = __builtin_amdgcn_mfma_f32_32x32x16_bf16(pa2, (bf16x8){l2[0], l2[1], l2[2], l2[3], h2[0], h2[1], h2[2], h2[3]}, o[d0], 0, 0, 0);   \
        o[d0] = __builtin_amdgcn_mfma_f32_32x32x16_bf16(pa3, (bf16x8){l3[0], l3[1], l3[2], l3[3], h3[0], h3[1], h3[2], h3[3]}, o[d0], 0, 0, 0); } while (0)
    PV_D0(0); PV_D0(1); PV_D0(2); PV_D0(3);
#undef PV_D0
#undef TRRD
}
#define ATT_PK4(P, B_, OUT) do { unsigned a0 = cvtpk(P[B_+0], P[B_+1]), a1 = cvtpk(P[B_+2], P[B_+3]);                          \
        unsigned b0 = cvtpk(P[B_+4], P[B_+5]), b1 = cvtpk(P[B_+6], P[B_+7]);                                             \
        auto r0 = __builtin_amdgcn_permlane32_swap(a0, b0, false, false); auto r1 = __builtin_amdgcn_permlane32_swap(a1, b1, false, false); \
        u32x4 w = {r0[0], r1[0], r0[1], r1[1]}; OUT = *reinterpret_cast<bf16x8*>(&w); } while (0)

constexpr int OFF_STAGE = OFF_SCAN + 64, STAGE_PER_WAVE = 0;
template <bool FOX, class BG, int NH = 1>
__device__ __forceinline__ void attn_block(ATT_LAS char* lds, const bf16_t* Qg, const bf16_t* Kg, const bf16_t* Vg, bf16_t* Og, int b, int h, int qb, BG& bg) {
    int tid = threadIdx.x; asm volatile("" : "+v"(tid));
    const int wid = __builtin_amdgcn_readfirstlane(tid >> 6), lane = tid & 63, r32 = lane & 31, hi = lane >> 5;
    const size_t hb = (size_t)b * S * PITCH + (size_t)h * D;
    const bf16_t* Qp = Qg + hb; const bf16_t* Kp = Kg + hb; const bf16_t* Vp = Vg + hb; bf16_t* Op = Og + hb;
    const int P0 = qb * QB, qlo = P0 + wid * QBLK, NT = 4 * (qb + 1);
    bf16x8 qr[8];
#pragma unroll
    for (int d0 = 0; d0 < 8; ++d0) qr[d0] = *(const bf16x8*)(Qp + (size_t)(qlo + r32) * PITCH + d0 * 16 + hi * 8);
    unsigned koff[2], voff[2];
#pragma unroll
    for (int i = 0; i < 2; ++i) { const int j = 2 * wid + i;
        { const int row = 4 * j + (lane >> 4), c = (lane & 15) ^ (row & 7); koff[i] = (unsigned)(row * PITCH + 8 * c) * 2u; }
        { const int sub = 2 * j + (lane >> 5), kk = 8 * (sub >> 2) + ((lane & 31) >> 2), c = 32 * (sub & 3) + 8 * (lane & 3), k = (kk & ~0xC) | ((kk & 4) << 1) | ((kk & 8) >> 1); voff[i] = (unsigned)(k * PITCH + c) * 2u; } }
    ATT_LAS char* V_lds = lds + OFF_V; ATT_LAS char* K_lds = lds + OFF_K;
    ATT_LAS float* wsf = (ATT_LAS float*)(lds + OFF_WS) + wid * 64; ATT_LAS float* li_l = wsf; ATT_LAS float* al_l = wsf + 32;
    const ATT_LAS float* biasL = (const ATT_LAS float*)(lds + OFF_BIAS);
    const int vbase = (int)(unsigned)(size_t)V_lds + v_rd_base(lane);
    float m_reg = -1e30f, l_reg = 0.f, R2 = 0.f; f32x16 o[4] = {};
    typename BG::Burst bbC, bbP; bg.burst_begin_n(bbC, 0); bbP = bbC; bool isC = false, isP = false; f32x4 hv[4] = {};
    typename BG::Burst bbD; bg.burst_begin_n(bbD, 0); bool isD = false; f32x4 hw[4] = {};
#define TILEJ(t) (FOX ? (t) : (NT - 1 - (t)))
#define LOADT(j, bf) do { const char* kt_ = (const char*)(Kp + (size_t)(j) * KVBLK * PITCH); const char* vt_ = (const char*)(Vp + (size_t)(j) * KVBLK * PITCH); \
        _Pragma("unroll") for (int i_ = 0; i_ < 2; ++i_) { \
            __builtin_amdgcn_global_load_lds((const unsigned*)(kt_ + koff[i_]), (ATT_LAS unsigned*)(K_lds + (bf) * SHM_K + (2 * wid + i_) * 1024), 16, 0, 0); \
            __builtin_amdgcn_global_load_lds((const unsigned*)(vt_ + voff[i_]), (ATT_LAS unsigned*)(V_lds + (bf) * SHM_V + (2 * wid + i_) * 1024), 16, 0, 0); } } while (0)
    static_assert(!BG::ON || BG::REG, "register-staged hosting only");
    LOADT(TILEJ(0), 0); LOADT(TILEJ(1), 1); asm volatile("s_waitcnt vmcnt(0)" ::: "memory"); __syncthreads();
    asm volatile(".p2align 6" ::: "memory");
    for (int t = 0; t < NT; ++t) {
        if ((t & 1) == 0 && t + 2 < NT) { LOADT(TILEJ(t + 2), (t + 2) & 3); LOADT(TILEJ(t + 3), (t + 3) & 3); }
        bbP = bbC; isP = isC; isC = bg.live;
        if (isC) { bg.burst_begin_n(bbC, 4);
            if constexpr (BG::REG) {
#pragma unroll
                for (int i = 0; i < 4; ++i) hv[i] = bg.burst_ld(bbC, i);
                if constexpr (NH == 2) { isD = bg.live; if (isD) { bg.burst_begin_n(bbD, 4);
#pragma unroll
                    for (int i = 0; i < 4; ++i) hw[i] = bg.burst_ld(bbD, i); } }
            } else {
#pragma unroll
            for (int i = 0; i < 4; ++i) bg.burst_dma(bbC, i, (ATT_LAS unsigned char*)(lds + OFF_STAGE + wid * STAGE_PER_WAVE + (t & 1) * 4096 + i * 1024)); } }
        const int bufi = t & 3, kb = TILEJ(t) * KVBLK;
        if (kb <= qlo + QBLK - 1) {
            f32x16 p0, p1; bf16x8 pa0, pa1, pa2, pa3;
            qkt(p0, p1, K_lds + bufi * SHM_K, r32, hi, qr);
            const int dq = qlo + r32 - kb - 4 * hi;
            if constexpr (FOX) {
                const ATT_LAS float* bp = biasL + kb + 4 * hi;
#pragma unroll
                for (int i = 0; i < 4; ++i) { const f32x4 b0 = *(const ATT_LAS f32x4*)(bp + 8 * i), b1 = *(const ATT_LAS f32x4*)(bp + 32 + 8 * i);
#pragma unroll
                    for (int j = 0; j < 4; ++j) { p0[4 * i + j] += b0[j]; p1[4 * i + j] += b1[j]; } }
                if (kb + KVBLK - 1 > qlo) {
                    const float NEG = -__builtin_inff();
#pragma unroll
                    for (int r = 0; r < 16; ++r) { const int c = (r & 3) + 8 * (r >> 2); if (c > dq) p0[r] = NEG; if (c + 32 > dq) p1[r] = NEG; }
                }
                float pmax = p0[0];
#pragma unroll
                for (int r = 1; r < 16; ++r) pmax = fmaxf(pmax, p0[r]);
#pragma unroll
                for (int r = 0; r < 16; ++r) pmax = fmaxf(pmax, p1[r]);
                { auto rr = __builtin_amdgcn_permlane32_swap(__float_as_uint(pmax), __float_as_uint(pmax), false, false); pmax = fmaxf(__uint_as_float(rr[0]), __uint_as_float(rr[1])); }
                const float mn = fmaxf(m_reg, pmax), alpha = __builtin_amdgcn_exp2f(m_reg - mn); m_reg = mn;
                float ps = 0.f;
#pragma unroll
                for (int r = 0; r < 16; ++r) { p0[r] = __builtin_amdgcn_exp2f(p0[r] - mn); p1[r] = __builtin_amdgcn_exp2f(p1[r] - mn); ps += p0[r] + p1[r]; }
                { auto rr = __builtin_amdgcn_permlane32_swap(__float_as_uint(ps), __float_as_uint(ps), false, false); ps = __uint_as_float(rr[0]) + __uint_as_float(rr[1]); }
                l_reg = l_reg * alpha + ps;
                if (__any(alpha < 1.f)) { if (hi == 0) al_l[r32] = alpha; asm volatile("s_waitcnt lgkmcnt(0)" ::: "memory");
#pragma unroll
                    for (int r = 0; r < 16; ++r) { const float a = al_l[crow(r, hi)];
#pragma unroll
                        for (int d_ = 0; d_ < 4; ++d_) o[d_][r] *= a; }
                    asm volatile("s_waitcnt lgkmcnt(0)" ::: "memory"); }
            } else {
                const bool MSK = (kb + KVBLK - 1 >= qlo);
                f32x16 l0, l1;
#pragma unroll
                for (int r = 0; r < 16; ++r) {
                    const float y0 = p0[r], y1 = p1[r];
                    float L0 = -(fmaxf(y0, 0.f) + __builtin_amdgcn_logf(1.0f + __builtin_amdgcn_exp2f(-__builtin_fabsf(y0))));
                    float L1 = -(fmaxf(y1, 0.f) + __builtin_amdgcn_logf(1.0f + __builtin_amdgcn_exp2f(-__builtin_fabsf(y1))));
                    if (MSK) { const int c = (r & 3) + 8 * (r >> 2); if (!(c < dq)) L0 = 0.f; if (!(c + 32 < dq)) L1 = 0.f; }
                    l0[r] = L0; l1[r] = L1;
                }
                float T[8], HO[8];
#pragma unroll
                for (int i = 0; i < 8; ++i) { const float g = (i < 4) ? ((l0[4 * i] + l0[4 * i + 1]) + (l0[4 * i + 2] + l0[4 * i + 3])) : ((l1[4 * i - 16] + l1[4 * i - 15]) + (l1[4 * i - 14] + l1[4 * i - 13]));
                    auto rr = __builtin_amdgcn_permlane32_swap(__float_as_uint(g), __float_as_uint(g), false, false);
                    const float glo = __uint_as_float(rr[0]), ghi = __uint_as_float(rr[1]); T[i] = glo + ghi; HO[i] = hi ? 0.f : ghi; }
                float run = R2;
#pragma unroll
                for (int i = 7; i >= 0; --i) {
                    const float off = run + HO[i];
                    if (i < 4) { float s3 = l0[4 * i + 3] + off, s2 = l0[4 * i + 2] + s3, s1 = l0[4 * i + 1] + s2, s0 = l0[4 * i] + s1;
                        p0[4 * i + 3] = __builtin_amdgcn_exp2f(p0[4 * i + 3] + s3); p0[4 * i + 2] = __builtin_amdgcn_exp2f(p0[4 * i + 2] + s2);
                        p0[4 * i + 1] = __builtin_amdgcn_exp2f(p0[4 * i + 1] + s1); p0[4 * i] = __builtin_amdgcn_exp2f(p0[4 * i] + s0); }
                    else { const int q = 4 * i - 16; float s3 = l1[q + 3] + off, s2 = l1[q + 2] + s3, s1 = l1[q + 1] + s2, s0 = l1[q] + s1;
                        p1[q + 3] = __builtin_amdgcn_exp2f(p1[q + 3] + s3); p1[q + 2] = __builtin_amdgcn_exp2f(p1[q + 2] + s2);
                        p1[q + 1] = __builtin_amdgcn_exp2f(p1[q + 1] + s1); p1[q] = __builtin_amdgcn_exp2f(p1[q] + s0); }
                    run += T[i];
                }
                R2 = run;
                if (MSK) {
#pragma unroll
                    for (int r = 0; r < 16; ++r) { const int c = (r & 3) + 8 * (r >> 2); if (!(c < dq)) p0[r] = 0.f; if (!(c + 32 < dq)) p1[r] = 0.f; }
                }
            }
            ATT_PK4(p0, 0, pa0); ATT_PK4(p0, 8, pa1); ATT_PK4(p1, 0, pa2); ATT_PK4(p1, 8, pa3);
            pv_tile(o, vbase + bufi * SHM_V, pa0, pa1, pa2, pa3);
        }
        asm volatile("s_waitcnt vmcnt(0)" ::: "memory");
        if constexpr (BG::REG) { if (isC) { bg.burst_finish_regs(bbC, hv, (ATT_LAS unsigned char*)(lds + OFF_STAGE + wid * STAGE_PER_WAVE)); if constexpr (NH == 2) { if (isD) bg.burst_finish_regs(bbD, hw, (ATT_LAS unsigned char*)(lds + OFF_STAGE + wid * STAGE_PER_WAVE + 4096)); isD = false; } } }
        else
        if (t > 0 && isP) { if (isC) asm volatile("s_waitcnt vmcnt(%0)" :: "n"(BG::HOST_VMCNT) : "memory"); else asm volatile("s_waitcnt vmcnt(0)" ::: "memory");
            bg.burst_finish4(bbP, (ATT_LAS unsigned char*)(lds + OFF_STAGE + wid * STAGE_PER_WAVE + ((t - 1) & 1) * 4096)); }
        if (t & 1) { asm volatile("s_waitcnt lgkmcnt(0)" ::: "memory"); __builtin_amdgcn_s_barrier(); asm volatile("" ::: "memory"); }
    }
    if constexpr (!BG::REG) if (isC) { asm volatile("s_waitcnt vmcnt(0)" ::: "memory"); bg.burst_finish4(bbC, (ATT_LAS unsigned char*)(lds + OFF_STAGE + wid * STAGE_PER_WAVE + ((NT - 1) & 1) * 4096)); }
    if (0) {
    }
    float rli[16];
    if constexpr (FOX) {
        if (hi == 0) li_l[r32] = l_reg; asm volatile("s_waitcnt lgkmcnt(0)" ::: "memory");
#pragma unroll
        for (int r = 0; r < 16; ++r) rli[r] = __builtin_amdgcn_rcpf(li_l[crow(r, hi)]);
        asm volatile("s_waitcnt lgkmcnt(0)" ::: "memory");
    } else {
#pragma unroll
        for (int r = 0; r < 16; ++r) rli[r] = 1.f;
    }
    bf16_t* Ow = Op + (size_t)qlo * PITCH;
#pragma unroll
    for (int r = 0; r < 16; ++r) { const int orow = crow(r, hi);
#pragma unroll
        for (int d0 = 0; d0 < 4; ++d0) { const float v = o[d0][r] * rli[r]; const float vn = __shfl_xor(v, 1);
            if ((r32 & 1) == 0) *(unsigned*)(Ow + (size_t)orow * PITCH + d0 * 32 + r32) = cvtpk(v, vn); } }
#undef TILEJ
#undef LOADT
#undef WRITET
}
}
#ifndef MK_ONE_LAUNCH
#define MK_ONE_LAUNCH 1
#endif
constexpr bool ONE_LAUNCH = (MK_ONE_LAUNCH != 0);
constexpr int NWAVES = 8, NTHR = NWAVES * 64;
constexpr int BATCH = 4, SEQ = 2048, DM = 2048, NH = 16, HD = 128, T = BATCH * SEQ;
constexpr int FF = 5632, NE = 8, FFX = 7168;
constexpr float RMS_EPS = 1e-6f;
constexpr float QSCALE = 0.08838834764831845f * 1.4426950408889634f;
constexpr int MAXTILES = 72;
constexpr int NPHASES = 16;
constexpr size_t MiB = 1u << 20;
constexpr size_t WS_CTL = 0, CTL_ZERO_BYTES = 1 * MiB;
constexpr size_t WS_WQKV = 2 * MiB;
constexpr size_t WS_WOA  = 26 * MiB;
constexpr size_t WS_WGU  = 34 * MiB;
constexpr size_t WS_WDN  = 78 * MiB;
constexpr size_t WS_WKVQ = 100 * MiB;
constexpr size_t WS_WF   = 124 * MiB;
constexpr size_t WS_WOB  = 125 * MiB;
constexpr size_t WS_WGUX = 134 * MiB;
constexpr size_t WS_WDNX = 582 * MiB;
constexpr size_t WS_A    = 806 * MiB;
constexpr size_t WS_Q    = 838 * MiB, WS_K = 870 * MiB, WS_V = 902 * MiB;
constexpr size_t WS_O    = 934 * MiB;
constexpr size_t WS_H1   = 966 * MiB;
constexpr size_t WS_ACT  = 1030 * MiB;
constexpr size_t WS_H2   = 1118 * MiB;
constexpr size_t WS_H3   = 1182 * MiB;
constexpr size_t WS_AS   = 1246 * MiB;
constexpr size_t WS_ACT2 = 1318 * MiB;
constexpr size_t WS_Y    = 1570 * MiB;
constexpr size_t WS_FP   = 1714 * MiB;
constexpr size_t WS_TOK  = 1716 * MiB;
constexpr size_t WS_CNT  = 1717 * MiB;
constexpr size_t WS_TAB  = 1718 * MiB;
constexpr size_t WS_YP   = 1720 * MiB;
constexpr size_t WS_SSQ1 = 1848 * MiB, WS_SSQ2 = 1850 * MiB, WS_RSTD = 1852 * MiB;
constexpr size_t WS_END  = 1854 * MiB;
constexpr int CW_BAR = 4096;
constexpr int RING_OFF = 0, RING_BYTES = 131072;
constexpr int LDS_BYTES = 163840;
constexpr int LDSCTL_OFF = LDS_BYTES - 2048, MISC_OFF = LDSCTL_OFF + 320;

#define GAS __attribute__((address_space(1)))
#define LAS __attribute__((address_space(3)))
typedef unsigned short bf16;
typedef unsigned v4u __attribute__((ext_vector_type(4)));
typedef unsigned v2u __attribute__((ext_vector_type(2)));
typedef float f32x4 __attribute__((ext_vector_type(4)));
typedef short bf16x8 __attribute__((ext_vector_type(8)));
typedef GAS unsigned gu32;
#define RLX_AGENT __ATOMIC_RELAXED, __HIP_MEMORY_SCOPE_AGENT
#define LDS_WAIT() asm volatile("s_waitcnt lgkmcnt(0)" ::: "memory")
#define VM_WAIT() asm volatile("s_waitcnt vmcnt(0)" ::: "memory")
__device__ __forceinline__ unsigned cvtpk2(float lo, float hi) { unsigned r; asm volatile("v_cvt_pk_bf16_f32 %0, %1, %2" : "=v"(r) : "v"(lo), "v"(hi)); return r; }

#define XB_TMO      128
#define XB_XCNT(j)  (256  + 64 * (j))
#define XB_XSUB(j)  (1280 + 64 * (j))
#define XB_XGEN(j)  (2304 + 64 * (j))
#define XB_TOP      3328
#define XB_TOPGEN   3392
#define XCD_BAR_WORDS 3456
#define XB_SPIN_CAP (1u << 18)
__device__ __forceinline__ unsigned xb_ld(unsigned* p)              { return __hip_atomic_load(p, __ATOMIC_RELAXED, __HIP_MEMORY_SCOPE_AGENT); }
__device__ __forceinline__ unsigned xb_add(unsigned* p, unsigned v) { return __hip_atomic_fetch_add(p, v, __ATOMIC_RELAXED, __HIP_MEMORY_SCOPE_AGENT); }
__device__ __forceinline__ unsigned xb_xcc_id() { return (unsigned)__builtin_amdgcn_s_getreg((3 << 11) | 20) & 0xFu; }
#define XB_SPIN(cond, bar) do { unsigned _sp = 0; while (cond) { __builtin_amdgcn_s_sleep(1); \
    if ((++_sp & 255u) == 0u) { if (xb_ld(&(bar)[XB_TMO])) break; if (_sp > XB_SPIN_CAP) { atomicAdd(&(bar)[XB_TMO], 1u); break; } } } } while (0)
struct XcdBarrier { unsigned* bar; unsigned x; volatile LAS unsigned* st; };
__device__ __forceinline__ XcdBarrier xcd_barrier_post(unsigned* bar, volatile LAS unsigned* st) {
    XcdBarrier b; b.bar = bar; b.x = xb_xcc_id(); b.st = st;
    if (threadIdx.x == 0) (void)xb_add(&bar[XB_XCNT(b.x)], 1u);
    return b;
}
__device__ __forceinline__ void xcd_barrier_complete(unsigned* bar, unsigned x, unsigned& nloc, unsigned& nx) {
    const unsigned G = gridDim.x * gridDim.y * gridDim.z;
    unsigned sum, cnt, mine, sp = 0u;
    for (;;) {
        sum = 0u; cnt = 0u; mine = 0u;
#pragma unroll
        for (unsigned j = 0; j < 16; ++j) { const unsigned c = xb_ld(&bar[XB_XCNT(j)]); sum += c; cnt += (c > 0u) ? 1u : 0u; mine = (j == x) ? c : mine; }
        if (sum == G) break;
        __builtin_amdgcn_s_sleep(1);
        if ((++sp & 255u) == 0u) { if (xb_ld(&bar[XB_TMO])) break; if (sp > XB_SPIN_CAP) { atomicAdd(&bar[XB_TMO], 1u); break; } }
    }
    nloc = mine > 0u ? mine : 1u; nx = cnt > 0u ? cnt : 1u;
}
__device__ __forceinline__ void xcd_barrier(const XcdBarrier& b) {
    asm volatile("s_waitcnt vmcnt(0)" ::: "memory");
    __syncthreads();
    if (threadIdx.x == 0) {
        unsigned* bar = b.bar;
        __builtin_amdgcn_s_waitcnt(0);
        unsigned nloc = b.st[0], nx = b.st[1];
        if (nloc == 0u) { xcd_barrier_complete(bar, b.x, nloc, nx); b.st[0] = nloc; b.st[1] = nx; }
        const unsigned old = xb_add(&bar[XB_XSUB(b.x)], 1u);
        const unsigned gen = old / nloc;
        if (old + 1u == (gen + 1u) * nloc) {
            __builtin_amdgcn_fence(__ATOMIC_RELEASE, "agent");
            asm volatile("s_waitcnt vmcnt(0)" ::: "memory");
            const unsigned og = xb_add(&bar[XB_TOP], 1u);
            const unsigned tg = og / nx;
            if (og + 1u == (tg + 1u) * nx) xb_add(&bar[XB_TOPGEN], 1u);
            else XB_SPIN(xb_ld(&bar[XB_TOPGEN]) == tg, bar);
            __builtin_amdgcn_fence(__ATOMIC_ACQUIRE, "agent");
            xb_add(&bar[XB_XGEN(b.x)], 1u);
            asm volatile("s_waitcnt vmcnt(0)" ::: "memory");
        } else {
            XB_SPIN(xb_ld(&bar[XB_XGEN(b.x)]) == gen, bar);
            __builtin_amdgcn_fence(__ATOMIC_ACQUIRE, "agent");
            asm volatile("s_waitcnt vmcnt(0)" ::: "memory");
        }
    }
    __syncthreads();
}

__device__ __forceinline__ float wave_sum(float v) {
#pragma unroll
    for (int o = 1; o < 64; o <<= 1) v += __shfl_xor(v, o);
    return v;
}

constexpr int CT_M0 = 0, CT_M1 = CT_M0 + 64 * 24, CT_M2 = CT_M1 + 64 * 8, CT_M3 = CT_M2 + 64 * 44, CT_M4 = CT_M3 + 176 * 8, CT_M5 = CT_M4 + 64 * 16, CT_M6 = CT_M5 + 64 * 8, CT_M7 = CT_M6 + 64 * 8,
              CT_M8 = CT_M7 + 8 * 64 * 56, CT_END = CT_M8 + 8 * 224 * 8;
static_assert(CT_END == 51328, "task count");
struct CDesc { const float* src; const float* gain; unsigned dst_off; int K, N, nblk, Np, dcol0, mode, F, base, pad; };
static_assert(sizeof(CDesc) == 56 || sizeof(CDesc) == 64, "CDesc");
constexpr int CDESC_OFF = LDSCTL_OFF + 1024;
__device__ __forceinline__ unsigned udiv_small(unsigned a, unsigned b) {
    unsigned q = (unsigned)__builtin_amdgcn_readfirstlane((int)(unsigned)((float)a * __builtin_amdgcn_rcpf((float)b))); if (q * b > a) --q; if ((q + 1) * b <= a) ++q; return q; }
#define CAS __attribute__((address_space(4)))
struct ConvJob { const GAS char* sp; const CAS float* gp; unsigned dp; unsigned sstride, dstride; };
__device__ __forceinline__ unsigned conv_slane(int mode, unsigned foff, int lane) {
    const int l = (mode == 2) ? (lane & 31) : lane;
    const unsigned pf = 32u * (l >> 3) + 4u * (2u * (l & 3) + ((l >> 2) & 1));
    return (mode == 0) ? 16u * lane : (4u * pf + ((mode == 2 && lane >= 32) ? foff : 0u));
}
__device__ __forceinline__ v2u conv_pack(f32x4 v, float g) { v2u o; o.x = cvtpk2(v.x * g, v.y * g); o.y = cvtpk2(v.z * g, v.w * g); return o; }
struct ConvStream {
    static constexpr bool ON = true, REG = false; static constexpr int HOST_VMCNT = 8;
    const LAS CDesc* tabL; unsigned char* ws; ConvJob j; int task, tstep, tend, rows_left; unsigned slane; int lane; bool live;
    __device__ __forceinline__ void decode(int t) {
        const int m = (t >= CT_M1) + (t >= CT_M2) + (t >= CT_M3) + (t >= CT_M4) + (t >= CT_M5) + (t >= CT_M6) + (t >= CT_M7) + (t >= CT_M8);
        const LAS CDesc* d = tabL + m;
#define RFL(x) __builtin_amdgcn_readfirstlane(x)
        const int K = RFL(d->K), N = RFL(d->N), nblk = RFL(d->nblk), Np = RFL(d->Np), mode = RFL(d->mode), F = RFL(d->F), base = RFL(d->base), dcol0 = RFL(d->dcol0); const unsigned dst_off = (unsigned)RFL((int)d->dst_off);
        const LAS unsigned* dw = (const LAS unsigned*)d;
        const GAS float* srcp = (const GAS float*)(((unsigned long long)(unsigned)RFL((int)dw[1]) << 32) | (unsigned)RFL((int)dw[0]));
        const CAS float* gn = (const CAS float*)(((unsigned long long)(unsigned)RFL((int)dw[3]) << 32) | (unsigned)RFL((int)dw[2]));
#undef RFL
        const unsigned r = (unsigned)(t - base), per = (unsigned)((K >> 5) * nblk), e = udiv_small(r, per), r2 = r - e * per, rc = udiv_small(r2, (unsigned)nblk), blk = r2 - rc * nblk;
        const size_t row0 = (size_t)e * K + (size_t)rc * 32; const unsigned sc = (mode == 2) ? blk * 128u : blk * 256u;
        j.sp = (const GAS char*)(srcp + row0 * N + sc); j.dp = dst_off + (unsigned)((row0 * Np + dcol0 + blk * 256u) * 2u);
        j.gp = gn ? gn + rc * 32 : nullptr; j.sstride = (unsigned)N * 4u; j.dstride = (unsigned)Np * 2u;
        slane = conv_slane(mode, (unsigned)F * 4u, lane); rows_left = 32;
    }
    __device__ __forceinline__ void start(const LAS CDesc* tabL_, unsigned char* ws_, int t0, int tstep_, int tend_, int lane_) { tabL = tabL_; ws = ws_; task = t0; tstep = tstep_; tend = tend_; lane = lane_; live = t0 < tend_;
        decode(live ? t0 : tend_ - 1); }
    __device__ __forceinline__ void advance() {
        if (rows_left > 1) { --rows_left; j.sp += j.sstride; j.dp += j.dstride; if (j.gp) ++j.gp; }
        else if (task + tstep < tend) { task += tstep; decode(task); }
        else live = false;
    }
    struct Burst { const GAS char* sp; const CAS float* gp; unsigned dp, sstride, dstride, slane; };
    __device__ __forceinline__ bool burst_begin(Burst& b) {
        b.sp = j.sp; b.gp = j.gp; b.dp = j.dp; b.sstride = j.sstride; b.dstride = j.dstride; b.slane = slane; const bool was = live;
        if (rows_left > 16) { rows_left -= 16; j.sp += 16 * j.sstride; j.dp += 16 * j.dstride; if (j.gp) j.gp += 16; }
        else if (task + tstep < tend) { task += tstep; decode(task); }
        else live = false;
        return was;
    }
    __device__ __forceinline__ bool burst_begin_n(Burst& b, int R) {
        b.sp = j.sp; b.gp = j.gp; b.dp = j.dp; b.sstride = j.sstride; b.dstride = j.dstride; b.slane = slane; const bool was = live;
        if (rows_left > R) { rows_left -= R; j.sp += R * j.sstride; j.dp += R * j.dstride; if (j.gp) j.gp += R; }
        else if (task + tstep < tend) { task += tstep; decode(task); }
        else live = false;
        return was;
    }
    __device__ __forceinline__ void burst_dma(const Burst& b, int i, LAS unsigned char* dst) const {
        __builtin_amdgcn_global_load_lds((const GAS unsigned*)(b.sp + (size_t)i * b.sstride + b.slane), (LAS unsigned*)dst, 16, 0, 0); }
    __device__ __forceinline__ void burst_finish4(const Burst& b, LAS unsigned char* src) const {
        typedef float gain4 __attribute__((ext_vector_type(4)));
        gain4 g = {1.f, 1.f, 1.f, 1.f}; if (b.gp) g = *(const CAS gain4*)b.gp;
#pragma unroll
        for (int i = 0; i < 4; ++i) { const f32x4 v = *(const LAS f32x4*)(src + i * 1024 + 16 * lane); store(b.dp + (unsigned)i * b.dstride, conv_pack(v, g[i])); }
    }
    __device__ __forceinline__ f32x4 burst_load(const Burst& b, int i) const { return __builtin_nontemporal_load((const GAS f32x4*)(b.sp + (size_t)i * b.sstride + b.slane)); }
    typedef float gain16 __attribute__((ext_vector_type(16)));
    __device__ __forceinline__ gain16 burst_gains(const Burst& b) const { gain16 g;
#pragma unroll
        for (int i = 0; i < 16; ++i) g[i] = 1.0f;
        if (b.gp) g = *(const CAS gain16*)b.gp;
        return g; }
    __device__ __forceinline__ void burst_store(const Burst& b, int i, f32x4 v, float g) const { store(b.dp + (unsigned)i * b.dstride, conv_pack(v, g)); }
    __device__ __forceinline__ f32x4 load() const { return __builtin_nontemporal_load((const GAS f32x4*)(j.sp + slane)); }
    __device__ __forceinline__ void load_asm(f32x4& x) const { const unsigned long long p = (unsigned long long)j.sp;
        const unsigned long long ps = ((unsigned long long)(unsigned)__builtin_amdgcn_readfirstlane((int)(unsigned)(p >> 32)) << 32) | (unsigned)__builtin_amdgcn_readfirstlane((int)(unsigned)p);
        asm volatile("s_nop 4\n\tglobal_load_dwordx4 %0, %1, %2 nt" : "=&v"(x) : "v"(slane), "s"(ps) : "memory"); }
    __device__ __forceinline__ float gain() const { return j.gp ? *j.gp : 1.0f; }
    __device__ __forceinline__ void store(unsigned dp, v2u y) const { *(GAS v2u*)((GAS unsigned char*)ws + (dp + 8u * (unsigned)lane)) = y; }
};
__device__ __forceinline__ void conv_drain(ConvStream& s) {
    while (s.live) {
        f32x4 v[8]; unsigned dp[8]; float g[8]; bool ok[8];
#pragma unroll
        for (int i = 0; i < 8; ++i) { ok[i] = s.live; v[i] = s.load(); dp[i] = s.j.dp; g[i] = s.gain(); s.advance(); }
#pragma unroll
        for (int i = 0; i < 8; ++i) if (ok[i]) s.store(dp[i], conv_pack(v[i], g[i]));
    }
}
__device__ __forceinline__ unsigned cvt4_fp8(float a, float b, float c, float d) { int w = __builtin_amdgcn_cvt_pk_fp8_f32(a, b, 0, false); w = __builtin_amdgcn_cvt_pk_fp8_f32(c, d, w, true); return (unsigned)w; }
__device__ __forceinline__ void conv8_task(const float* src, int K, int N, unsigned char* dst, const float* gain, int F, float scale, int t, int lane) {
    const int nstrip = N / 32, nkc = K / 512, per = nstrip * nkc;
    const int e = t / per, r = t - e * per, kc = r / nstrip, strip = r - kc * nstrip;
    src += (size_t)e * K * N; dst += (size_t)e * N * K;
    const int n = strip * 32 + 4 * (lane & 7), q = lane >> 3;
    int drow = n; if (F > 0) drow = (n < F) ? ((n >> 7) * 256 + (n & 127)) : (((n - F) >> 7) * 256 + 128 + ((n - F) & 127));
#pragma unroll 1
    for (int step = 0; step < 4; ++step) {
        const int k0 = kc * 512 + step * 128 + 16 * q;
        f32x4 v[16];
#pragma unroll
        for (int i = 0; i < 16; ++i) v[i] = __builtin_nontemporal_load((const f32x4*)(src + (size_t)(k0 + i) * N + n));
        float g[16];
#pragma unroll
        for (int i = 0; i < 4; ++i) { f32x4 gv = {scale, scale, scale, scale}; if (gain) gv = *(const f32x4*)(gain + k0 + 4 * i) * scale; g[4 * i] = gv.x; g[4 * i + 1] = gv.y; g[4 * i + 2] = gv.z; g[4 * i + 3] = gv.w; }
#pragma unroll
        for (int j = 0; j < 4; ++j) { v4u o;
            o.x = cvt4_fp8(v[0][j] * g[0], v[1][j] * g[1], v[2][j] * g[2], v[3][j] * g[3]); o.y = cvt4_fp8(v[4][j] * g[4], v[5][j] * g[5], v[6][j] * g[6], v[7][j] * g[7]);
            o.z = cvt4_fp8(v[8][j] * g[8], v[9][j] * g[9], v[10][j] * g[10], v[11][j] * g[11]); o.w = cvt4_fp8(v[12][j] * g[12], v[13][j] * g[13], v[14][j] * g[14], v[15][j] * g[15]);
            *(v4u*)(dst + (size_t)(drow + j) * K + k0) = o; }
    }
}
template <bool REG_, bool DIRECT_ = false> struct Conv8StreamT {
    static constexpr bool ON = true, REG = REG_; static constexpr int HOST_VMCNT = 4;
    struct Burst { const GAS char* sp; GAS unsigned char* dp; unsigned doff; };
    const float* src; unsigned char* dst; int task, tstep, tend, step; int lane; bool live; float scale;
    const GAS char* sp; GAS unsigned char* dp; unsigned doff;
    static constexpr int K = DM, N = 2 * FFX, F = FFX, NSTRIP = N / 32, PER = NSTRIP * (K / 512);
    __device__ __forceinline__ void decode(int t) {
        const int e = t / PER, r = t - e * PER, kc = r / NSTRIP, strip = r - kc * NSTRIP;
        const int n0 = strip * 32, k0 = kc * 512;
        sp = (const GAS char*)(src + ((size_t)e * K + k0) * N + n0); dp = (GAS unsigned char*)dst + (size_t)e * N * K + k0;
        const int n = DIRECT_ ? n0 + 4 * (lane & 7) : n0 + (lane & 31); const int drow = (n < F) ? ((n >> 7) * 256 + (n & 127)) : (((n - F) >> 7) * 256 + 128 + ((n - F) & 127));
        doff = DIRECT_ ? (unsigned)drow * (unsigned)K + 4u * (unsigned)(lane >> 3) : (unsigned)drow * (unsigned)K + 16u * (unsigned)(lane >> 5); step = 0;
    }
    __device__ __forceinline__ void start(const float* src_, unsigned char* dst_, float scale_, int t0, int tstep_, int tend_, int lane_) { src = src_; dst = dst_; scale = scale_; task = t0; tstep = tstep_; tend = tend_; lane = lane_;
        live = t0 < tend_; decode(live ? t0 : tend_ - 1); }
    __device__ __forceinline__ bool burst_begin_n(Burst& b, int R) {
        b.sp = sp; b.dp = dp; b.doff = doff; const bool was = live; if (R == 0) return was;
        if (step < 15) { ++step; sp += (size_t)32 * N * 4; dp += 32; }
        else if (task + tstep < tend) { task += tstep; decode(task); }
        else live = false;
        return was;
    }
    __device__ __forceinline__ void burst_dma(const Burst& b, int i, LAS unsigned char* dstl) const {
        __builtin_amdgcn_global_load_lds((const GAS unsigned*)(b.sp + ((size_t)((lane >> 3) + 8 * i) * N + 4 * (lane & 7)) * 4), (LAS unsigned*)dstl, 16, 0, 0); }
    __device__ __forceinline__ f32x4 burst_ld(const Burst& b, int i) const {
        const int row = DIRECT_ ? 4 * (lane >> 3) + i : (lane >> 3) + 8 * i;
        return __builtin_nontemporal_load((const GAS f32x4*)(b.sp + ((size_t)row * N + 4 * (lane & 7)) * 4)); }
    __device__ __forceinline__ void burst_finish_regs(const Burst& b, const f32x4 (&hv)[4], LAS unsigned char* stl) const {
        if constexpr (DIRECT_) {
#pragma unroll
            for (int j = 0; j < 4; ++j) *(GAS unsigned*)(b.dp + b.doff + (size_t)j * K) = cvt4_fp8(hv[0][j] * scale, hv[1][j] * scale, hv[2][j] * scale, hv[3][j] * scale);
            return; }
#pragma unroll
        for (int i = 0; i < 4; ++i) *(LAS f32x4*)(stl + i * 1024 + 16 * lane) = hv[i];
        asm volatile("s_waitcnt lgkmcnt(0)" ::: "memory");
        burst_finish4(b, stl);
        asm volatile("s_waitcnt lgkmcnt(0)" ::: "memory");
    }
    __device__ __forceinline__ void burst_finish4(const Burst& b, LAS unsigned char* srcl) const {
        const LAS float* p = (const LAS float*)srcl + 16 * (lane >> 5) * 32 + (lane & 31);
        float v[16];
#pragma unroll
        for (int j = 0; j < 16; ++j) v[j] = p[j * 32] * scale;
        v4u o; o.x = cvt4_fp8(v[0], v[1], v[2], v[3]); o.y = cvt4_fp8(v[4], v[5], v[6], v[7]); o.z = cvt4_fp8(v[8], v[9], v[10], v[11]); o.w = cvt4_fp8(v[12], v[13], v[14], v[15]);
        *(GAS v4u*)(b.dp + b.doff) = o;
    }
};
template <class S8> __device__ __forceinline__ void conv8_drain(S8& s) {
    while (s.live) { conv8_task(s.src, S8::K, S8::N, s.dst, nullptr, S8::F, s.scale, s.task, s.lane);
        if (s.task + s.tstep < s.tend) s.task += s.tstep; else s.live = false; }
}
typedef Conv8StreamT<false> Conv8Stream; typedef Conv8StreamT<true> Conv8StreamR; typedef Conv8StreamT<true, true> Conv8StreamD;
constexpr float SC_WGU = 64.f, SC_ACT = 8.f, SC_WDN = 128.f;
#define BF4_TO_F4(w_) ((f32x4){__uint_as_float((w_).x << 16), __uint_as_float((w_).x & 0xffff0000u), __uint_as_float((w_).y << 16), __uint_as_float((w_).y & 0xffff0000u)})
__device__ __forceinline__ void rms_rowh_to_bf16(const bf16* xrow, bf16* orow, int lane) {
    const v2u* xr = (const v2u*)xrow + lane;
    f32x4 v[8]; float s = 0.f;
#pragma unroll
    for (int j = 0; j < 8; ++j) { const v2u w = xr[64 * j]; v[j] = BF4_TO_F4(w); s += (v[j].x * v[j].x + v[j].y * v[j].y) + (v[j].z * v[j].z + v[j].w * v[j].w); }
    const float rstd = 1.0f / sqrtf(wave_sum(s) * (1.f / DM) + RMS_EPS);
    v2u* o8 = (v2u*)orow + lane;
#pragma unroll
    for (int j = 0; j < 8; ++j) { v2u w; w.x = cvtpk2(v[j].x * rstd, v[j].y * rstd); w.y = cvtpk2(v[j].z * rstd, v[j].w * rstd); o8[64 * j] = w; }
}
__device__ __forceinline__ void rms_row_to_bf16(const float* xrow, bf16* orow, int lane) {
    const f32x4* xr = (const f32x4*)xrow + lane;
    f32x4 v[8]; float s = 0.f;
#pragma unroll
    for (int j = 0; j < 8; ++j) { v[j] = xr[64 * j]; s += (v[j].x * v[j].x + v[j].y * v[j].y) + (v[j].z * v[j].z + v[j].w * v[j].w); }
    const float rstd = 1.0f / sqrtf(wave_sum(s) * (1.f / DM) + RMS_EPS);
    v2u* o8 = (v2u*)orow + lane;
#pragma unroll
    for (int j = 0; j < 8; ++j) { v2u w; w.x = cvtpk2(v[j].x * rstd, v[j].y * rstd); w.y = cvtpk2(v[j].z * rstd, v[j].w * rstd); o8[64 * j] = w; }
}
struct Args { const float* in[16]; float* out; unsigned char* ws; int ph_lo, ph_hi; };
enum { I_X = 0, I_NMIX, I_NFFN, I_WQKVA, I_WOA, I_NKV, I_WKVF, I_BF, I_WQB, I_WOB, I_WGU, I_WDN, I_WR, I_WGUX, I_WDNX, I_NFIN };

__global__ void __launch_bounds__(NTHR, 2) yoco_fwd(Args args) {
    extern __shared__ __attribute__((aligned(16))) unsigned char lds_raw[];
    LAS unsigned char* lds = (LAS unsigned char*)lds_raw;
    volatile LAS unsigned* MISC = (volatile LAS unsigned*)(lds + MISC_OFF);
    const int tid = threadIdx.x, lane = tid & 63, wave = __builtin_amdgcn_readfirstlane(tid >> 6);
    const int G = gridDim.x; const int bx = blockIdx.x; const int vcu = (G % 8 == 0) ? (bx % 8) * (G / 8) + bx / 8 : bx;
    const int gw = vcu * NWAVES + wave, NGW = G * NWAVES;
    unsigned char* ws = args.ws;
    gu32* ctl = (gu32*)(ws + WS_CTL);
    for (int u = tid; u < (LDS_BYTES - LDSCTL_OFF) / 4; u += NTHR) ((LAS unsigned*)(lds + LDSCTL_OFF))[u] = 0u;
    __syncthreads();
    if (tid == 0) {
        const float* nmix = args.in[I_NMIX]; const float* nffn = args.in[I_NFFN]; const float* nkv = args.in[I_NKV]; const float* nul = nullptr;
#define CD_SET(i_, SRC_, GAIN_, DST_, K_, N_, NBLK_, NP_, DCOL0_, MODE_, F_, BASE_) { LAS CDesc* d_ = (LAS CDesc*)(lds + CDESC_OFF) + (i_); d_->src = (SRC_); d_->gain = (GAIN_); d_->dst_off = (unsigned)(DST_); \
            d_->K = (K_); d_->N = (N_); d_->nblk = (NBLK_); d_->Np = (NP_); d_->dcol0 = (DCOL0_); d_->mode = (MODE_); d_->F = (F_); d_->base = (BASE_); d_->pad = 0; }
        CD_SET(0, args.in[I_WQKVA], nmix,        WS_WQKV, 2048, 6144,    24, 6144,    0,    1, 0,   CT_M0)
        CD_SET(1, args.in[I_WOA],   nul,         WS_WOA,  2048, 2048,    8,  2048,    0,    1, 0,   CT_M1)
        CD_SET(2, args.in[I_WGU],   nffn,        WS_WGU,  2048, 2 * FF,  44, 2 * FF,  0,    2, FF,  CT_M2)
        CD_SET(3, args.in[I_WDN],   nul,         WS_WDN,  FF,   2048,    8,  2048,    0,    1, 0,   CT_M3)
        CD_SET(4, args.in[I_WKVF],  nkv,         WS_WKVQ, 2048, 4112,    16, 6144,    2048, 1, 0,   CT_M4)
        CD_SET(5, args.in[I_WQB],   nmix + 2048, WS_WKVQ, 2048, 2048,    8,  6144,    0,    1, 0,   CT_M5)
        CD_SET(6, args.in[I_WOB],   nul,         WS_WOB,  2048, 2048,    8,  2048,    0,    1, 0,   CT_M6)
        CD_SET(7, args.in[I_WGUX],  nffn + 2048, WS_WGUX, 2048, 2 * FFX, 56, 2 * FFX, 0,    2, FFX, CT_M7)
        CD_SET(8, args.in[I_WDNX],  nul,         WS_WDNX, FFX,  2048,    8,  2048,    0,    0, 0,   CT_M8)
#undef CD_SET
    }
    __syncthreads();
    XcdBarrier bar; bar.bar = (unsigned*)(ctl + CW_BAR); bar.x = 0; bar.st = nullptr;
    if (ONE_LAUNCH) bar = xcd_barrier_post((unsigned*)(ctl + CW_BAR), MISC + 8);
    const int lo = args.ph_lo, hi = args.ph_hi;
#define IN(k) (lo <= (k) && (k) < hi)
#define SEAM(k) do { if (IN(k) && IN((k) + 1)) xcd_barrier(bar); } while (0)

    bf16* const wA = (bf16*)(ws + WS_A); bf16* const wQ = (bf16*)(ws + WS_Q); bf16* const wK = (bf16*)(ws + WS_K); bf16* const wV = (bf16*)(ws + WS_V); bf16* const wO = (bf16*)(ws + WS_O);
    bf16* const H1 = (bf16*)(ws + WS_H1); bf16* const H2 = (bf16*)(ws + WS_H2); bf16* const H3 = (bf16*)(ws + WS_H3);
    int* const tokE = (int*)(ws + WS_TOK); float* const tokG = (float*)(ws + WS_TOK + 65536); int* const tokR = (int*)(ws + WS_TOK + 2 * 65536); int* const tokS = (int*)(ws + WS_TOK + 3 * 65536);
    int* const cntG = (int*)(ws + WS_CNT); int* const tab = (int*)(ws + WS_TAB);
    constexpr int CL_P0A_LO = CT_M0, CL_P0A_HI = CT_M1;
    constexpr int CL_P1_LO = CT_M1, CL_P1_HI = CT_M7;
    constexpr int CL_P2_LO = CT_M3, CL_P2_HI = CT_M7;
    constexpr int CL_P9_LO = CT_M7, CL_P9_HI = CT_M7;
    constexpr int CL_P13_LO = CT_M8, CL_P13_HI = CT_END;
    constexpr int NTG = 8 * (2 * FFX / 32) * (DM / 512), NTD = 8 * (DM / 32) * (FFX / 512), NCV = 16, NCV13 = 32, X5 = 2048, HH2 = 4096, HH9 = 8192;
    const bool cvsplit = (G >= 128); const int GW = G - NCV, GW13 = G - NCV13; const bool cvb = cvsplit && (bx >= GW), cvb13 = cvsplit && (bx >= GW13);
    const LAS CDesc* tabL = (const LAS CDesc*)(lds + CDESC_OFF);

    if (IN(0)) {
        const float* nmix = args.in[I_NMIX]; const float* nffn = args.in[I_NFFN]; const float* nkv = args.in[I_NKV];
        {   ConvStream cs; cs.start(tabL, ws, CL_P0A_LO + gw, NGW, CL_P0A_HI, lane); conv_drain(cs); }
        {
            const int n0 = cvsplit ? NTG - X5 - HH2 - HH9 : NTG + NTD;
            for (int t = gw; t < n0; t += NGW) {
                if (t < NTG) conv8_task(args.in[I_WGUX], DM, 2 * FFX, ws + WS_WGUX, nullptr, FFX, SC_WGU, t, lane);
                else conv8_task(args.in[I_WDNX], FFX, DM, ws + WS_WDNX, nullptr, 0, SC_WDN, t - NTG, lane); }
        }
        {
            const float* wkvf = args.in[I_WKVF]; bf16* WF = (bf16*)(ws + WS_WF);
            for (int idx = (vcu * NTHR + tid); idx < 16 * 2048; idx += G * NTHR) { const int k = idx >> 4, j = idx & 15;
                const float v = wkvf[(size_t)k * 4112 + 4096 + j] * nkv[k]; WF[j * 2048 + k] = (bf16)(cvtpk2(v, 0.f) & 0xffffu); }
        }
        for (int m = gw; m < T; m += NGW) rms_row_to_bf16(args.in[I_X] + (size_t)m * DM, wA + (size_t)m * DM, lane);
    }
    SEAM(0);
    if (IN(1)) {
        pg8::Gemm g{wA, (const bf16*)(ws + WS_WQKV), DM, 3 * DM, DM}; pg8::StaticOrder S; S.init(T, 3 * DM, G, bx);
        pg8::EpiBf16Split E{wQ, DM, DM, (size_t)(WS_K - WS_Q) / 2, QSCALE, 0, 1.0f, nullptr, nullptr, nullptr};
        ConvStream bg; bg.start(tabL, ws, CL_P1_LO + gw, NGW, CL_P1_HI, lane);
        pg8::gemm_phase<pg8::EpiBf16Split, pg8::StaticOrder, ConvStream>(lds + RING_OFF, g, S, E, bg); conv_drain(bg);
    }
    SEAM(1);
    if (IN(2)) {
        Conv8StreamD bgA; { const int lo8 = cvsplit ? NTG - X5 - HH2 - HH9 : NTG; bgA.start(args.in[I_WGUX], ws + WS_WGUX, SC_WGU, lo8 + gw, NGW, lo8 + (cvsplit ? HH2 : 0), lane); }
        for (int it = vcu; it < 256; it += G) { const int bh = it >> 2, x = it & 3, b = bh >> 4, h = bh & 15;
            for (int pass = 0; pass < 2; ++pass) att::attn_block<false, Conv8StreamD>((LAS char*)lds, wQ, wK, wV, wO, b, h, pass ? x : 7 - x, bgA); }
        conv8_drain(bgA);
    }
    SEAM(2);
    if (IN(3)) {
        pg8::Gemm g{wO, (const bf16*)(ws + WS_WOA), DM, DM, DM}; pg8::StaticOrder S; S.init(T, DM, G, bx);
        pg8::EpiResBf16 E{H1, DM, args.in[I_X], nullptr, (float*)(ws + WS_SSQ1)};
        pg8::NoBg nobg; pg8::gemm_phase<pg8::EpiResBf16, pg8::StaticOrder, pg8::NoBg>(lds + RING_OFF, g, S, E, nobg);
    }
    SEAM(3);
    if (IN(5)) {
        if (cvb) { const float* nffn = args.in[I_NFFN];
            for (int t = NTG - X5 + (bx - GW) * NWAVES + wave; t < NTG; t += NCV * NWAVES) conv8_task(args.in[I_WGUX], DM, 2 * FFX, ws + WS_WGUX, nullptr, FFX, SC_WGU, t, lane);
        } else {
        const int Gw = cvsplit ? GW : G;
        pg8::Gemm g{H1, (const bf16*)(ws + WS_WGU), DM, 2 * FF, DM}; pg8::StaticOrder S; S.init(T, 2 * FF, Gw, bx);
        pg8::EpiSwiGLU E{(bf16*)(ws + WS_ACT), FF, (const float*)(ws + WS_SSQ1), (const LAS float*)(lds + RING_BYTES), nullptr};
        pg8::NoBg nobg; pg8::gemm_phase<pg8::EpiSwiGLU, pg8::StaticOrder, pg8::NoBg>(lds + RING_OFF, g, S, E, nobg);
        }
    }
    SEAM(5);
    if (IN(6)) {
        pg8::Gemm g{(const bf16*)(ws + WS_ACT), (const bf16*)(ws + WS_WDN), FF, DM, FF}; pg8::StaticOrder S; S.init(T, DM, G, bx);
        pg8::EpiResBf16 E{H2, DM, nullptr, H1, (float*)(ws + WS_SSQ2)};
        pg8::NoBg nobg; pg8::gemm_phase<pg8::EpiResBf16, pg8::StaticOrder, pg8::NoBg>(lds + RING_OFF, g, S, E, nobg);
    }
    SEAM(6);
    if (IN(8)) {
        {   const bf16* WF = (const bf16*)(ws + WS_WF); float* FP = (float*)(ws + WS_FP); const int fr = lane & 15, fq = lane >> 4;
            for (int task = gw; task < 2048; task += NGW) { const int rt = task >> 2, kq = task & 3;
                const bf16* Ap = H2 + (size_t)(16 * rt + fr) * DM + 512 * kq + 8 * fq; const bf16* Bp = WF + (size_t)fr * DM + 512 * kq + 8 * fq;
                f32x4 acc = {0.f, 0.f, 0.f, 0.f};
#pragma unroll
                for (int s = 0; s < 16; ++s) { const bf16x8 a = *(const bf16x8*)(Ap + 32 * s), bb = *(const bf16x8*)(Bp + 32 * s); acc = __builtin_amdgcn_mfma_f32_16x16x32_bf16(bb, a, acc, 0, 0, 0); }
                *(f32x4*)(FP + ((size_t)kq * T + 16 * rt + fr) * 16 + 4 * fq) = acc; }
        }
        pg8::Gemm g{H2, (const bf16*)(ws + WS_WKVQ), DM, 3 * DM, DM}; pg8::StaticOrder S; S.init(T, 3 * DM, G, bx);
        pg8::EpiBf16Split E{wQ, DM, DM, (size_t)(WS_K - WS_Q) / 2, QSCALE, 0, 1.0f, (const float*)(ws + WS_SSQ2), (const LAS float*)(lds + RING_BYTES), (float*)(ws + WS_RSTD)};
        pg8::NoBg nobg; pg8::gemm_phase<pg8::EpiBf16Split, pg8::StaticOrder, pg8::NoBg>(lds + RING_OFF, g, S, E, nobg);
    }
    SEAM(8);
    if (IN(9)) {
        Conv8StreamD bgA; { const int lo8 = cvsplit ? NTG - X5 - HH9 : NTG; bgA.start(args.in[I_WGUX], ws + WS_WGUX, SC_WGU, lo8 + gw, NGW, lo8 + (cvsplit ? HH9 : 0), lane); }
        const float* FP = (const float*)(ws + WS_FP); const float* bfp = args.in[I_BF];
        LAS float* biasL = (LAS float*)(lds + att::OFF_BIAS); LAS float* scanL = (LAS float*)(lds + att::OFF_SCAN);
        for (int it = vcu; it < 256; it += G) { const int bh = it >> 2, x = it & 3, b = bh >> 4, h = bh & 15;
            {
                float c[4]; float run = 0.f; const float bfh = bfp[h];
#pragma unroll
                for (int j = 0; j < 4; ++j) { const size_t row = (size_t)b * SEQ + 4 * tid + j; float f = 0.f;
#pragma unroll
                    for (int kq = 0; kq < 4; ++kq) f += FP[((size_t)kq * T + row) * 16 + h];
                    f = bfh + f * ((const float*)(ws + WS_RSTD))[row];
                    const float lf = fminf(f, 0.f) - __logf(1.0f + __expf(-fabsf(f))); run += lf; c[j] = run; }
                float incl = run;
#pragma unroll
                for (int o = 1; o < 64; o <<= 1) { const float n = __shfl_up(incl, o); if (lane >= o) incl += n; }
                if (lane == 63) scanL[wave] = incl;
                __syncthreads();
                float wpre = 0.f;
#pragma unroll
                for (int w = 0; w < 8; ++w) { const float tw = scanL[w]; if (w < wave) wpre += tw; }
                const float base = wpre + (incl - run);
#pragma unroll
                for (int j = 0; j < 4; ++j) biasL[4 * tid + j] = -(base + c[j]) * 1.4426950408889634f;
                __syncthreads();
            }
            for (int pass = 0; pass < 2; ++pass) att::attn_block<true, Conv8StreamD, 2>((LAS char*)lds, wQ, wK, wV, wO, b, h, pass ? x : 7 - x, bgA); }
        conv8_drain(bgA);
    }
    SEAM(9);
    if (IN(10)) {
        pg8::Gemm g{wO, (const bf16*)(ws + WS_WOB), DM, DM, DM}; pg8::StaticOrder S; S.init(T, DM, G, bx);
        pg8::EpiResBf16 E{H3, DM, nullptr, H2, nullptr};
        pg8::NoBg nobg; pg8::gemm_phase<pg8::EpiResBf16, pg8::StaticOrder, pg8::NoBg>(lds + RING_OFF, g, S, E, nobg);
    }
    SEAM(10);
    if (IN(11)) {
        LAS float* wrL = (LAS float*)lds;
        LAS int* eL = (LAS int*)(lds + 65536);
        const float* wr = args.in[I_WR]; const float* gn = args.in[I_NFFN] + 2048;
        for (int idx = tid; idx < 8 * 2048; idx += NTHR) { const int c = idx >> 3, e = idx & 7; wrL[e * 2048 + c] = wr[idx]; }
        __syncthreads();
        for (int g = vcu; g < 256; g += G) {
            for (int i = 0; i < 4; ++i) { const int tl = 4 * wave + i, token = 32 * g + tl;
                const v2u* xr = (const v2u*)(H3 + (size_t)token * DM) + lane;
                f32x4 v[8]; float s = 0.f;
#pragma unroll
                for (int j = 0; j < 8; ++j) { const v2u w_ = xr[64 * j]; v[j] = BF4_TO_F4(w_); s += (v[j].x * v[j].x + v[j].y * v[j].y) + (v[j].z * v[j].z + v[j].w * v[j].w); }
                const float rstd = 1.0f / sqrtf(wave_sum(s) * (1.f / DM) + RMS_EPS);
                unsigned* o4 = (unsigned*)((unsigned char*)wA + (size_t)token * DM) + lane;
#pragma unroll
                for (int j = 0; j < 8; ++j) { v[j] = v[j] * rstd * ((const f32x4*)gn)[lane + 64 * j]; o4[64 * j] = pg8::pk4_fp8(v[j].x, v[j].y, v[j].z, v[j].w); }
                float lg[8];
#pragma unroll
                for (int e = 0; e < 8; ++e) { float a = 0.f;
#pragma unroll
                    for (int j = 0; j < 8; ++j) { const f32x4 w4 = *(const LAS f32x4*)(wrL + e * 2048 + 256 * j + 4 * lane); a += (v[j].x * w4.x + v[j].y * w4.y) + (v[j].z * w4.z + v[j].w * w4.w); }
                    lg[e] = wave_sum(a); }
                int e1 = 0; float v1 = lg[0];
#pragma unroll
                for (int e = 1; e < 8; ++e) if (lg[e] > v1) { v1 = lg[e]; e1 = e; }
                int e2 = -1; float v2 = -__builtin_inff();
#pragma unroll
                for (int e = 0; e < 8; ++e) if (e != e1 && lg[e] > v2) { v2 = lg[e]; e2 = e; }
                const float g1 = 1.0f / (1.0f + __expf(v2 - v1)), g2 = 1.0f - g1;
                if (lane == 0) { eL[2 * tl] = e1; eL[2 * tl + 1] = e2; tokE[2 * token] = e1; tokE[2 * token + 1] = e2; tokG[2 * token] = g1; tokG[2 * token + 1] = g2; }
            }
            __syncthreads();
            if (tid == 0) { int cnt[8];
#pragma unroll
                for (int e = 0; e < 8; ++e) cnt[e] = 0;
                for (int q = 0; q < 64; ++q) { const int e = eL[q]; int r = 0;
#pragma unroll
                    for (int k = 0; k < 8; ++k) if (k == e) { r = cnt[k]; cnt[k] = r + 1; }
                    tokR[64 * g + q] = r; }
#pragma unroll
                for (int e = 0; e < 8; ++e) cntG[8 * g + e] = cnt[e]; }
            __syncthreads();
        }
    }
    SEAM(11);
    if (IN(12)) {
        LAS int* totL = (LAS int*)lds; LAS int* befL = totL + 8; LAS int* segL = totL + 16;
        for (int g = vcu; g < 256; g += G) {
            {   const int e = wave; int tot = 0, bef = 0;
#pragma unroll
                for (int i = 0; i < 4; ++i) { const int bb = lane + 64 * i; const int c = cntG[8 * bb + e]; tot += c; bef += (bb < g) ? c : 0; }
#pragma unroll
                for (int o = 1; o < 64; o <<= 1) { tot += __shfl_xor(tot, o); bef += __shfl_xor(bef, o); }
                if (lane == 0) { totL[e] = tot; befL[e] = bef; } }
            __syncthreads();
            if (tid == 0) { int acc = 0;
                for (int e = 0; e < 8; ++e) { segL[e] = acc * 256; acc += (totL[e] + 255) >> 8; }
                if (g == 0) { tab[0] = acc; int pm = 0; for (int e = 0; e < 8; ++e) { const int n = (totL[e] + 255) >> 8; for (int q = 0; q < n; ++q) tab[64 + pm++] = e; } } }
            __syncthreads();
            for (int i = 0; i < 4; ++i) { const int token = 32 * g + 4 * wave + i;
                const v4u* src = (const v4u*)((const unsigned char*)wA + (size_t)token * DM) + lane; v4u r4[2];
#pragma unroll
                for (int j = 0; j < 2; ++j) r4[j] = src[64 * j];
#pragma unroll
                for (int k = 0; k < 2; ++k) { const int e = tokE[2 * token + k], r = tokR[2 * token + k]; const int slot = segL[e] + befL[e] + r;
                    v4u* dst = (v4u*)(ws + WS_AS + (size_t)slot * DM) + lane;
#pragma unroll
                    for (int j = 0; j < 2; ++j) dst[64 * j] = r4[j];
                    if (lane == 0) tokS[2 * token + k] = slot; } }
            __syncthreads();
        }
    }
    SEAM(12);
    if (IN(13)) {
        if (cvb13) {
            for (int t = (bx - GW13) * NWAVES + wave; t < NTD; t += NCV13 * NWAVES) conv8_task(args.in[I_WDNX], FFX, DM, ws + WS_WDNX, nullptr, 0, SC_WDN, t, lane);
        } else {
        const int Gw = cvsplit ? GW13 : G;
        const int MT = __builtin_amdgcn_readfirstlane(tab[0]);
        pg8::Gemm g{(const bf16*)(ws + WS_AS), (const bf16*)(ws + WS_WGUX), DM / 2, 0, DM / 2}; pg8::MoeOrder8 S; S.init(MT < MAXTILES ? MT : MAXTILES, 2 * FFX / 256, Gw, bx, tab + 64, DM);
        pg8::EpiSwiGLU8 E{ws + WS_ACT2, FFX, 1.0f / SC_WGU, SC_ACT};
        pg8::gemm_phase_f8<pg8::EpiSwiGLU8, pg8::MoeOrder8>(lds + RING_OFF, g, S, E);
        }
    }
    SEAM(13);
    if (IN(14)) {
        const int MT0 = __builtin_amdgcn_readfirstlane(tab[0]); const int MT = MT0 < MAXTILES ? MT0 : MAXTILES; const int tail0 = (MT >> 5) << 5;
        {   pg8::Gemm g{(const bf16*)(ws + WS_ACT2), (const bf16*)(ws + WS_WDNX), FFX / 2, 0, FFX / 2}; pg8::MoeOrder8 S; S.init(tail0, DM / 256, G, bx, tab + 64, FFX);
            pg8::EpiBf16Split E{(bf16*)(ws + WS_Y), DM, 1 << 30, 0, 1.0f, -1, 1.0f / (SC_ACT * SC_WDN), nullptr, nullptr, nullptr};
            pg8::gemm_phase_f8<pg8::EpiBf16Split, pg8::MoeOrder8>(lds + RING_OFF, g, S, E); }
        if (MT > tail0) {
            pg8::Gemm g{(const bf16*)(ws + WS_ACT2), (const bf16*)(ws + WS_WDNX), FFX / 2, 0, 512}; pg8::MoeTailOrder8 S; S.init(tail0, MT - tail0, DM / 256, G, bx, tab + 64, FFX);
            pg8::EpiBf16Split E{(bf16*)(ws + WS_YP), DM, 1 << 30, 0, 1.0f, -1, 1.0f / (SC_ACT * SC_WDN), nullptr, nullptr, nullptr};
            pg8::gemm_phase_f8<pg8::EpiBf16Split, pg8::MoeTailOrder8>(lds + RING_OFF, g, S, E); }
    }
    SEAM(14);
    if (IN(15)) {
        const bf16* Y = (const bf16*)(ws + WS_Y); const float* nf = args.in[I_NFIN]; const int MT15 = __builtin_amdgcn_readfirstlane(tab[0]); const int tail0 = ((MT15 < MAXTILES ? MT15 : MAXTILES) >> 5) << 5;
        for (int m = gw; m < T; m += NGW) {
            const int s0 = tokS[2 * m], s1 = tokS[2 * m + 1]; const float g0 = tokG[2 * m], g1 = tokG[2 * m + 1];
            const v2u* xr = (const v2u*)(H3 + (size_t)m * DM) + lane;
            f32x4 v[8];
#pragma unroll
            for (int j = 0; j < 8; ++j) { const v2u w_ = xr[64 * j]; v[j] = BF4_TO_F4(w_); }
#pragma unroll 1
            for (int k = 0; k < 2; ++k) { const int sk = k ? s1 : s0; const float gk = k ? g1 : g0;
#define Y4(w_) ((f32x4){__uint_as_float((w_).x << 16), __uint_as_float((w_).x & 0xffff0000u), __uint_as_float((w_).y << 16), __uint_as_float((w_).y & 0xffff0000u)})
                if ((sk >> 8) < tail0) { const v2u* y = (const v2u*)(Y + (size_t)sk * DM) + lane;
#pragma unroll
                    for (int j = 0; j < 8; ++j) { const v2u w = y[64 * j]; v[j] += gk * Y4(w); } }
                else { const bf16* YP = (const bf16*)(ws + WS_YP);
#pragma unroll 1
                    for (int kq = 0; kq < 7; ++kq) { const v2u* y = (const v2u*)(YP + ((size_t)(kq * 8 + (sk >> 8) - tail0) * 256 + (sk & 255)) * DM) + lane;
#pragma unroll
                        for (int j = 0; j < 8; ++j) { const v2u w = y[64 * j]; v[j] += gk * Y4(w); } } } }
#undef Y4
            float s = 0.f;
#pragma unroll
            for (int j = 0; j < 8; ++j) s += (v[j].x * v[j].x + v[j].y * v[j].y) + (v[j].z * v[j].z + v[j].w * v[j].w);
            const float rstd = 1.0f / sqrtf(wave_sum(s) * (1.f / DM) + RMS_EPS);
            f32x4* orow = (f32x4*)(args.out + (size_t)m * DM) + lane; const f32x4* nfr = (const f32x4*)nf + lane;
#pragma unroll
            for (int j = 0; j < 8; ++j) orow[64 * j] = v[j] * rstd * nfr[64 * j];
        }
    }
#undef IN
#undef SEAM
}

extern "C" void kernel_launch(void* const* d_in, const int* in_sizes, int n_in, void* d_out, int out_size, void* d_ws, size_t ws_size, hipStream_t stream) {
    static int grid = 0;
    if (grid == 0) {
        if (n_in != 16 || out_size != T * DM || ws_size < WS_END) { fprintf(stderr, "kernel_launch: unexpected shapes (n_in %d out %d ws %zu)\n", n_in, out_size, ws_size); grid = -1; return; }
        int dev = 0, cus = 0, per_cu = 0;
        if (hipGetDevice(&dev) != hipSuccess || hipDeviceGetAttribute(&cus, hipDeviceAttributeMultiprocessorCount, dev) != hipSuccess) { grid = -1; return; }
        if (hipFuncSetAttribute((const void*)yoco_fwd, hipFuncAttributeMaxDynamicSharedMemorySize, LDS_BYTES) != hipSuccess) { fprintf(stderr, "kernel_launch: hipFuncSetAttribute failed\n"); grid = -1; return; }
        if (hipOccupancyMaxActiveBlocksPerMultiprocessor(&per_cu, (const void*)yoco_fwd, NTHR, LDS_BYTES) != hipSuccess || per_cu < 1) fprintf(stderr, "kernel_launch: occupancy query reports %d\n", per_cu);
        (void)hipGetLastError();
        grid = cus;
    }
    if (grid < 0) return;
    (void)hipMemsetAsync((char*)d_ws + WS_CTL, 0, CTL_ZERO_BYTES, stream);
    Args a{};
    for (int i = 0; i < 16; ++i) a.in[i] = (const float*)d_in[i];
    a.out = (float*)d_out; a.ws = (unsigned char*)d_ws;
    if (ONE_LAUNCH) { a.ph_lo = 0; a.ph_hi = NPHASES; hipLaunchKernelGGL(yoco_fwd, dim3(grid), dim3(NTHR), LDS_BYTES, stream, a); }
    else for (int p = 0; p < NPHASES; ++p) { a.ph_lo = p; a.ph_hi = p + 1; hipLaunchKernelGGL(yoco_fwd, dim3(grid), dim3(NTHR), LDS_BYTES, stream, a); }
}
```

```cpp
#include <hip/hip_runtime.h>
#include <cstdio>
#include <cstdint>
namespace pg8 {
#define PG8_LAS __attribute__((address_space(3)))
typedef unsigned short bf16_t;
typedef short bf16x8 __attribute__((ext_vector_type(8)));
typedef float f32x4 __attribute__((ext_vector_type(4)));
typedef float f32x2 __attribute__((ext_vector_type(2)));
typedef unsigned u32x4 __attribute__((ext_vector_type(4)));
typedef short s16x4 __attribute__((ext_vector_type(4)));
typedef unsigned u32x2 __attribute__((ext_vector_type(2)));
constexpr int BM = 256, BK = 64, HALF = 128, HTB = HALF * BK * 2  , STAGE_BYTES = 8 * HTB, NXCD = 8, WGM = 8;

__host__ __device__ __forceinline__ int lds_byte(int r, int c) { const int st = (r >> 4) * 2 + (c >> 5), rr = r & 15, cc = c & 31, ob = rr * 64 + cc * 2; return st * 1024 + (ob ^ (((ob >> 9) & 1) << 5)); }
__host__ __device__ __forceinline__ void stage_rc(int b, int& R, int& C) { const int st = b / 1024, sb = b % 1024, swz = sb ^ (((sb >> 9) & 1) << 5); R = (st >> 1) * 16 + swz / 64; C = (st & 1) * 32 + (swz % 64) / 2; }
__host__ __device__ __forceinline__ int perm32(int rho) { const int n = rho >> 4, i = rho & 15; return 8 * (i >> 2) + 4 * n + (i & 3); }

struct Unit { int pm, pn, crow; size_t bofs, aofs; };
struct Gemm { const bf16_t* A; const bf16_t* Bm; int K, Np, Kloop; };

struct StaticOrder {
    int nM, nN, nwg, G, c;
    __device__ void init(int M, int N, int G_, int c_) { nM = M / BM; nN = N / BM; nwg = nM * nN; G = G_; c = c_; }
    __device__ __forceinline__ bool next(int i, Unit& u) const {
        const long L = (long)i * G + c; if (L >= nwg) return false;
        int wgid = (int)L; { const int q = nwg / NXCD, r = nwg % NXCD, xcd = wgid % NXCD, off = wgid / NXCD; wgid = (xcd < r ? xcd * (q + 1) : r * (q + 1) + (xcd - r) * q) + off; }
        const int nig = WGM * nN, gid = wgid / nig, fm = gid * WGM, gsz = (nM - fm) < WGM ? (nM - fm) : WGM;
        u.pm = fm + ((wgid % nig) % gsz); u.pn = (wgid % nig) / gsz; u.bofs = (size_t)u.pn * 512; u.crow = u.pm; u.aofs = 0; return true;
    }
};
struct MoeOrder {
    int nM, nN, nwg, G, c; const int* tileExp; size_t estride;
    __device__ void init(int nM_, int nN_, int G_, int c_, const int* te, int K_) { nM = nM_; nN = nN_; nwg = nM * nN; G = G_; c = c_; tileExp = te; estride = (size_t)K_ * nN_ * 512; }
    __device__ __forceinline__ bool next(int i, Unit& u) const {
        const long L = (long)i * G + c; if (L >= nwg) return false;
        int wgid = (int)L; { const int q = nwg / NXCD, r = nwg % NXCD, xcd = wgid % NXCD, off = wgid / NXCD; wgid = (xcd < r ? xcd * (q + 1) : r * (q + 1) + (xcd - r) * q) + off; }
        const int nig = WGM * nN, gid = wgid / nig, fm = gid * WGM, gsz = (nM - fm) < WGM ? (nM - fm) : WGM;
        u.pm = fm + ((wgid % nig) % gsz); u.pn = (wgid % nig) / gsz;
        const int e = __builtin_amdgcn_readfirstlane(tileExp[u.pm]); u.bofs = (size_t)e * estride + (size_t)u.pn * 512; u.crow = u.pm; u.aofs = 0; return true;
    }
};

struct MoeTailOrder {
    int tail0, nN, nwg, G, c; const int* tileExp; size_t estride; int Np;
    __device__ void init(int tail0_, int ntail, int nN_, int G_, int c_, const int* te, int K_, int Np_) { tail0 = tail0_; nN = nN_; nwg = ntail * nN_ * 8; G = G_; c = c_; tileExp = te; estride = (size_t)K_ * nN_ * 512; Np = Np_; }
    __device__ __forceinline__ bool next(int i, Unit& u) const {
        const long L = (long)i * G + c; if (L >= nwg) return false;
        const int kq = (int)L & 7, r = (int)L >> 3, pn = r % nN, tl = r / nN;
        u.pm = tail0 + tl; u.pn = pn; u.crow = kq * 8 + tl; u.aofs = (size_t)kq * 896 * 2;
        const int e = __builtin_amdgcn_readfirstlane(tileExp[u.pm]); u.bofs = (size_t)e * estride + (size_t)pn * 512 + (size_t)kq * 896 * Np * 2; return true;
    }
};

__device__ __forceinline__ unsigned cvt_pk_bf16(float lo, float hi) { unsigned r; asm volatile("v_cvt_pk_bf16_f32 %0, %1, %2" : "=v"(r) : "v"(lo), "v"(hi)); return r; }

struct EpiBf16Split {
    static constexpr bool PERM = true, ROWSCALE = true;
    bf16_t* O; int ldc; int split_cols; size_t split_stride; float scale; int scale_t; float gscale;
    const float* ssq; const PG8_LAS float* tab; float* rstd_out;
    __device__ __forceinline__ void operator()(const f32x4 (&acc)[2][2][4][2], const Unit& u, int wr, int wc, int fr, int fq) const {
        const int row0 = u.crow * BM + wr * 64 + fr; int colt = u.pn * BM; bf16_t* base = O;
        float sc = gscale; { const int t = colt / split_cols; base += (size_t)t * split_stride; colt -= t * split_cols; if (t == scale_t) sc *= scale; }
        const int col0 = colt + wc * 32 + 8 * fq;
#pragma unroll
        for (int ai = 0; ai < 2; ++ai)
#pragma unroll
            for (int m = 0; m < 4; ++m) { bf16_t* rowp = base + (size_t)(row0 + ai * HALF + m * 16) * ldc + col0;
#pragma unroll
                for (int bj = 0; bj < 2; ++bj) { const float sr = ssq ? sc * tab[ai * HALF + wr * 64 + m * 16 + fr] : sc; f32x4 v0 = acc[ai][bj][m][0] * sr, v1 = acc[ai][bj][m][1] * sr;
                    u32x4 w; w.x = cvt_pk_bf16(v0[0], v0[1]); w.y = cvt_pk_bf16(v0[2], v0[3]); w.z = cvt_pk_bf16(v1[0], v1[1]); w.w = cvt_pk_bf16(v1[2], v1[3]);
                    *(u32x4*)(rowp + bj * HALF) = w; } }
    }
};
struct EpiResBf16 {
    static constexpr bool PERM = true, ROWSCALE = false;
    bf16_t* O; int ldc; const float* basef; const bf16_t* baseh; float* ssq;
    __device__ __forceinline__ void operator()(const f32x4 (&acc)[2][2][4][2], const Unit& u, int wr, int wc, int fr, int fq) const {
        const int row0 = u.crow * BM + wr * 64 + fr, col0 = u.pn * BM + wc * 32 + 8 * fq;
#pragma unroll
        for (int ai = 0; ai < 2; ++ai)
#pragma unroll
            for (int m = 0; m < 4; ++m) { const size_t off = (size_t)(row0 + ai * HALF + m * 16) * ldc + col0; float sq = 0.f;
#pragma unroll
                for (int bj = 0; bj < 2; ++bj) { f32x4 v0 = acc[ai][bj][m][0], v1 = acc[ai][bj][m][1];
                    if (basef) { v0 += *(const f32x4*)(basef + off + bj * HALF); v1 += *(const f32x4*)(basef + off + bj * HALF + 4); }
                    else { const u32x4 b = *(const u32x4*)(baseh + off + bj * HALF);
                        v0 += (f32x4){__uint_as_float(b.x << 16), __uint_as_float(b.x & 0xffff0000u), __uint_as_float(b.y << 16), __uint_as_float(b.y & 0xffff0000u)};
                        v1 += (f32x4){__uint_as_float(b.z << 16), __uint_as_float(b.z & 0xffff0000u), __uint_as_float(b.w << 16), __uint_as_float(b.w & 0xffff0000u)}; }
                    u32x4 w; w.x = cvt_pk_bf16(v0[0], v0[1]); w.y = cvt_pk_bf16(v0[2], v0[3]); w.z = cvt_pk_bf16(v1[0], v1[1]); w.w = cvt_pk_bf16(v1[2], v1[3]);
                    *(u32x4*)(O + off + bj * HALF) = w;
                    if (ssq) {
                        const f32x4 r0 = {__uint_as_float(w.x << 16), __uint_as_float(w.x & 0xffff0000u), __uint_as_float(w.y << 16), __uint_as_float(w.y & 0xffff0000u)};
                        const f32x4 r1 = {__uint_as_float(w.z << 16), __uint_as_float(w.z & 0xffff0000u), __uint_as_float(w.w << 16), __uint_as_float(w.w & 0xffff0000u)};
                        sq += ((r0[0] * r0[0] + r0[1] * r0[1]) + (r0[2] * r0[2] + r0[3] * r0[3])) + ((r1[0] * r1[0] + r1[1] * r1[1]) + (r1[2] * r1[2] + r1[3] * r1[3])); } }
                if (ssq) { sq += __shfl_xor(sq, 16); sq += __shfl_xor(sq, 32); if (fq == 0) ssq[(size_t)(row0 + ai * HALF + m * 16) * 32 + 4 * u.pn + wc] = sq; } }
    }
};
struct EpiF32 {
    static constexpr bool PERM = false, ROWSCALE = false;
    float* C; int ldc; const float* base;
    __device__ __forceinline__ void operator()(const f32x4 (&acc)[2][2][4][2], const Unit& u, int wr, int wc, int fr, int fq) const {
        const int row0 = u.crow * BM + wr * 64 + fr, col0 = u.pn * BM + wc * 32 + 4 * fq;
#pragma unroll
        for (int ai = 0; ai < 2; ++ai)
#pragma unroll
            for (int m = 0; m < 4; ++m) { const size_t off = (size_t)(row0 + ai * HALF + m * 16) * ldc + col0;
#pragma unroll
                for (int bj = 0; bj < 2; ++bj)
#pragma unroll
                    for (int n = 0; n < 2; ++n) { f32x4 v = acc[ai][bj][m][n]; if (base) v += *(const f32x4*)(base + off + bj * HALF + n * 16); *(f32x4*)(C + off + bj * HALF + n * 16) = v; } }
    }
};
struct EpiSwiGLU {
    static constexpr bool PERM = true, ROWSCALE = true;
    bf16_t* O; int ldc; const float* ssq; const PG8_LAS float* tab; float* rstd_out;
    __device__ __forceinline__ static float act(float g, float u) { return g * __builtin_amdgcn_rcpf(1.0f + __builtin_amdgcn_exp2f(g * -1.4426950408889634f)) * u; }
    __device__ __forceinline__ void operator()(const f32x4 (&acc)[2][2][4][2], const Unit& u, int wr, int wc, int fr, int fq) const {
        const int row0 = u.crow * BM + wr * 64 + fr, col0 = u.pn * HALF + wc * 32 + 8 * fq;
#pragma unroll
        for (int ai = 0; ai < 2; ++ai)
#pragma unroll
            for (int m = 0; m < 4; ++m) { bf16_t* rowp = O + (size_t)(row0 + ai * HALF + m * 16) * ldc + col0;
                const float sr = ssq ? tab[ai * HALF + wr * 64 + m * 16 + fr] : 1.0f;
                const f32x4 g0 = acc[ai][0][m][0] * sr, g1 = acc[ai][0][m][1] * sr, u0 = acc[ai][1][m][0] * sr, u1 = acc[ai][1][m][1] * sr;
                u32x4 w; w.x = cvt_pk_bf16(act(g0[0], u0[0]), act(g0[1], u0[1])); w.y = cvt_pk_bf16(act(g0[2], u0[2]), act(g0[3], u0[3]));
                w.z = cvt_pk_bf16(act(g1[0], u1[0]), act(g1[1], u1[1])); w.w = cvt_pk_bf16(act(g1[2], u1[2]), act(g1[3], u1[3]));
                *(u32x4*)rowp = w; }
    }
};
template <class Epi> __device__ __forceinline__ void rowscale_prepare(const Epi& E, const Unit& u, int tid) {
    if (E.ssq) { const int row = tid >> 1, half = tid & 1; const f32x4* p = (const f32x4*)(E.ssq + ((size_t)u.pm * BM + row) * 32 + 16 * half);
        const f32x4 a = p[0], b = p[1], c = p[2], d = p[3]; float s = ((a[0] + a[1]) + (a[2] + a[3])) + ((b[0] + b[1]) + (b[2] + b[3])) + ((c[0] + c[1]) + (c[2] + c[3])) + ((d[0] + d[1]) + (d[2] + d[3]));
        s += __shfl_xor(s, 1); const float r = 1.0f / sqrtf(s * (1.0f / 2048.0f) + 1e-6f);
        if (half == 0) { ((PG8_LAS float*)E.tab)[row] = r; if (E.rstd_out && u.pn == 0) E.rstd_out[(size_t)u.pm * BM + row] = r; } }
}

struct NoBg { static constexpr bool ON = false; };
template <class Epi, class Sched, class BG = NoBg, bool ALIGN_EPI = true>
__device__ __forceinline__ void gemm_phase(PG8_LAS unsigned char* lds, const Gemm g, const Sched& S, const Epi& E, BG& bg) {
    constexpr bool HB = BG::ON;
    const int tid = threadIdx.x, wid = __builtin_amdgcn_readfirstlane(tid >> 6), lane = tid & 63, wr = wid >> 2, wc = wid & 3, fr = lane & 15, fq = lane >> 4;
    const int K = g.K, nt = g.Kloop / BK;
    unsigned voffA[2], voffB[2];
#pragma unroll
    for (int i = 0; i < 2; ++i) { int R, C; stage_rc(tid * 16 + i * 8192, R, C); voffA[i] = (unsigned)(R * K + C) * 2u;
        const int kk = 4 * wid + 32 * i + (lane >> 4), ch = (lane & 15) ^ (((kk & 3) << 2) | ((kk >> 2) & 3)); voffB[i] = (unsigned)(kk * g.Np + 8 * ch) * 2u; }
    const size_t kstep = (size_t)(BK * 2);
    const size_t hstep = (size_t)HALF * K * 2;
    const size_t tstep = 2 * hstep;
    const size_t kstepB = (size_t)BK * g.Np * 2, hstepB = 256;
    const unsigned ldsw = (unsigned)wid * 1024u;
    const int aoff = lds_byte(wr * 64 + fr, fq * 8);
    int bo[2][2];
    { const int q = fr >> 2, p = fr & 3;
#pragma unroll
      for (int n = 0; n < 2; ++n)
#pragma unroll
        for (int t = 0; t < 2; ++t) bo[n][t] = (int)(unsigned)(size_t)lds + 4 * HTB + 256 * (8 * fq + 4 * t + q) + 16 * (((wc ^ q) << 2) | ((n ^ (fq & 1)) << 1) | ((p >> 1) ^ t)) + 8 * (p & 1); }
#define PG8_SA(b, h) (((b) * 2 + (h)) * HTB)
#define PG8_SB(b, h) ((4 + (b) * 2 + (h)) * HTB)
#define PG8_STAGE(bufoff, gbase, voff) do { _Pragma("unroll") for (int _i = 0; _i < 2; ++_i) \
        __builtin_amdgcn_global_load_lds((const unsigned*)((const char*)(gbase) + (voff)[_i]), (PG8_LAS unsigned*)(lds + (bufoff) + ldsw + _i * 8192), 16, 0, 0); } while (0)
#define PG8_LDA(dst, b, h) do { _Pragma("unroll") for (int m = 0; m < 4; ++m) _Pragma("unroll") for (int k = 0; k < 2; ++k) dst[m][k] = *(const PG8_LAS bf16x8*)(lds + PG8_SA(b, h) + aoff + m * 2048 + k * 1024); } while (0)
#define PG8_TR(dst, addr, off) asm volatile("ds_read_b64_tr_b16 %0, %1 offset:%2" : "=&v"(dst) : "v"(addr), "i"(off) : "memory")
#define PG8_LDB(dst, b, h) do { _Pragma("unroll") for (int n = 0; n < 2; ++n) _Pragma("unroll") for (int k = 0; k < 2; ++k) { s16x4 t0_, t1_; \
        PG8_TR(t0_, bo[n][0], ((b) * 2 + (h)) * HTB + k * 8192); PG8_TR(t1_, bo[n][1], ((b) * 2 + (h)) * HTB + k * 8192); \
        dst[n][k] = (bf16x8){t0_[0], t0_[1], t0_[2], t0_[3], t1_[0], t1_[1], t1_[2], t1_[3]}; } } while (0)
#define PG8_MMA(ai, bj, At, Bt) do { __builtin_amdgcn_s_setprio(1); _Pragma("unroll") for (int m = 0; m < 4; ++m) _Pragma("unroll") for (int n = 0; n < 2; ++n) _Pragma("unroll") for (int k = 0; k < 2; ++k) \
        acc[ai][bj][m][n] = __builtin_amdgcn_mfma_f32_16x16x32_bf16(Bt[n][k], At[m][k], acc[ai][bj][m][n], 0, 0, 0); __builtin_amdgcn_s_setprio(0); } while (0)
#define PG8_WAIT_V(n) asm volatile("s_waitcnt vmcnt(" #n ")" ::: "memory")
#define PG8_WAIT_L(n) asm volatile("s_waitcnt lgkmcnt(" #n ")" ::: "memory")
#define PG8_BAR __builtin_amdgcn_s_barrier()
#define PG8_SCHED __builtin_amdgcn_sched_barrier(0)
    Unit cur, nxt; int ui = 0;
    if (!S.next(0, cur)) return;
    f32x4 acc[2][2][4][2];
#pragma unroll
    for (int a = 0; a < 2; ++a)
#pragma unroll
        for (int b = 0; b < 2; ++b)
#pragma unroll
            for (int m = 0; m < 4; ++m)
#pragma unroll
                for (int n = 0; n < 2; ++n) acc[a][b][m][n] = (f32x4){0.f, 0.f, 0.f, 0.f};
    bf16x8 At[4][2], B0[2][2], B1[2][2];
    const char* cA = (const char*)g.A + (size_t)cur.pm * tstep + cur.aofs; const char* cB = (const char*)g.Bm + cur.bofs;
    PG8_STAGE(PG8_SB(0, 0), cB, voffB); PG8_STAGE(PG8_SB(0, 1), cB + hstepB, voffB); PG8_STAGE(PG8_SA(0, 0), cA, voffA); PG8_STAGE(PG8_SA(0, 1), cA + hstep, voffA);
    if (wr == 1) PG8_BAR;
    PG8_WAIT_V(2); PG8_BAR;
    PG8_STAGE(PG8_SB(1, 0), cB + kstepB, voffB); PG8_STAGE(PG8_SA(1, 0), cA + kstep, voffA); PG8_STAGE(PG8_SB(1, 1), cB + hstepB + kstepB, voffB);
    PG8_WAIT_V(6); PG8_BAR;
    for (;;) {
        const bool has_next = S.next(ui + 1, nxt);
        const char* nA = has_next ? (const char*)g.A + (size_t)nxt.pm * tstep + nxt.aofs : cA; const char* nB = has_next ? (const char*)g.Bm + nxt.bofs : cB;
        for (int t = 0; t < nt; t += 2) {
            const bool last = (t == nt - 2);
            const char* a1 = cA + (size_t)(t + 1) * kstep;
            const char* a2 = last ? nA : cA + (size_t)(t + 2) * kstep; const char* b2 = last ? nB : cB + (size_t)(t + 2) * kstepB;
            const char* a3 = a2 + kstep; const char* b3 = b2 + kstepB;
            PG8_LDB(B0, 0, 0); PG8_LDB(B1, 0, 1); PG8_SCHED; PG8_LDA(At, 0, 0); PG8_STAGE(PG8_SA(1, 1), a1 + hstep, voffA);
            PG8_WAIT_V(8); PG8_WAIT_L(0); PG8_BAR; PG8_MMA(0, 0, At, B0); PG8_MMA(0, 1, At, B1); PG8_BAR; PG8_SCHED;
            PG8_LDA(At, 0, 1); PG8_STAGE(PG8_SB(0, 0), b2, voffB); PG8_STAGE(PG8_SB(0, 1), b2 + hstepB, voffB); PG8_STAGE(PG8_SA(0, 0), a2, voffA);
            PG8_WAIT_V(8); PG8_WAIT_L(0); PG8_BAR; PG8_MMA(1, 0, At, B0); PG8_MMA(1, 1, At, B1); PG8_BAR; PG8_SCHED;
            PG8_LDB(B0, 1, 0); PG8_LDB(B1, 1, 1); PG8_SCHED; PG8_LDA(At, 1, 0); PG8_STAGE(PG8_SA(0, 1), a2 + hstep, voffA);
            PG8_WAIT_V(8); PG8_WAIT_L(0); PG8_BAR; PG8_MMA(0, 0, At, B0); PG8_MMA(0, 1, At, B1); PG8_BAR; PG8_SCHED;
            PG8_LDA(At, 1, 1); PG8_STAGE(PG8_SB(1, 0), b3, voffB); PG8_STAGE(PG8_SB(1, 1), b3 + hstepB, voffB); PG8_STAGE(PG8_SA(1, 0), a3, voffA);
            PG8_WAIT_V(8); PG8_WAIT_L(0); PG8_BAR; PG8_MMA(1, 0, At, B0); PG8_MMA(1, 1, At, B1); PG8_BAR; PG8_SCHED;
        }
        if constexpr (ALIGN_EPI) { if (wr == 0) PG8_BAR; }
        if constexpr (Epi::ROWSCALE) { rowscale_prepare(E, cur, tid); asm volatile("s_waitcnt lgkmcnt(0)" ::: "memory"); PG8_BAR; asm volatile("" ::: "memory"); }
        if constexpr (HB) {
            typename BG::Burst bb; f32x4 xb[16];
            (void)bg.burst_begin(bb);
#pragma unroll
            for (int i = 0; i < 16; ++i) xb[i] = bg.burst_load(bb, i);
            asm volatile("" ::: "memory");
            E(acc, cur, wr, wc, fr, fq);
            asm volatile("" ::: "memory");
            const typename BG::gain16 gg = bg.burst_gains(bb);
#pragma unroll
            for (int i = 0; i < 16; ++i) bg.burst_store(bb, i, xb[i], gg[i]);
        } else
        E(acc, cur, wr, wc, fr, fq);
        if (!has_next) break;
#pragma unroll
        for (int a = 0; a < 2; ++a)
#pragma unroll
            for (int b = 0; b < 2; ++b)
#pragma unroll
                for (int m = 0; m < 4; ++m)
#pragma unroll
                    for (int n = 0; n < 2; ++n) acc[a][b][m][n] = (f32x4){0.f, 0.f, 0.f, 0.f};
        cur = nxt; cA = nA; cB = nB; ++ui;
        if constexpr (ALIGN_EPI) { if (wr == 1) PG8_BAR; }
    }
    PG8_WAIT_V(0);
    if constexpr (!ALIGN_EPI) { if (wr == 0) PG8_BAR; }
    PG8_BAR;
#undef PG8_SA
#undef PG8_SB
#undef PG8_STAGE
#undef PG8_LDA
#undef PG8_LDB
#undef PG8_TR
#undef PG8_MMA
#undef PG8_WAIT_V
#undef PG8_WAIT_L
#undef PG8_BAR
#undef PG8_SCHED
}
typedef int i32x8 __attribute__((ext_vector_type(8)));
struct StaticOrder8 : StaticOrder {
    size_t tstride;
    __device__ void init8(int M, int N, int G_, int c_, int Kbytes) { init(M, N, G_, c_); tstride = (size_t)256 * Kbytes; }
    __device__ __forceinline__ bool next(int i, Unit& u) const { if (!StaticOrder::next(i, u)) return false; u.bofs = (size_t)u.pn * tstride; return true; }
};
struct MoeOrder8 {
    int nM, nN, nwg, G, c; const int* tileExp; size_t estride, tstride;
    __device__ void init(int nM_, int nN_, int G_, int c_, const int* te, int Kbytes) { nM = nM_; nN = nN_; nwg = nM * nN; G = G_; c = c_; tileExp = te; tstride = (size_t)256 * Kbytes; estride = (size_t)nN_ * tstride; }
    __device__ __forceinline__ bool next(int i, Unit& u) const {
        const long L = (long)i * G + c; if (L >= nwg) return false;
        int wgid = (int)L; { const int q = nwg / NXCD, r = nwg % NXCD, xcd = wgid % NXCD, off = wgid / NXCD; wgid = (xcd < r ? xcd * (q + 1) : r * (q + 1) + (xcd - r) * q) + off; }
        const int nig = WGM * nN, gid = wgid / nig, fm = gid * WGM, gsz = (nM - fm) < WGM ? (nM - fm) : WGM;
        u.pm = fm + ((wgid % nig) % gsz); u.pn = (wgid % nig) / gsz; u.crow = u.pm; u.aofs = 0;
        const int e = __builtin_amdgcn_readfirstlane(tileExp[u.pm]); u.bofs = (size_t)e * estride + (size_t)u.pn * tstride; return true;
    }
};
struct MoeTailOrder8 {
    int tail0, nN, nwg, G, c; const int* tileExp; size_t estride, tstride;
    __device__ void init(int tail0_, int ntail, int nN_, int G_, int c_, const int* te, int Kbytes) { tail0 = tail0_; nN = nN_; nwg = ntail * nN_ * 7; G = G_; c = c_; tileExp = te; tstride = (size_t)256 * Kbytes; estride = (size_t)nN_ * tstride; }
    __device__ __forceinline__ bool next(int i, Unit& u) const {
        const long L = (long)i * G + c; if (L >= nwg) return false;
        const int kq = (int)L % 7, r = (int)L / 7, pn = r % nN, tl = r / nN;
        u.pm = tail0 + tl; u.pn = pn; u.crow = kq * 8 + tl; u.aofs = (size_t)kq * 1024;
        const int e = __builtin_amdgcn_readfirstlane(tileExp[u.pm]); u.bofs = (size_t)e * estride + (size_t)pn * tstride + (size_t)kq * 1024; return true;
    }
};
__device__ __forceinline__ unsigned pk4_fp8(float a, float b, float c, float d) {
    a = __builtin_amdgcn_fmed3f(a, -448.f, 448.f); b = __builtin_amdgcn_fmed3f(b, -448.f, 448.f); c = __builtin_amdgcn_fmed3f(c, -448.f, 448.f); d = __builtin_amdgcn_fmed3f(d, -448.f, 448.f);
    int w = __builtin_amdgcn_cvt_pk_fp8_f32(a, b, 0, false); w = __builtin_amdgcn_cvt_pk_fp8_f32(c, d, w, true); return (unsigned)w; }
struct EpiSwiGLU8 {
    static constexpr bool PERM = true;
    unsigned char* O; int ldc; float sin, sout;
    __device__ __forceinline__ float act(float g, float u) const { g *= sin; return g * __builtin_amdgcn_rcpf(1.0f + __builtin_amdgcn_exp2f(g * -1.4426950408889634f)) * (u * (sin * sout)); }
    __device__ __forceinline__ void operator()(const f32x4 (&acc)[2][2][4][2], const Unit& u, int wr, int wc, int fr, int fq) const {
        const int row0 = u.crow * BM + wr * 64 + fr, col0 = u.pn * HALF + wc * 32 + 8 * fq;
#pragma unroll
        for (int ai = 0; ai < 2; ++ai)
#pragma unroll
            for (int m = 0; m < 4; ++m) { unsigned char* rowp = O + (size_t)(row0 + ai * HALF + m * 16) * ldc + col0;
                const f32x4 g0 = acc[ai][0][m][0], g1 = acc[ai][0][m][1], u0 = acc[ai][1][m][0], u1 = acc[ai][1][m][1];
                u32x2 w; w.x = pk4_fp8(act(g0[0], u0[0]), act(g0[1], u0[1]), act(g0[2], u0[2]), act(g0[3], u0[3])); w.y = pk4_fp8(act(g1[0], u1[0]), act(g1[1], u1[1]), act(g1[2], u1[2]), act(g1[3], u1[3]));
                *(u32x2*)rowp = w; }
    }
};
struct EpiF32s {
    static constexpr bool PERM = false;
    float* C; int ldc; float scale;
    __device__ __forceinline__ void operator()(const f32x4 (&acc)[2][2][4][2], const Unit& u, int wr, int wc, int fr, int fq) const {
        const int row0 = u.crow * BM + wr * 64 + fr, col0 = u.pn * BM + wc * 32 + 4 * fq;
#pragma unroll
        for (int ai = 0; ai < 2; ++ai)
#pragma unroll
            for (int m = 0; m < 4; ++m) { const size_t off = (size_t)(row0 + ai * HALF + m * 16) * ldc + col0;
#pragma unroll
                for (int bj = 0; bj < 2; ++bj)
#pragma unroll
                    for (int n = 0; n < 2; ++n) *(f32x4*)(C + off + bj * HALF + n * 16) = acc[ai][bj][m][n] * scale; }
    }
};
template <class Epi, class Sched, bool ALIGN_EPI = true>
__device__ __forceinline__ void gemm_phase_f8(PG8_LAS unsigned char* lds, const Gemm g, const Sched& S, const Epi& E) {
    int tid = threadIdx.x; asm volatile("" : "+v"(tid));
    const int wid = __builtin_amdgcn_readfirstlane(tid >> 6), lane = tid & 63, wr = wid >> 2, wc = wid & 3, fr = lane & 15, fq = lane >> 4;
    const int K = g.K; int nt = g.Kloop / BK; asm volatile("" : "+s"(nt));
    unsigned voffA[2], voffB[2];
#pragma unroll
    for (int i = 0; i < 2; ++i) { int R, C; stage_rc(tid * 16 + i * 8192, R, C); const int Rb = Epi::PERM ? ((R & ~31) + perm32(R & 31)) : R;
        voffA[i] = (unsigned)(R * K + C) * 2u; voffB[i] = (unsigned)(Rb * K + C) * 2u; }
    const size_t kstep = (size_t)(BK * 2);
    const size_t hstep = (size_t)HALF * K * 2;
    const size_t tstep = 2 * hstep;
    const unsigned ldsb = (unsigned)(size_t)lds + (unsigned)wid * 1024u;
    const int aoff = lds_byte(wr * 64 + fr, (fq >> 1) * 32 + (fq & 1) * 16), boff = lds_byte(wc * 32 + fr, (fq >> 1) * 32 + (fq & 1) * 16);
#define PG8_SA(b, h) (((b) * 2 + (h)) * HTB)
#define PG8_SB(b, h) ((4 + (b) * 2 + (h)) * HTB)
#define PG8_GLDS(off32, base64, ldsaddr) do { unsigned keep_; asm volatile("s_mov_b32 %0, m0\n\ts_mov_b32 m0, %3\n\ts_nop 1\n\tglobal_load_lds_dwordx4 %1, %2\n\ts_mov_b32 m0, %0" \
        : "=&s"(keep_) : "v"(off32), "s"(base64), "s"(ldsaddr) : "memory"); } while (0)
#define PG8_STAGE(bufoff, gbase, voff) do { _Pragma("unroll") for (int _i = 0; _i < 2; ++_i) PG8_GLDS((voff)[_i], (const char*)(gbase), ldsb + (unsigned)((bufoff) + _i * 8192)); } while (0)
#define PG8_LDA(dst, b, h) do { _Pragma("unroll") for (int m = 0; m < 4; ++m) { const u32x4 lo_ = *(const PG8_LAS u32x4*)(lds + PG8_SA(b, h) + aoff + m * 2048), hi_ = *(const PG8_LAS u32x4*)(lds + PG8_SA(b, h) + aoff + m * 2048 + 16); \
        dst[m] = (i32x8){(int)lo_[0], (int)lo_[1], (int)lo_[2], (int)lo_[3], (int)hi_[0], (int)hi_[1], (int)hi_[2], (int)hi_[3]}; } } while (0)
#define PG8_LDB(dst, b, h) do { _Pragma("unroll") for (int n = 0; n < 2; ++n) { const u32x4 lo_ = *(const PG8_LAS u32x4*)(lds + PG8_SB(b, h) + boff + n * 2048), hi_ = *(const PG8_LAS u32x4*)(lds + PG8_SB(b, h) + boff + n * 2048 + 16); \
        dst[n] = (i32x8){(int)lo_[0], (int)lo_[1], (int)lo_[2], (int)lo_[3], (int)hi_[0], (int)hi_[1], (int)hi_[2], (int)hi_[3]}; } } while (0)
#define PG8_MMA(ai, bj, At, Bt) do { __builtin_amdgcn_s_setprio(1); _Pragma("unroll") for (int m = 0; m < 4; ++m) _Pragma("unroll") for (int n = 0; n < 2; ++n) \
        asm volatile("v_mfma_f32_16x16x128_f8f6f4 %0, %1, %2, %0" : "+v"(acc[ai][bj][m][n]) : "v"(Bt[n]), "v"(At[m])); __builtin_amdgcn_s_setprio(0); } while (0)
#define PG8_WAIT_V(n) asm volatile("s_waitcnt vmcnt(" #n ")" ::: "memory")
#define PG8_WAIT_L(n) asm volatile("s_waitcnt lgkmcnt(" #n ")" ::: "memory")
#define PG8_BAR __builtin_amdgcn_s_barrier()
#define PG8_SCHED __builtin_amdgcn_sched_barrier(0)
    Unit cur, nxt; int ui = 0;
    if (!S.next(0, cur)) return;
    f32x4 acc[2][2][4][2];
#pragma unroll
    for (int a = 0; a < 2; ++a)
#pragma unroll
        for (int b = 0; b < 2; ++b)
#pragma unroll
            for (int m = 0; m < 4; ++m)
#pragma unroll
                for (int n = 0; n < 2; ++n) acc[a][b][m][n] = (f32x4){0.f, 0.f, 0.f, 0.f};
    i32x8 At[4], B0[2], B1[2];
    const char* cA = (const char*)g.A + (size_t)cur.pm * tstep + cur.aofs; const char* cB = (const char*)g.Bm + cur.bofs;
    PG8_STAGE(PG8_SB(0, 0), cB, voffB); PG8_STAGE(PG8_SB(0, 1), cB + hstep, voffB); PG8_STAGE(PG8_SA(0, 0), cA, voffA); PG8_STAGE(PG8_SA(0, 1), cA + hstep, voffA);
    if (wr == 1) PG8_BAR;
    PG8_WAIT_V(2); PG8_BAR;
    PG8_STAGE(PG8_SB(1, 0), cB + kstep, voffB); PG8_STAGE(PG8_SA(1, 0), cA + kstep, voffA); PG8_STAGE(PG8_SB(1, 1), cB + hstep + kstep, voffB);
    PG8_WAIT_V(6); PG8_BAR;
    for (;;) {
        const bool has_next = S.next(ui + 1, nxt);
        const char* nA = has_next ? (const char*)g.A + (size_t)nxt.pm * tstep + nxt.aofs : cA; const char* nB = has_next ? (const char*)g.Bm + nxt.bofs : cB;
        for (int t = 0; t < nt; t += 2) {
            const bool last = (t == nt - 2);
            const char* a1 = cA + (size_t)(t + 1) * kstep;
            const char* a2 = last ? nA : cA + (size_t)(t + 2) * kstep; const char* b2 = last ? nB : cB + (size_t)(t + 2) * kstep;
            const char* a3 = a2 + kstep; const char* b3 = b2 + kstep;
            PG8_LDB(B0, 0, 0); PG8_LDB(B1, 0, 1); PG8_SCHED; PG8_LDA(At, 0, 0); PG8_STAGE(PG8_SA(1, 1), a1 + hstep, voffA);
            PG8_WAIT_V(8); PG8_WAIT_L(0); PG8_BAR; PG8_MMA(0, 0, At, B0); PG8_MMA(0, 1, At, B1); PG8_BAR; PG8_SCHED;
            PG8_LDA(At, 0, 1); PG8_STAGE(PG8_SB(0, 0), b2, voffB); PG8_STAGE(PG8_SB(0, 1), b2 + hstep, voffB); PG8_STAGE(PG8_SA(0, 0), a2, voffA);
            PG8_WAIT_V(8); PG8_WAIT_L(0); PG8_BAR; PG8_MMA(1, 0, At, B0); PG8_MMA(1, 1, At, B1); PG8_BAR; PG8_SCHED;
            PG8_LDB(B0, 1, 0); PG8_LDB(B1, 1, 1); PG8_SCHED; PG8_LDA(At, 1, 0); PG8_STAGE(PG8_SA(0, 1), a2 + hstep, voffA);
            PG8_WAIT_V(8); PG8_WAIT_L(0); PG8_BAR; PG8_MMA(0, 0, At, B0); PG8_MMA(0, 1, At, B1); PG8_BAR; PG8_SCHED;
            PG8_LDA(At, 1, 1); PG8_STAGE(PG8_SB(1, 0), b3, voffB); PG8_STAGE(PG8_SB(1, 1), b3 + hstep, voffB); PG8_STAGE(PG8_SA(1, 0), a3, voffA);
            PG8_WAIT_V(8); PG8_WAIT_L(0); PG8_BAR; PG8_MMA(1, 0, At, B0); PG8_MMA(1, 1, At, B1); PG8_BAR; PG8_SCHED;
        }
        asm volatile("s_nop 15\n\ts_nop 15" ::: "memory");
        if constexpr (ALIGN_EPI) { if (wr == 0) PG8_BAR; }
        E(acc, cur, wr, wc, fr, fq);
        if (!has_next) break;
#pragma unroll
        for (int a = 0; a < 2; ++a)
#pragma unroll
            for (int b = 0; b < 2; ++b)
#pragma unroll
                for (int m = 0; m < 4; ++m)
#pragma unroll
                    for (int n = 0; n < 2; ++n) acc[a][b][m][n] = (f32x4){0.f, 0.f, 0.f, 0.f};
        cur = nxt; cA = nA; cB = nB; ++ui;
        if constexpr (ALIGN_EPI) { if (wr == 1) PG8_BAR; }
    }
    PG8_WAIT_V(0);
    if constexpr (!ALIGN_EPI) { if (wr == 0) PG8_BAR; }
    PG8_BAR;
#undef PG8_SA
#undef PG8_SB
#undef PG8_STAGE
#undef PG8_GLDS
#undef PG8_LDA
#undef PG8_LDB
#undef PG8_MMA
#undef PG8_WAIT_V
#undef PG8_WAIT_L
#undef PG8_BAR
#undef PG8_SCHED
}
}
namespace att {
#define ATT_LAS __attribute__((address_space(3)))
typedef unsigned short bf16_t;
typedef short bf16x8 __attribute__((ext_vector_type(8)));
typedef short s16x4 __attribute__((ext_vector_type(4)));
typedef float f32x16 __attribute__((ext_vector_type(16)));
typedef float f32x4 __attribute__((ext_vector_type(4)));
typedef unsigned u32x4 __attribute__((ext_vector_type(4)));
constexpr int S = 2048, PITCH = 2048, D = 128, NW = 8, QBLK = 32, KVBLK = 64, QB = NW * QBLK;
constexpr int SHM_V = KVBLK * D * 2, SHM_K = KVBLK * D * 2;
constexpr int NKB = 4;
constexpr int OFF_V = 0, OFF_K = NKB * SHM_V, OFF_WS = NKB * SHM_V + NKB * SHM_K, OFF_BIAS = OFF_WS + NW * 64 * 4, OFF_SCAN = OFF_BIAS + S * 4, LDS_BYTES = OFF_SCAN + 64;
#define KSWZ(row, colB) ((row) * 256 + ((colB) ^ (((row) & 7) << 4)))
#define SBAR() __builtin_amdgcn_sched_barrier(0)
__device__ __forceinline__ int v_st(int k, int c) { const int kk = (k & ~0xC) | ((k & 4) << 1) | ((k & 8) >> 1); return ((kk >> 3) * 4 + (c >> 5)) * 512 + ((kk & 7) * 32 + (c & 31)) * 2; }
__device__ __forceinline__ int v_rd_base(int lane) { return ((lane & 3) << 3) | (((lane >> 2) & 3) << 6) | (((lane >> 4) & 1) << 5) | (((lane >> 5) & 1) << 8); }
constexpr int v_rd_off(int d0, int ks, int half) { return d0 * 512 + ks * 4096 + half * 2048; }
__device__ __forceinline__ int crow(int r, int hi) { return (r & 3) + 8 * (r >> 2) + 4 * hi; }
__device__ __forceinline__ unsigned cvtpk(float lo, float hi) { unsigned r; asm volatile("v_cvt_pk_bf16_f32 %0, %1, %2" : "=v"(r) : "v"(lo), "v"(hi)); return r; }

__device__ __forceinline__ void qkt(f32x16& p0, f32x16& p1, const ATT_LAS char* Kt, int r32, int hi, const bf16x8* qr) {
    p0 = f32x16{}; p1 = f32x16{};
    const ATT_LAS char* kb[4];
#pragma unroll
    for (int dd = 0; dd < 4; ++dd) kb[dd] = Kt + KSWZ(r32, (dd * 16 + hi * 8) * 2);
#pragma unroll
    for (int d0 = 0; d0 < 8; ++d0) { const ATT_LAS char* a = kb[d0 & 3] + (d0 >> 2) * 128;
        bf16x8 b0 = *reinterpret_cast<const ATT_LAS bf16x8*>(a);
        bf16x8 b1 = *reinterpret_cast<const ATT_LAS bf16x8*>(a + 32 * 256);
        p0 = __builtin_amdgcn_mfma_f32_32x32x16_bf16(b0, qr[d0], p0, 0, 0, 0);
        p1 = __builtin_amdgcn_mfma_f32_32x32x16_bf16(b1, qr[d0], p1, 0, 0, 0); }
}
__device__ __forceinline__ void pv_tile(f32x16* o, int vb0, bf16x8 pa0, bf16x8 pa1, bf16x8 pa2, bf16x8 pa3) {
#define TRRD(dst, off) asm volatile("ds_read_b64_tr_b16 %0, %1 offset:%2" : "=&v"(dst) : "v"(vb0), "i"(off) : "memory")
#define PV_D0(d0) do { s16x4 l0, l1, l2, l3, h0, h1, h2, h3; constexpr int b_ = v_rd_off(d0, 0, 0); \
        TRRD(l0, b_); TRRD(h0, b_ + 2048); TRRD(l1, b_ + 4096); TRRD(h1, b_ + 6144); TRRD(l2, b_ + 8192); TRRD(h2, b_ + 10240); TRRD(l3, b_ + 12288); TRRD(h3, b_ + 14336); \
        asm volatile("s_waitcnt lgkmcnt(0)" ::: "memory"); SBAR(); \
        o[d0] = __builtin_amdgcn_mfma_f32_32x32x16_bf16(pa0, (bf16x8){l0[0], l0[1], l0[2], l0[3], h0[0], h0[1], h0[2], h0[3]}, o[d0], 0, 0, 0);   \
        o[d0] = __builtin_amdgcn_mfma_f32_32x32x16_bf16(pa1, (bf16x8){l1[0], l1[1], l1[2], l1[3], h1[0], h1[1], h1[2], h1[3]}, o[d0], 0, 0, 0);   \
        o[d0] = __builtin_amdgcn_mfma_f32_32x32x16_bf16(pa2, (bf16x8){l2[0], l2[1], l2[2], l2[3], h2[0], h2[1], h2[2], h2[3]}, o[d0], 0, 0, 0);   \
        o[d0] = __builtin_amdgcn_mfma_f32_32x32x16_bf16(pa3, (bf16x8){l3[0], l3[1], l3[2], l3[3], h3[0], h3[1], h3[2], h3[3]}, o[d0], 0, 0, 0); } while (0)
    PV_D0(0); PV_D0(1); PV_D0(2); PV_D0(3);
#undef PV_D0
#undef TRRD
}
#define ATT_PK4(P, B_, OUT) do { unsigned a0 = cvtpk(P[B_+0], P[B_+1]), a1 = cvtpk(P[B_+2], P[B_+3]);                          \
        unsigned b0 = cvtpk(P[B_+4], P[B_+5]), b1 = cvtpk(P[B_+6], P[B_+7]);                                             \
        auto r0 = __builtin_amdgcn_permlane32_swap(a0, b0, false, false); auto r1 = __builtin_amdgcn_permlane32_swap(a1, b1, false, false); \
        u32x4 w = {r0[0], r1[0], r0[1], r1[1]}; OUT = *reinterpret_cast<bf16x8*>(&w); } while (0)

constexpr int OFF_STAGE = OFF_SCAN + 64, STAGE_PER_WAVE = 0;
template <bool FOX, class BG, int NH = 1>
__device__ __forceinline__ void attn_block(ATT_LAS char* lds, const bf16_t* Qg, const bf16_t* Kg, const bf16_t* Vg, bf16_t* Og, int b, int h, int qb, BG& bg) {
    int tid = threadIdx.x; asm volatile("" : "+v"(tid));
    const int wid = __builtin_amdgcn_readfirstlane(tid >> 6), lane = tid & 63, r32 = lane & 31, hi = lane >> 5;
    const size_t hb = (size_t)b * S * PITCH + (size_t)h * D;
    const bf16_t* Qp = Qg + hb; const bf16_t* Kp = Kg + hb; const bf16_t* Vp = Vg + hb; bf16_t* Op = Og + hb;
    const int P0 = qb * QB, qlo = P0 + wid * QBLK, NT = 4 * (qb + 1);
    bf16x8 qr[8];
#pragma unroll
    for (int d0 = 0; d0 < 8; ++d0) qr[d0] = *(const bf16x8*)(Qp + (size_t)(qlo + r32) * PITCH + d0 * 16 + hi * 8);
    unsigned koff[2], voff[2];
#pragma unroll
    for (int i = 0; i < 2; ++i) { const int j = 2 * wid + i;
        { const int row = 4 * j + (lane >> 4), c = (lane & 15) ^ (row & 7); koff[i] = (unsigned)(row * PITCH + 8 * c) * 2u; }
        { const int sub = 2 * j + (lane >> 5), kk = 8 * (sub >> 2) + ((lane & 31) >> 2), c = 32 * (sub & 3) + 8 * (lane & 3), k = (kk & ~0xC) | ((kk & 4) << 1) | ((kk & 8) >> 1); voff[i] = (unsigned)(k * PITCH + c) * 2u; } }
    ATT_LAS char* V_lds = lds + OFF_V; ATT_LAS char* K_lds = lds + OFF_K;
    ATT_LAS float* wsf = (ATT_LAS float*)(lds + OFF_WS) + wid * 64; ATT_LAS float* li_l = wsf; ATT_LAS float* al_l = wsf + 32;
    const ATT_LAS float* biasL = (const ATT_LAS float*)(lds + OFF_BIAS);
    const int vbase = (int)(unsigned)(size_t)V_lds + v_rd_base(lane);
    float m_reg = -1e30f, l_reg = 0.f, R2 = 0.f; f32x16 o[4] = {};
    typename BG::Burst bbC, bbP; bg.burst_begin_n(bbC, 0); bbP = bbC; bool isC = false, isP = false; f32x4 hv[4] = {};
    typename BG::Burst bbD; bg.burst_begin_n(bbD, 0); bool isD = false; f32x4 hw[4] = {};
#define TILEJ(t) (FOX ? (t) : (NT - 1 - (t)))
#define LOADT(j, bf) do { const char* kt_ = (const char*)(Kp + (size_t)(j) * KVBLK * PITCH); const char* vt_ = (const char*)(Vp + (size_t)(j) * KVBLK * PITCH); \
        _Pragma("unroll") for (int i_ = 0; i_ < 2; ++i_) { \
            __builtin_amdgcn_global_load_lds((const unsigned*)(kt_ + koff[i_]), (ATT_LAS unsigned*)(K_lds + (bf) * SHM_K + (2 * wid + i_) * 1024), 16, 0, 0); \
            __builtin_amdgcn_global_load_lds((const unsigned*)(vt_ + voff[i_]), (ATT_LAS unsigned*)(V_lds + (bf) * SHM_V + (2 * wid + i_) * 1024), 16, 0, 0); } } while (0)
    static_assert(!BG::ON || BG::REG, "register-staged hosting only");
    bool wdone = false; ATT_LAS int* donef = (ATT_LAS int*)(lds + OFF_SCAN);
    LOADT(TILEJ(0), 0); LOADT(TILEJ(1), 1); asm volatile("s_waitcnt vmcnt(0)" ::: "memory"); __syncthreads();
    for (int t = 0; t < NT; ++t) {
        if ((t & 1) == 0 && t + 2 < NT) { LOADT(TILEJ(t + 2), (t + 2) & 3); LOADT(TILEJ(t + 3), (t + 3) & 3); }
        bbP = bbC; isP = isC; isC = bg.live;
        if (isC) { bg.burst_begin_n(bbC, 4);
            if constexpr (BG::REG) {
#pragma unroll
                for (int i = 0; i < 4; ++i) hv[i] = bg.burst_ld(bbC, i);
                if constexpr (NH == 2) { isD = bg.live; if (isD) { bg.burst_begin_n(bbD, 4);
#pragma unroll
                    for (int i = 0; i < 4; ++i) hw[i] = bg.burst_ld(bbD, i); } }
            } else {
#pragma unroll
            for (int i = 0; i < 4; ++i) bg.burst_dma(bbC, i, (ATT_LAS unsigned char*)(lds + OFF_STAGE + wid * STAGE_PER_WAVE + (t & 1) * 4096 + i * 1024)); } }
        const int bufi = t & 3, kb = TILEJ(t) * KVBLK;
        if (!wdone && kb <= qlo + QBLK - 1) {
            f32x16 p0, p1; bf16x8 pa0, pa1, pa2, pa3;
            qkt(p0, p1, K_lds + bufi * SHM_K, r32, hi, qr);
            const int dq = qlo + r32 - kb - 4 * hi;
            if constexpr (FOX) {
                const ATT_LAS float* bp = biasL + kb + 4 * hi;
#pragma unroll
                for (int i = 0; i < 4; ++i) { const f32x4 b0 = *(const ATT_LAS f32x4*)(bp + 8 * i), b1 = *(const ATT_LAS f32x4*)(bp + 32 + 8 * i);
#pragma unroll
                    for (int j = 0; j < 4; ++j) { p0[4 * i + j] += b0[j]; p1[4 * i + j] += b1[j]; } }
                if (kb + KVBLK - 1 > qlo) {
                    const float NEG = -__builtin_inff();
#pragma unroll
                    for (int r = 0; r < 16; ++r) { const int c = (r & 3) + 8 * (r >> 2); if (c > dq) p0[r] = NEG; if (c + 32 > dq) p1[r] = NEG; }
                }
                float pmax = p0[0];
#pragma unroll
                for (int r = 1; r < 16; ++r) pmax = fmaxf(pmax, p0[r]);
#pragma unroll
                for (int r = 0; r < 16; ++r) pmax = fmaxf(pmax, p1[r]);
                { auto rr = __builtin_amdgcn_permlane32_swap(__float_as_uint(pmax), __float_as_uint(pmax), false, false); pmax = fmaxf(__uint_as_float(rr[0]), __uint_as_float(rr[1])); }
                const float mn = fmaxf(m_reg, pmax), alpha = __builtin_amdgcn_exp2f(m_reg - mn); m_reg = mn;
                float ps = 0.f;
#pragma unroll
                for (int r = 0; r < 16; ++r) { p0[r] = __builtin_amdgcn_exp2f(p0[r] - mn); p1[r] = __builtin_amdgcn_exp2f(p1[r] - mn); ps += p0[r] + p1[r]; }
                { auto rr = __builtin_amdgcn_permlane32_swap(__float_as_uint(ps), __float_as_uint(ps), false, false); ps = __uint_as_float(rr[0]) + __uint_as_float(rr[1]); }
                l_reg = l_reg * alpha + ps;
                if (__any(alpha < 1.f)) { if (hi == 0) al_l[r32] = alpha; asm volatile("s_waitcnt lgkmcnt(0)" ::: "memory");
#pragma unroll
                    for (int r = 0; r < 16; ++r) { const float a = al_l[crow(r, hi)];
#pragma unroll
                        for (int d_ = 0; d_ < 4; ++d_) o[d_][r] *= a; }
                    asm volatile("s_waitcnt lgkmcnt(0)" ::: "memory"); }
            } else {
                const bool MSK = (kb + KVBLK - 1 >= qlo);
                f32x16 l0, l1;
#pragma unroll
                for (int r = 0; r < 16; ++r) {
                    const float y0 = p0[r], y1 = p1[r];
                    float L0 = -(fmaxf(y0, 0.f) + __builtin_amdgcn_logf(1.0f + __builtin_amdgcn_exp2f(-__builtin_fabsf(y0))));
                    float L1 = -(fmaxf(y1, 0.f) + __builtin_amdgcn_logf(1.0f + __builtin_amdgcn_exp2f(-__builtin_fabsf(y1))));
                    if (MSK) { const int c = (r & 3) + 8 * (r >> 2); if (!(c < dq)) L0 = 0.f; if (!(c + 32 < dq)) L1 = 0.f; }
                    l0[r] = L0; l1[r] = L1;
                }
                float T[8], HO[8];
#pragma unroll
                for (int i = 0; i < 8; ++i) { const float g = (i < 4) ? ((l0[4 * i] + l0[4 * i + 1]) + (l0[4 * i + 2] + l0[4 * i + 3])) : ((l1[4 * i - 16] + l1[4 * i - 15]) + (l1[4 * i - 14] + l1[4 * i - 13]));
                    auto rr = __builtin_amdgcn_permlane32_swap(__float_as_uint(g), __float_as_uint(g), false, false);
                    const float glo = __uint_as_float(rr[0]), ghi = __uint_as_float(rr[1]); T[i] = glo + ghi; HO[i] = hi ? 0.f : ghi; }
                float run = R2;
#pragma unroll
                for (int i = 7; i >= 0; --i) {
                    const float off = run + HO[i];
                    if (i < 4) { float s3 = l0[4 * i + 3] + off, s2 = l0[4 * i + 2] + s3, s1 = l0[4 * i + 1] + s2, s0 = l0[4 * i] + s1;
                        p0[4 * i + 3] = __builtin_amdgcn_exp2f(p0[4 * i + 3] + s3); p0[4 * i + 2] = __builtin_amdgcn_exp2f(p0[4 * i + 2] + s2);
                        p0[4 * i + 1] = __builtin_amdgcn_exp2f(p0[4 * i + 1] + s1); p0[4 * i] = __builtin_amdgcn_exp2f(p0[4 * i] + s0); }
                    else { const int q = 4 * i - 16; float s3 = l1[q + 3] + off, s2 = l1[q + 2] + s3, s1 = l1[q + 1] + s2, s0 = l1[q] + s1;
                        p1[q + 3] = __builtin_amdgcn_exp2f(p1[q + 3] + s3); p1[q + 2] = __builtin_amdgcn_exp2f(p1[q + 2] + s2);
                        p1[q + 1] = __builtin_amdgcn_exp2f(p1[q + 1] + s1); p1[q] = __builtin_amdgcn_exp2f(p1[q] + s0); }
                    run += T[i];
                }
                R2 = run; wdone = __all(R2 < -160.0f);
                if (MSK) {
#pragma unroll
                    for (int r = 0; r < 16; ++r) { const int c = (r & 3) + 8 * (r >> 2); if (!(c < dq)) p0[r] = 0.f; if (!(c + 32 < dq)) p1[r] = 0.f; }
                }
            }
            ATT_PK4(p0, 0, pa0); ATT_PK4(p0, 8, pa1); ATT_PK4(p1, 0, pa2); ATT_PK4(p1, 8, pa3);
            pv_tile(o, vbase + bufi * SHM_V, pa0, pa1, pa2, pa3);
        }
        asm volatile("s_waitcnt vmcnt(0)" ::: "memory");
        if constexpr (BG::REG) { if (isC) { bg.burst_finish_regs(bbC, hv, (ATT_LAS unsigned char*)(lds + OFF_STAGE + wid * STAGE_PER_WAVE)); if constexpr (NH == 2) { if (isD) bg.burst_finish_regs(bbD, hw, (ATT_LAS unsigned char*)(lds + OFF_STAGE + wid * STAGE_PER_WAVE + 4096)); isD = false; } } }
        else
        if (t > 0 && isP) { if (isC) asm volatile("s_waitcnt vmcnt(%0)" :: "n"(BG::HOST_VMCNT) : "memory"); else asm volatile("s_waitcnt vmcnt(0)" ::: "memory");
            bg.burst_finish4(bbP, (ATT_LAS unsigned char*)(lds + OFF_STAGE + wid * STAGE_PER_WAVE + ((t - 1) & 1) * 4096)); }
        if (t & 1) { if constexpr (!FOX) { if (lane == 0) donef[((t >> 1) & 1) * NW + wid] = wdone ? 1 : 0; }
            asm volatile("s_waitcnt lgkmcnt(0)" ::: "memory"); __builtin_amdgcn_s_barrier(); asm volatile("" ::: "memory");
            if constexpr (!FOX) { int all = 1;
#pragma unroll
                for (int w = 0; w < NW; ++w) all &= donef[((t >> 1) & 1) * NW + w];
                if (__builtin_amdgcn_readfirstlane(all)) break; } }
    }
    if constexpr (!BG::REG) if (isC) { asm volatile("s_waitcnt vmcnt(0)" ::: "memory"); bg.burst_finish4(bbC, (ATT_LAS unsigned char*)(lds + OFF_STAGE + wid * STAGE_PER_WAVE + ((NT - 1) & 1) * 4096)); }
    if (0) {
    }
    float rli[16];
    if constexpr (FOX) {
        if (hi == 0) li_l[r32] = l_reg; asm volatile("s_waitcnt lgkmcnt(0)" ::: "memory");
#pragma unroll
        for (int r = 0; r < 16; ++r) rli[r] = __builtin_amdgcn_rcpf(li_l[crow(r, hi)]);
        asm volatile("s_waitcnt lgkmcnt(0)" ::: "memory");
    } else {
#pragma unroll
        for (int r = 0; r < 16; ++r) rli[r] = 1.f;
    }
    bf16_t* Ow = Op + (size_t)qlo * PITCH;
#pragma unroll
    for (int r = 0; r < 16; ++r) { const int orow = crow(r, hi);
#pragma unroll
        for (int d0 = 0; d0 < 4; ++d0) { const float v = o[d0][r] * rli[r]; const float vn = __shfl_xor(v, 1);
            if ((r32 & 1) == 0) *(unsigned*)(Ow + (size_t)orow * PITCH + d0 * 32 + r32) = cvtpk(v, vn); } }
#undef TILEJ
#undef LOADT
#undef WRITET
}
}
#ifndef MK_ONE_LAUNCH
#define MK_ONE_LAUNCH 1
#endif
constexpr bool ONE_LAUNCH = (MK_ONE_LAUNCH != 0);
constexpr int NWAVES = 8, NTHR = NWAVES * 64;
constexpr int BATCH = 4, SEQ = 2048, DM = 2048, NH = 16, HD = 128, T = BATCH * SEQ;
constexpr int FF = 5632, NE = 8, FFX = 7168;
constexpr float RMS_EPS = 1e-6f;
constexpr float QSCALE = 0.08838834764831845f * 1.4426950408889634f;
constexpr int MAXTILES = 72;
constexpr int NPHASES = 16;
constexpr size_t MiB = 1u << 20;
constexpr size_t WS_CTL = 0, CTL_ZERO_BYTES = 1 * MiB;
constexpr size_t WS_WQKV = 2 * MiB;
constexpr size_t WS_WOA  = 26 * MiB;
constexpr size_t WS_WGU  = 34 * MiB;
constexpr size_t WS_WDN  = 78 * MiB;
constexpr size_t WS_WKVQ = 100 * MiB;
constexpr size_t WS_WF   = 124 * MiB;
constexpr size_t WS_WOB  = 125 * MiB;
constexpr size_t WS_WGUX = 134 * MiB;
constexpr size_t WS_WDNX = 582 * MiB;
constexpr size_t WS_A    = 806 * MiB;
constexpr size_t WS_Q    = 838 * MiB, WS_K = 870 * MiB, WS_V = 902 * MiB;
constexpr size_t WS_O    = 934 * MiB;
constexpr size_t WS_H1   = 966 * MiB;
constexpr size_t WS_ACT  = 1030 * MiB;
constexpr size_t WS_H2   = 1118 * MiB;
constexpr size_t WS_H3   = 1182 * MiB;
constexpr size_t WS_AS   = 1246 * MiB;
constexpr size_t WS_ACT2 = 1318 * MiB;
constexpr size_t WS_Y    = 1570 * MiB;
constexpr size_t WS_FP   = 1714 * MiB;
constexpr size_t WS_TOK  = 1716 * MiB;
constexpr size_t WS_CNT  = 1717 * MiB;
constexpr size_t WS_TAB  = 1718 * MiB;
constexpr size_t WS_YP   = 1720 * MiB;
constexpr size_t WS_SSQ1 = 1848 * MiB, WS_SSQ2 = 1850 * MiB, WS_RSTD = 1852 * MiB;
constexpr size_t WS_END  = 1854 * MiB;
constexpr int CW_BAR = 4096;
constexpr int RING_OFF = 0, RING_BYTES = 131072;
constexpr int LDS_BYTES = 163840;
constexpr int LDSCTL_OFF = LDS_BYTES - 2048, MISC_OFF = LDSCTL_OFF + 320;

#define GAS __attribute__((address_space(1)))
#define LAS __attribute__((address_space(3)))
typedef unsigned short bf16;
typedef unsigned v4u __attribute__((ext_vector_type(4)));
typedef unsigned v2u __attribute__((ext_vector_type(2)));
typedef float f32x4 __attribute__((ext_vector_type(4)));
typedef short bf16x8 __attribute__((ext_vector_type(8)));
typedef GAS unsigned gu32;
#define RLX_AGENT __ATOMIC_RELAXED, __HIP_MEMORY_SCOPE_AGENT
#define LDS_WAIT() asm volatile("s_waitcnt lgkmcnt(0)" ::: "memory")
#define VM_WAIT() asm volatile("s_waitcnt vmcnt(0)" ::: "memory")
__device__ __forceinline__ unsigned cvtpk2(float lo, float hi) { unsigned r; asm volatile("v_cvt_pk_bf16_f32 %0, %1, %2" : "=v"(r) : "v"(lo), "v"(hi)); return r; }

#define XB_TMO      128
#define XB_XCNT(j)  (256  + 64 * (j))
#define XB_XSUB(j)  (1280 + 64 * (j))
#define XB_XGEN(j)  (2304 + 64 * (j))
#define XB_TOP      3328
#define XB_TOPGEN   3392
#define XCD_BAR_WORDS 3456
#define XB_SPIN_CAP (1u << 18)
__device__ __forceinline__ unsigned xb_ld(unsigned* p)              { return __hip_atomic_load(p, __ATOMIC_RELAXED, __HIP_MEMORY_SCOPE_AGENT); }
__device__ __forceinline__ unsigned xb_add(unsigned* p, unsigned v) { return __hip_atomic_fetch_add(p, v, __ATOMIC_RELAXED, __HIP_MEMORY_SCOPE_AGENT); }
__device__ __forceinline__ unsigned xb_xcc_id() { return (unsigned)__builtin_amdgcn_s_getreg((3 << 11) | 20) & 0xFu; }
#define XB_SPIN(cond, bar) do { unsigned _sp = 0; while (cond) { __builtin_amdgcn_s_sleep(1); \
    if ((++_sp & 255u) == 0u) { if (xb_ld(&(bar)[XB_TMO])) break; if (_sp > XB_SPIN_CAP) { atomicAdd(&(bar)[XB_TMO], 1u); break; } } } } while (0)
struct XcdBarrier { unsigned* bar; unsigned x; volatile LAS unsigned* st; };
__device__ __forceinline__ XcdBarrier xcd_barrier_post(unsigned* bar, volatile LAS unsigned* st) {
    XcdBarrier b; b.bar = bar; b.x = xb_xcc_id(); b.st = st;
    if (threadIdx.x == 0) (void)xb_add(&bar[XB_XCNT(b.x)], 1u);
    return b;
}
__device__ __forceinline__ void xcd_barrier_complete(unsigned* bar, unsigned x, unsigned& nloc, unsigned& nx) {
    const unsigned G = gridDim.x * gridDim.y * gridDim.z;
    unsigned sum, cnt, mine, sp = 0u;
    for (;;) {
        sum = 0u; cnt = 0u; mine = 0u;
#pragma unroll
        for (unsigned j = 0; j < 16; ++j) { const unsigned c = xb_ld(&bar[XB_XCNT(j)]); sum += c; cnt += (c > 0u) ? 1u : 0u; mine = (j == x) ? c : mine; }
        if (sum == G) break;
        __builtin_amdgcn_s_sleep(1);
        if ((++sp & 255u) == 0u) { if (xb_ld(&bar[XB_TMO])) break; if (sp > XB_SPIN_CAP) { atomicAdd(&bar[XB_TMO], 1u); break; } }
    }
    nloc = mine > 0u ? mine : 1u; nx = cnt > 0u ? cnt : 1u;
}
__device__ __forceinline__ void xcd_barrier(const XcdBarrier& b) {
    asm volatile("s_waitcnt vmcnt(0)" ::: "memory");
    __syncthreads();
    if (threadIdx.x == 0) {
        unsigned* bar = b.bar;
        __builtin_amdgcn_s_waitcnt(0);
        unsigned nloc = b.st[0], nx = b.st[1];
        if (nloc == 0u) { xcd_barrier_complete(bar, b.x, nloc, nx); b.st[0] = nloc; b.st[1] = nx; }
        const unsigned old = xb_add(&bar[XB_XSUB(b.x)], 1u);
        const unsigned gen = old / nloc;
        if (old + 1u == (gen + 1u) * nloc) {
            __builtin_amdgcn_fence(__ATOMIC_RELEASE, "agent");
            asm volatile("s_waitcnt vmcnt(0)" ::: "memory");
            const unsigned og = xb_add(&bar[XB_TOP], 1u);
            const unsigned tg = og / nx;
            if (og + 1u == (tg + 1u) * nx) xb_add(&bar[XB_TOPGEN], 1u);
            else XB_SPIN(xb_ld(&bar[XB_TOPGEN]) == tg, bar);
            __builtin_amdgcn_fence(__ATOMIC_ACQUIRE, "agent");
            xb_add(&bar[XB_XGEN(b.x)], 1u);
            asm volatile("s_waitcnt vmcnt(0)" ::: "memory");
        } else {
            XB_SPIN(xb_ld(&bar[XB_XGEN(b.x)]) == gen, bar);
            __builtin_amdgcn_fence(__ATOMIC_ACQUIRE, "agent");
            asm volatile("s_waitcnt vmcnt(0)" ::: "memory");
        }
    }
    __syncthreads();
}

__device__ __forceinline__ float wave_sum(float v) {
#pragma unroll
    for (int o = 1; o < 64; o <<= 1) v += __shfl_xor(v, o);
    return v;
}

constexpr int CT_M0 = 0, CT_M1 = CT_M0 + 64 * 24, CT_M2 = CT_M1 + 64 * 8, CT_M3 = CT_M2 + 64 * 44, CT_M4 = CT_M3 + 176 * 8, CT_M5 = CT_M4 + 64 * 16, CT_M6 = CT_M5 + 64 * 8, CT_M7 = CT_M6 + 64 * 8,
              CT_M8 = CT_M7 + 8 * 64 * 56, CT_END = CT_M8 + 8 * 224 * 8;
static_assert(CT_END == 51328, "task count");
struct CDesc { const float* src; const float* gain; unsigned dst_off; int K, N, nblk, Np, dcol0, mode, F, base, pad; };
static_assert(sizeof(CDesc) == 56 || sizeof(CDesc) == 64, "CDesc");
constexpr int CDESC_OFF = LDSCTL_OFF + 1024;
__device__ __forceinline__ unsigned udiv_small(unsigned a, unsigned b) {
    unsigned q = (unsigned)__builtin_amdgcn_readfirstlane((int)(unsigned)((float)a * __builtin_amdgcn_rcpf((float)b))); if (q * b > a) --q; if ((q + 1) * b <= a) ++q; return q; }
#define CAS __attribute__((address_space(4)))
struct ConvJob { const GAS char* sp; const CAS float* gp; unsigned dp; unsigned sstride, dstride; };
__device__ __forceinline__ unsigned conv_slane(int mode, unsigned foff, int lane) {
    const int l = (mode == 2) ? (lane & 31) : lane;
    const unsigned pf = 32u * (l >> 3) + 4u * (2u * (l & 3) + ((l >> 2) & 1));
    return (mode == 0) ? 16u * lane : (4u * pf + ((mode == 2 && lane >= 32) ? foff : 0u));
}
__device__ __forceinline__ v2u conv_pack(f32x4 v, float g) { v2u o; o.x = cvtpk2(v.x * g, v.y * g); o.y = cvtpk2(v.z * g, v.w * g); return o; }
struct ConvStream {
    static constexpr bool ON = true, REG = false; static constexpr int HOST_VMCNT = 8;
    const LAS CDesc* tabL; unsigned char* ws; ConvJob j; int task, tstep, tend, rows_left; unsigned slane; int lane; bool live;
    __device__ __forceinline__ void decode(int t) {
        const int m = (t >= CT_M1) + (t >= CT_M2) + (t >= CT_M3) + (t >= CT_M4) + (t >= CT_M5) + (t >= CT_M6) + (t >= CT_M7) + (t >= CT_M8);
        const LAS CDesc* d = tabL + m;
#define RFL(x) __builtin_amdgcn_readfirstlane(x)
        const int K = RFL(d->K), N = RFL(d->N), nblk = RFL(d->nblk), Np = RFL(d->Np), mode = RFL(d->mode), F = RFL(d->F), base = RFL(d->base), dcol0 = RFL(d->dcol0); const unsigned dst_off = (unsigned)RFL((int)d->dst_off);
        const LAS unsigned* dw = (const LAS unsigned*)d;
        const GAS float* srcp = (const GAS float*)(((unsigned long long)(unsigned)RFL((int)dw[1]) << 32) | (unsigned)RFL((int)dw[0]));
        const CAS float* gn = (const CAS float*)(((unsigned long long)(unsigned)RFL((int)dw[3]) << 32) | (unsigned)RFL((int)dw[2]));
#undef RFL
        const unsigned r = (unsigned)(t - base), per = (unsigned)((K >> 5) * nblk), e = udiv_small(r, per), r2 = r - e * per, rc = udiv_small(r2, (unsigned)nblk), blk = r2 - rc * nblk;
        const size_t row0 = (size_t)e * K + (size_t)rc * 32; const unsigned sc = (mode == 2) ? blk * 128u : blk * 256u;
        j.sp = (const GAS char*)(srcp + row0 * N + sc); j.dp = dst_off + (unsigned)((row0 * Np + dcol0 + blk * 256u) * 2u);
        j.gp = gn ? gn + rc * 32 : nullptr; j.sstride = (unsigned)N * 4u; j.dstride = (unsigned)Np * 2u;
        slane = conv_slane(mode, (unsigned)F * 4u, lane); rows_left = 32;
    }
    __device__ __forceinline__ void start(const LAS CDesc* tabL_, unsigned char* ws_, int t0, int tstep_, int tend_, int lane_) { tabL = tabL_; ws = ws_; task = t0; tstep = tstep_; tend = tend_; lane = lane_; live = t0 < tend_;
        decode(live ? t0 : tend_ - 1); }
    __device__ __forceinline__ void advance() {
        if (rows_left > 1) { --rows_left; j.sp += j.sstride; j.dp += j.dstride; if (j.gp) ++j.gp; }
        else if (task + tstep < tend) { task += tstep; decode(task); }
        else live = false;
    }
    struct Burst { const GAS char* sp; const CAS float* gp; unsigned dp, sstride, dstride, slane; };
    __device__ __forceinline__ bool burst_begin(Burst& b) {
        b.sp = j.sp; b.gp = j.gp; b.dp = j.dp; b.sstride = j.sstride; b.dstride = j.dstride; b.slane = slane; const bool was = live;
        if (rows_left > 16) { rows_left -= 16; j.sp += 16 * j.sstride; j.dp += 16 * j.dstride; if (j.gp) j.gp += 16; }
        else if (task + tstep < tend) { task += tstep; decode(task); }
        else live = false;
        return was;
    }
    __device__ __forceinline__ bool burst_begin_n(Burst& b, int R) {
        b.sp = j.sp; b.gp = j.gp; b.dp = j.dp; b.sstride = j.sstride; b.dstride = j.dstride; b.slane = slane; const bool was = live;
        if (rows_left > R) { rows_left -= R; j.sp += R * j.sstride; j.dp += R * j.dstride; if (j.gp) j.gp += R; }
        else if (task + tstep < tend) { task += tstep; decode(task); }
        else live = false;
        return was;
    }
    __device__ __forceinline__ void burst_dma(const Burst& b, int i, LAS unsigned char* dst) const {
        __builtin_amdgcn_global_load_lds((const GAS unsigned*)(b.sp + (size_t)i * b.sstride + b.slane), (LAS unsigned*)dst, 16, 0, 0); }
    __device__ __forceinline__ void burst_finish4(const Burst& b, LAS unsigned char* src) const {
        typedef float gain4 __attribute__((ext_vector_type(4)));
        gain4 g = {1.f, 1.f, 1.f, 1.f}; if (b.gp) g = *(const CAS gain4*)b.gp;
#pragma unroll
        for (int i = 0; i < 4; ++i) { const f32x4 v = *(const LAS f32x4*)(src + i * 1024 + 16 * lane); store(b.dp + (unsigned)i * b.dstride, conv_pack(v, g[i])); }
    }
    __device__ __forceinline__ f32x4 burst_load(const Burst& b, int i) const { return __builtin_nontemporal_load((const GAS f32x4*)(b.sp + (size_t)i * b.sstride + b.slane)); }
    typedef float gain16 __attribute__((ext_vector_type(16)));
    __device__ __forceinline__ gain16 burst_gains(const Burst& b) const { gain16 g;
#pragma unroll
        for (int i = 0; i < 16; ++i) g[i] = 1.0f;
        if (b.gp) g = *(const CAS gain16*)b.gp;
        return g; }
    __device__ __forceinline__ void burst_store(const Burst& b, int i, f32x4 v, float g) const { store(b.dp + (unsigned)i * b.dstride, conv_pack(v, g)); }
    __device__ __forceinline__ f32x4 load() const { return __builtin_nontemporal_load((const GAS f32x4*)(j.sp + slane)); }
    __device__ __forceinline__ void load_asm(f32x4& x) const { const unsigned long long p = (unsigned long long)j.sp;
        const unsigned long long ps = ((unsigned long long)(unsigned)__builtin_amdgcn_readfirstlane((int)(unsigned)(p >> 32)) << 32) | (unsigned)__builtin_amdgcn_readfirstlane((int)(unsigned)p);
        asm volatile("s_nop 4\n\tglobal_load_dwordx4 %0, %1, %2 nt" : "=&v"(x) : "v"(slane), "s"(ps) : "memory"); }
    __device__ __forceinline__ float gain() const { return j.gp ? *j.gp : 1.0f; }
    __device__ __forceinline__ void store(unsigned dp, v2u y) const { *(GAS v2u*)((GAS unsigned char*)ws + (dp + 8u * (unsigned)lane)) = y; }
};
__device__ __forceinline__ void conv_drain(ConvStream& s) {
    while (s.live) {
        f32x4 v[8]; unsigned dp[8]; float g[8]; bool ok[8];
#pragma unroll
        for (int i = 0; i < 8; ++i) { ok[i] = s.live; v[i] = s.load(); dp[i] = s.j.dp; g[i] = s.gain(); s.advance(); }
#pragma unroll
        for (int i = 0; i < 8; ++i) if (ok[i]) s.store(dp[i], conv_pack(v[i], g[i]));
    }
}
__device__ __forceinline__ unsigned cvt4_fp8(float a, float b, float c, float d) { int w = __builtin_amdgcn_cvt_pk_fp8_f32(a, b, 0, false); w = __builtin_amdgcn_cvt_pk_fp8_f32(c, d, w, true); return (unsigned)w; }
__device__ __forceinline__ void conv8_task(const float* src, int K, int N, unsigned char* dst, const float* gain, int F, float scale, int t, int lane) {
    const int nstrip = N / 32, nkc = K / 512, per = nstrip * nkc;
    const int e = t / per, r = t - e * per, kc = r / nstrip, strip = r - kc * nstrip;
    src += (size_t)e * K * N; dst += (size_t)e * N * K;
    const int n = strip * 32 + 4 * (lane & 7), q = lane >> 3;
    int drow = n; if (F > 0) drow = (n < F) ? ((n >> 7) * 256 + (n & 127)) : (((n - F) >> 7) * 256 + 128 + ((n - F) & 127));
#pragma unroll 1
    for (int step = 0; step < 4; ++step) {
        const int k0 = kc * 512 + step * 128 + 16 * q;
        f32x4 v[16];
#pragma unroll
        for (int i = 0; i < 16; ++i) v[i] = __builtin_nontemporal_load((const f32x4*)(src + (size_t)(k0 + i) * N + n));
        float g[16];
#pragma unroll
        for (int i = 0; i < 4; ++i) { f32x4 gv = {scale, scale, scale, scale}; if (gain) gv = *(const f32x4*)(gain + k0 + 4 * i) * scale; g[4 * i] = gv.x; g[4 * i + 1] = gv.y; g[4 * i + 2] = gv.z; g[4 * i + 3] = gv.w; }
#pragma unroll
        for (int j = 0; j < 4; ++j) { v4u o;
            o.x = cvt4_fp8(v[0][j] * g[0], v[1][j] * g[1], v[2][j] * g[2], v[3][j] * g[3]); o.y = cvt4_fp8(v[4][j] * g[4], v[5][j] * g[5], v[6][j] * g[6], v[7][j] * g[7]);
            o.z = cvt4_fp8(v[8][j] * g[8], v[9][j] * g[9], v[10][j] * g[10], v[11][j] * g[11]); o.w = cvt4_fp8(v[12][j] * g[12], v[13][j] * g[13], v[14][j] * g[14], v[15][j] * g[15]);
            *(v4u*)(dst + (size_t)(drow + j) * K + k0) = o; }
    }
}
template <bool REG_, bool DIRECT_ = false> struct Conv8StreamT {
    static constexpr bool ON = true, REG = REG_; static constexpr int HOST_VMCNT = 4;
    struct Burst { const GAS char* sp; GAS unsigned char* dp; unsigned doff; };
    const float* src; unsigned char* dst; int task, tstep, tend, step; int lane; bool live; float scale;
    const GAS char* sp; GAS unsigned char* dp; unsigned doff;
    static constexpr int K = DM, N = 2 * FFX, F = FFX, NSTRIP = N / 32, PER = NSTRIP * (K / 512);
    __device__ __forceinline__ void decode(int t) {
        const int e = t / PER, r = t - e * PER, kc = r / NSTRIP, strip = r - kc * NSTRIP;
        const int n0 = strip * 32, k0 = kc * 512;
        sp = (const GAS char*)(src + ((size_t)e * K + k0) * N + n0); dp = (GAS unsigned char*)dst + (size_t)e * N * K + k0;
        const int n = DIRECT_ ? n0 + 4 * (lane & 7) : n0 + (lane & 31); const int drow = (n < F) ? ((n >> 7) * 256 + (n & 127)) : (((n - F) >> 7) * 256 + 128 + ((n - F) & 127));
        doff = DIRECT_ ? (unsigned)drow * (unsigned)K + 4u * (unsigned)(lane >> 3) : (unsigned)drow * (unsigned)K + 16u * (unsigned)(lane >> 5); step = 0;
    }
    __device__ __forceinline__ void start(const float* src_, unsigned char* dst_, float scale_, int t0, int tstep_, int tend_, int lane_) { src = src_; dst = dst_; scale = scale_; task = t0; tstep = tstep_; tend = tend_; lane = lane_;
        live = t0 < tend_; decode(live ? t0 : tend_ - 1); }
    __device__ __forceinline__ bool burst_begin_n(Burst& b, int R) {
        b.sp = sp; b.dp = dp; b.doff = doff; const bool was = live; if (R == 0) return was;
        if (step < 15) { ++step; sp += (size_t)32 * N * 4; dp += 32; }
        else if (task + tstep < tend) { task += tstep; decode(task); }
        else live = false;
        return was;
    }
    __device__ __forceinline__ void burst_dma(const Burst& b, int i, LAS unsigned char* dstl) const {
        __builtin_amdgcn_global_load_lds((const GAS unsigned*)(b.sp + ((size_t)((lane >> 3) + 8 * i) * N + 4 * (lane & 7)) * 4), (LAS unsigned*)dstl, 16, 0, 0); }
    __device__ __forceinline__ f32x4 burst_ld(const Burst& b, int i) const {
        const int row = DIRECT_ ? 4 * (lane >> 3) + i : (lane >> 3) + 8 * i;
        return __builtin_nontemporal_load((const GAS f32x4*)(b.sp + ((size_t)row * N + 4 * (lane & 7)) * 4)); }
    __device__ __forceinline__ void burst_finish_regs(const Burst& b, const f32x4 (&hv)[4], LAS unsigned char* stl) const {
        if constexpr (DIRECT_) {
#pragma unroll
            for (int j = 0; j < 4; ++j) *(GAS unsigned*)(b.dp + b.doff + (size_t)j * K) = cvt4_fp8(hv[0][j] * scale, hv[1][j] * scale, hv[2][j] * scale, hv[3][j] * scale);
            return; }
#pragma unroll
        for (int i = 0; i < 4; ++i) *(LAS f32x4*)(stl + i * 1024 + 16 * lane) = hv[i];
        asm volatile("s_waitcnt lgkmcnt(0)" ::: "memory");
        burst_finish4(b, stl);
        asm volatile("s_waitcnt lgkmcnt(0)" ::: "memory");
    }
    __device__ __forceinline__ void burst_finish4(const Burst& b, LAS unsigned char* srcl) const {
        const LAS float* p = (const LAS float*)srcl + 16 * (lane >> 5) * 32 + (lane & 31);
        float v[16];
#pragma unroll
        for (int j = 0; j < 16; ++j) v[j] = p[j * 32] * scale;
        v4u o; o.x = cvt4_fp8(v[0], v[1], v[2], v[3]); o.y = cvt4_fp8(v[4], v[5], v[6], v[7]); o.z = cvt4_fp8(v[8], v[9], v[10], v[11]); o.w = cvt4_fp8(v[12], v[13], v[14], v[15]);
        *(GAS v4u*)(b.dp + b.doff) = o;
    }
};
template <class S8> __device__ __forceinline__ void conv8_drain(S8& s) {
    while (s.live) { conv8_task(s.src, S8::K, S8::N, s.dst, nullptr, S8::F, s.scale, s.task, s.lane);
        if (s.task + s.tstep < s.tend) s.task += s.tstep; else s.live = false; }
}
typedef Conv8StreamT<false> Conv8Stream; typedef Conv8StreamT<true> Conv8StreamR; typedef Conv8StreamT<true, true> Conv8StreamD;
constexpr float SC_WGU = 64.f, SC_ACT = 8.f, SC_WDN = 128.f;
#define BF4_TO_F4(w_) ((f32x4){__uint_as_float((w_).x << 16), __uint_as_float((w_).x & 0xffff0000u), __uint_as_float((w_).y << 16), __uint_as_float((w_).y & 0xffff0000u)})
__device__ __forceinline__ void rms_rowh_to_bf16(const bf16* xrow, bf16* orow, int lane) {
    const v2u* xr = (const v2u*)xrow + lane;
    f32x4 v[8]; float s = 0.f;
#pragma unroll
    for (int j = 0; j < 8; ++j) { const v2u w = xr[64 * j]; v[j] = BF4_TO_F4(w); s += (v[j].x * v[j].x + v[j].y * v[j].y) + (v[j].z * v[j].z + v[j].w * v[j].w); }
    const float rstd = 1.0f / sqrtf(wave_sum(s) * (1.f / DM) + RMS_EPS);
    v2u* o8 = (v2u*)orow + lane;
#pragma unroll
    for (int j = 0; j < 8; ++j) { v2u w; w.x = cvtpk2(v[j].x * rstd, v[j].y * rstd); w.y = cvtpk2(v[j].z * rstd, v[j].w * rstd); o8[64 * j] = w; }
}
__device__ __forceinline__ void rms_row_to_bf16(const float* xrow, bf16* orow, int lane) {
    const f32x4* xr = (const f32x4*)xrow + lane;
    f32x4 v[8]; float s = 0.f;
#pragma unroll
    for (int j = 0; j < 8; ++j) { v[j] = xr[64 * j]; s += (v[j].x * v[j].x + v[j].y * v[j].y) + (v[j].z * v[j].z + v[j].w * v[j].w); }
    const float rstd = 1.0f / sqrtf(wave_sum(s) * (1.f / DM) + RMS_EPS);
    v2u* o8 = (v2u*)orow + lane;
#pragma unroll
    for (int j = 0; j < 8; ++j) { v2u w; w.x = cvtpk2(v[j].x * rstd, v[j].y * rstd); w.y = cvtpk2(v[j].z * rstd, v[j].w * rstd); o8[64 * j] = w; }
}
struct Args { const float* in[16]; float* out; unsigned char* ws; int ph_lo, ph_hi; };
enum { I_X = 0, I_NMIX, I_NFFN, I_WQKVA, I_WOA, I_NKV, I_WKVF, I_BF, I_WQB, I_WOB, I_WGU, I_WDN, I_WR, I_WGUX, I_WDNX, I_NFIN };

__global__ void __launch_bounds__(NTHR, 2) yoco_fwd(Args args) {
    extern __shared__ __attribute__((aligned(16))) unsigned char lds_raw[];
    LAS unsigned char* lds = (LAS unsigned char*)lds_raw;
    volatile LAS unsigned* MISC = (volatile LAS unsigned*)(lds + MISC_OFF);
    const int tid = threadIdx.x, lane = tid & 63, wave = __builtin_amdgcn_readfirstlane(tid >> 6);
    const int G = gridDim.x; const int bx = blockIdx.x; const int vcu = (G % 8 == 0) ? (bx % 8) * (G / 8) + bx / 8 : bx;
    const int gw = vcu * NWAVES + wave, NGW = G * NWAVES;
    unsigned char* ws = args.ws;
    gu32* ctl = (gu32*)(ws + WS_CTL);
    for (int u = tid; u < (LDS_BYTES - LDSCTL_OFF) / 4; u += NTHR) ((LAS unsigned*)(lds + LDSCTL_OFF))[u] = 0u;
    __syncthreads();
    if (tid == 0) {
        const float* nmix = args.in[I_NMIX]; const float* nffn = args.in[I_NFFN]; const float* nkv = args.in[I_NKV]; const float* nul = nullptr;
#define CD_SET(i_, SRC_, GAIN_, DST_, K_, N_, NBLK_, NP_, DCOL0_, MODE_, F_, BASE_) { LAS CDesc* d_ = (LAS CDesc*)(lds + CDESC_OFF) + (i_); d_->src = (SRC_); d_->gain = (GAIN_); d_->dst_off = (unsigned)(DST_); \
            d_->K = (K_); d_->N = (N_); d_->nblk = (NBLK_); d_->Np = (NP_); d_->dcol0 = (DCOL0_); d_->mode = (MODE_); d_->F = (F_); d_->base = (BASE_); d_->pad = 0; }
        CD_SET(0, args.in[I_WQKVA], nmix,        WS_WQKV, 2048, 6144,    24, 6144,    0,    1, 0,   CT_M0)
        CD_SET(1, args.in[I_WOA],   nul,         WS_WOA,  2048, 2048,    8,  2048,    0,    1, 0,   CT_M1)
        CD_SET(2, args.in[I_WGU],   nffn,        WS_WGU,  2048, 2 * FF,  44, 2 * FF,  0,    2, FF,  CT_M2)
        CD_SET(3, args.in[I_WDN],   nul,         WS_WDN,  FF,   2048,    8,  2048,    0,    1, 0,   CT_M3)
        CD_SET(4, args.in[I_WKVF],  nkv,         WS_WKVQ, 2048, 4112,    16, 6144,    2048, 1, 0,   CT_M4)
        CD_SET(5, args.in[I_WQB],   nmix + 2048, WS_WKVQ, 2048, 2048,    8,  6144,    0,    1, 0,   CT_M5)
        CD_SET(6, args.in[I_WOB],   nul,         WS_WOB,  2048, 2048,    8,  2048,    0,    1, 0,   CT_M6)
        CD_SET(7, args.in[I_WGUX],  nffn + 2048, WS_WGUX, 2048, 2 * FFX, 56, 2 * FFX, 0,    2, FFX, CT_M7)
        CD_SET(8, args.in[I_WDNX],  nul,         WS_WDNX, FFX,  2048,    8,  2048,    0,    0, 0,   CT_M8)
#undef CD_SET
    }
    __syncthreads();
    XcdBarrier bar; bar.bar = (unsigned*)(ctl + CW_BAR); bar.x = 0; bar.st = nullptr;
    if (ONE_LAUNCH) bar = xcd_barrier_post((unsigned*)(ctl + CW_BAR), MISC + 8);
    const int lo = args.ph_lo, hi = args.ph_hi;
#define IN(k) (lo <= (k) && (k) < hi)
#define SEAM(k) do { if (IN(k) && IN((k) + 1)) xcd_barrier(bar); } while (0)

    bf16* const wA = (bf16*)(ws + WS_A); bf16* const wQ = (bf16*)(ws + WS_Q); bf16* const wK = (bf16*)(ws + WS_K); bf16* const wV = (bf16*)(ws + WS_V); bf16* const wO = (bf16*)(ws + WS_O);
    bf16* const H1 = (bf16*)(ws + WS_H1); bf16* const H2 = (bf16*)(ws + WS_H2); bf16* const H3 = (bf16*)(ws + WS_H3);
    int* const tokE = (int*)(ws + WS_TOK); float* const tokG = (float*)(ws + WS_TOK + 65536); int* const tokR = (int*)(ws + WS_TOK + 2 * 65536); int* const tokS = (int*)(ws + WS_TOK + 3 * 65536);
    int* const cntG = (int*)(ws + WS_CNT); int* const tab = (int*)(ws + WS_TAB);
    constexpr int CL_P0A_LO = CT_M0, CL_P0A_HI = CT_M1;
    constexpr int CL_P1_LO = CT_M1, CL_P1_HI = CT_M7;
    constexpr int CL_P2_LO = CT_M3, CL_P2_HI = CT_M7;
    constexpr int CL_P9_LO = CT_M7, CL_P9_HI = CT_M7;
    constexpr int CL_P13_LO = CT_M8, CL_P13_HI = CT_END;
    constexpr int NTG = 8 * (2 * FFX / 32) * (DM / 512), NTD = 8 * (DM / 32) * (FFX / 512), NCV = 16, NCV13 = 32, X5 = 2048, HH2 = 4096, HH9 = 8192;
    const bool cvsplit = (G >= 128); const int GW = G - NCV, GW13 = G - NCV13; const bool cvb = cvsplit && (bx >= GW), cvb13 = cvsplit && (bx >= GW13);
    const LAS CDesc* tabL = (const LAS CDesc*)(lds + CDESC_OFF);

    if (IN(0)) {
        const float* nmix = args.in[I_NMIX]; const float* nffn = args.in[I_NFFN]; const float* nkv = args.in[I_NKV];
        {   ConvStream cs; cs.start(tabL, ws, CL_P0A_LO + gw, NGW, CL_P0A_HI, lane); conv_drain(cs); }
        {
            const int n0 = cvsplit ? NTG - X5 - HH2 - HH9 : NTG + NTD;
            for (int t = gw; t < n0; t += NGW) {
                if (t < NTG) conv8_task(args.in[I_WGUX], DM, 2 * FFX, ws + WS_WGUX, nullptr, FFX, SC_WGU, t, lane);
                else conv8_task(args.in[I_WDNX], FFX, DM, ws + WS_WDNX, nullptr, 0, SC_WDN, t - NTG, lane); }
        }
        {
            const float* wkvf = args.in[I_WKVF]; bf16* WF = (bf16*)(ws + WS_WF);
            for (int idx = (vcu * NTHR + tid); idx < 16 * 2048; idx += G * NTHR) { const int k = idx >> 4, j = idx & 15;
                const float v = wkvf[(size_t)k * 4112 + 4096 + j] * nkv[k]; WF[j * 2048 + k] = (bf16)(cvtpk2(v, 0.f) & 0xffffu); }
        }
        for (int m = gw; m < T; m += NGW) rms_row_to_bf16(args.in[I_X] + (size_t)m * DM, wA + (size_t)m * DM, lane);
    }
    SEAM(0);
    if (IN(1)) {
        pg8::Gemm g{wA, (const bf16*)(ws + WS_WQKV), DM, 3 * DM, DM}; pg8::StaticOrder S; S.init(T, 3 * DM, G, bx);
        pg8::EpiBf16Split E{wQ, DM, DM, (size_t)(WS_K - WS_Q) / 2, QSCALE, 0, 1.0f, nullptr, nullptr, nullptr};
        ConvStream bg; bg.start(tabL, ws, CL_P1_LO + gw, NGW, CL_P1_HI, lane);
        pg8::gemm_phase<pg8::EpiBf16Split, pg8::StaticOrder, ConvStream>(lds + RING_OFF, g, S, E, bg); conv_drain(bg);
    }
    SEAM(1);
    if (IN(2)) {
        Conv8StreamD bgA; { const int lo8 = cvsplit ? NTG - X5 - HH2 - HH9 : NTG; bgA.start(args.in[I_WGUX], ws + WS_WGUX, SC_WGU, lo8 + gw, NGW, lo8 + (cvsplit ? HH2 : 0), lane); }
        for (int it = vcu; it < 256; it += G) { const int bh = it >> 2, x = it & 3, b = bh >> 4, h = bh & 15;
            for (int pass = 0; pass < 2; ++pass) att::attn_block<false, Conv8StreamD, 2>((LAS char*)lds, wQ, wK, wV, wO, b, h, pass ? x : 7 - x, bgA); }
        conv8_drain(bgA);
    }
    SEAM(2);
    if (IN(3)) {
        pg8::Gemm g{wO, (const bf16*)(ws + WS_WOA), DM, DM, DM}; pg8::StaticOrder S; S.init(T, DM, G, bx);
        pg8::EpiResBf16 E{H1, DM, args.in[I_X], nullptr, (float*)(ws + WS_SSQ1)};
        pg8::NoBg nobg; pg8::gemm_phase<pg8::EpiResBf16, pg8::StaticOrder, pg8::NoBg>(lds + RING_OFF, g, S, E, nobg);
    }
    SEAM(3);
    if (IN(5)) {
        if (cvb) { const float* nffn = args.in[I_NFFN];
            for (int t = NTG - X5 + (bx - GW) * NWAVES + wave; t < NTG; t += NCV * NWAVES) conv8_task(args.in[I_WGUX], DM, 2 * FFX, ws + WS_WGUX, nullptr, FFX, SC_WGU, t, lane);
        } else {
        const int Gw = cvsplit ? GW : G;
        pg8::Gemm g{H1, (const bf16*)(ws + WS_WGU), DM, 2 * FF, DM}; pg8::StaticOrder S; S.init(T, 2 * FF, Gw, bx);
        pg8::EpiSwiGLU E{(bf16*)(ws + WS_ACT), FF, (const float*)(ws + WS_SSQ1), (const LAS float*)(lds + RING_BYTES), nullptr};
        pg8::NoBg nobg; pg8::gemm_phase<pg8::EpiSwiGLU, pg8::StaticOrder, pg8::NoBg>(lds + RING_OFF, g, S, E, nobg);
        }
    }
    SEAM(5);
    if (IN(6)) {
        pg8::Gemm g{(const bf16*)(ws + WS_ACT), (const bf16*)(ws + WS_WDN), FF, DM, FF}; pg8::StaticOrder S; S.init(T, DM, G, bx);
        pg8::EpiResBf16 E{H2, DM, nullptr, H1, (float*)(ws + WS_SSQ2)};
        pg8::NoBg nobg; pg8::gemm_phase<pg8::EpiResBf16, pg8::StaticOrder, pg8::NoBg>(lds + RING_OFF, g, S, E, nobg);
    }
    SEAM(6);
    if (IN(8)) {
        {   const bf16* WF = (const bf16*)(ws + WS_WF); float* FP = (float*)(ws + WS_FP); const int fr = lane & 15, fq = lane >> 4;
            for (int task = gw; task < 2048; task += NGW) { const int rt = task >> 2, kq = task & 3;
                const bf16* Ap = H2 + (size_t)(16 * rt + fr) * DM + 512 * kq + 8 * fq; const bf16* Bp = WF + (size_t)fr * DM + 512 * kq + 8 * fq;
                f32x4 acc = {0.f, 0.f, 0.f, 0.f};
#pragma unroll
                for (int s = 0; s < 16; ++s) { const bf16x8 a = *(const bf16x8*)(Ap + 32 * s), bb = *(const bf16x8*)(Bp + 32 * s); acc = __builtin_amdgcn_mfma_f32_16x16x32_bf16(bb, a, acc, 0, 0, 0); }
                *(f32x4*)(FP + ((size_t)kq * T + 16 * rt + fr) * 16 + 4 * fq) = acc; }
        }
        pg8::Gemm g{H2, (const bf16*)(ws + WS_WKVQ), DM, 3 * DM, DM}; pg8::StaticOrder S; S.init(T, 3 * DM, G, bx);
        pg8::EpiBf16Split E{wQ, DM, DM, (size_t)(WS_K - WS_Q) / 2, QSCALE, 0, 1.0f, (const float*)(ws + WS_SSQ2), (const LAS float*)(lds + RING_BYTES), (float*)(ws + WS_RSTD)};
        pg8::NoBg nobg; pg8::gemm_phase<pg8::EpiBf16Split, pg8::StaticOrder, pg8::NoBg>(lds + RING_OFF, g, S, E, nobg);
    }
    SEAM(8);
    if (IN(9)) {
        Conv8StreamD bgA; { const int lo8 = cvsplit ? NTG - X5 - HH9 : NTG; bgA.start(args.in[I_WGUX], ws + WS_WGUX, SC_WGU, lo8 + gw, NGW, lo8 + (cvsplit ? HH9 : 0), lane); }
        const float* FP = (const float*)(ws + WS_FP); const float* bfp = args.in[I_BF];
        LAS float* biasL = (LAS float*)(lds + att::OFF_BIAS); LAS float* scanL = (LAS float*)(lds + att::OFF_SCAN);
        for (int it = vcu; it < 256; it += G) { const int bh = it >> 2, x = it & 3, b = bh >> 4, h = bh & 15;
            {
                float c[4]; float run = 0.f; const float bfh = bfp[h];
#pragma unroll
                for (int j = 0; j < 4; ++j) { const size_t row = (size_t)b * SEQ + 4 * tid + j; float f = 0.f;
#pragma unroll
                    for (int kq = 0; kq < 4; ++kq) f += FP[((size_t)kq * T + row) * 16 + h];
                    f = bfh + f * ((const float*)(ws + WS_RSTD))[row];
                    const float lf = fminf(f, 0.f) - __logf(1.0f + __expf(-fabsf(f))); run += lf; c[j] = run; }
                float incl = run;
#pragma unroll
                for (int o = 1; o < 64; o <<= 1) { const float n = __shfl_up(incl, o); if (lane >= o) incl += n; }
                if (lane == 63) scanL[wave] = incl;
                __syncthreads();
                float wpre = 0.f;
#pragma unroll
                for (int w = 0; w < 8; ++w) { const float tw = scanL[w]; if (w < wave) wpre += tw; }
                const float base = wpre + (incl - run);
#pragma unroll
                for (int j = 0; j < 4; ++j) biasL[4 * tid + j] = -(base + c[j]) * 1.4426950408889634f;
                __syncthreads();
            }
            for (int pass = 0; pass < 2; ++pass) att::attn_block<true, Conv8StreamD, 2>((LAS char*)lds, wQ, wK, wV, wO, b, h, pass ? x : 7 - x, bgA); }
        conv8_drain(bgA);
    }
    SEAM(9);
    if (IN(10)) {
        pg8::Gemm g{wO, (const bf16*)(ws + WS_WOB), DM, DM, DM}; pg8::StaticOrder S; S.init(T, DM, G, bx);
        pg8::EpiResBf16 E{H3, DM, nullptr, H2, nullptr};
        pg8::NoBg nobg; pg8::gemm_phase<pg8::EpiResBf16, pg8::StaticOrder, pg8::NoBg>(lds + RING_OFF, g, S, E, nobg);
    }
    SEAM(10);
    if (IN(11)) {
        LAS float* wrL = (LAS float*)lds;
        LAS int* eL = (LAS int*)(lds + 65536);
        const float* wr = args.in[I_WR]; const float* gn = args.in[I_NFFN] + 2048;
        for (int idx = tid; idx < 8 * 2048; idx += NTHR) { const int c = idx >> 3, e = idx & 7; wrL[e * 2048 + c] = wr[idx]; }
        __syncthreads();
        for (int g = vcu; g < 256; g += G) {
            for (int i = 0; i < 4; ++i) { const int tl = 4 * wave + i, token = 32 * g + tl;
                const v2u* xr = (const v2u*)(H3 + (size_t)token * DM) + lane;
                f32x4 v[8]; float s = 0.f;
#pragma unroll
                for (int j = 0; j < 8; ++j) { const v2u w_ = xr[64 * j]; v[j] = BF4_TO_F4(w_); s += (v[j].x * v[j].x + v[j].y * v[j].y) + (v[j].z * v[j].z + v[j].w * v[j].w); }
                const float rstd = 1.0f / sqrtf(wave_sum(s) * (1.f / DM) + RMS_EPS);
                unsigned* o4 = (unsigned*)((unsigned char*)wA + (size_t)token * DM) + lane;
#pragma unroll
                for (int j = 0; j < 8; ++j) { v[j] = v[j] * rstd * ((const f32x4*)gn)[lane + 64 * j]; o4[64 * j] = pg8::pk4_fp8(v[j].x, v[j].y, v[j].z, v[j].w); }
                float lg[8];
#pragma unroll
                for (int e = 0; e < 8; ++e) { float a = 0.f;
#pragma unroll
                    for (int j = 0; j < 8; ++j) { const f32x4 w4 = *(const LAS f32x4*)(wrL + e * 2048 + 256 * j + 4 * lane); a += (v[j].x * w4.x + v[j].y * w4.y) + (v[j].z * w4.z + v[j].w * w4.w); }
                    lg[e] = wave_sum(a); }
                int e1 = 0; float v1 = lg[0];
#pragma unroll
                for (int e = 1; e < 8; ++e) if (lg[e] > v1) { v1 = lg[e]; e1 = e; }
                int e2 = -1; float v2 = -__builtin_inff();
#pragma unroll
                for (int e = 0; e < 8; ++e) if (e != e1 && lg[e] > v2) { v2 = lg[e]; e2 = e; }
                const float g1 = 1.0f / (1.0f + __expf(v2 - v1)), g2 = 1.0f - g1;
                if (lane == 0) { eL[2 * tl] = e1; eL[2 * tl + 1] = e2; tokE[2 * token] = e1; tokE[2 * token + 1] = e2; tokG[2 * token] = g1; tokG[2 * token + 1] = g2; }
            }
            __syncthreads();
            if (tid == 0) { int cnt[8];
#pragma unroll
                for (int e = 0; e < 8; ++e) cnt[e] = 0;
                for (int q = 0; q < 64; ++q) { const int e = eL[q]; int r = 0;
#pragma unroll
                    for (int k = 0; k < 8; ++k) if (k == e) { r = cnt[k]; cnt[k] = r + 1; }
                    tokR[64 * g + q] = r; }
#pragma unroll
                for (int e = 0; e < 8; ++e) cntG[8 * g + e] = cnt[e]; }
            __syncthreads();
        }
    }
    SEAM(11);
    if (IN(12)) {
        LAS int* totL = (LAS int*)lds; LAS int* befL = totL + 8; LAS int* segL = totL + 16;
        for (int g = vcu; g < 256; g += G) {
            {   const int e = wave; int tot = 0, bef = 0;
#pragma unroll
                for (int i = 0; i < 4; ++i) { const int bb = lane + 64 * i; const int c = cntG[8 * bb + e]; tot += c; bef += (bb < g) ? c : 0; }
#pragma unroll
                for (int o = 1; o < 64; o <<= 1) { tot += __shfl_xor(tot, o); bef += __shfl_xor(bef, o); }
                if (lane == 0) { totL[e] = tot; befL[e] = bef; } }
            __syncthreads();
            if (tid == 0) { int acc = 0;
                for (int e = 0; e < 8; ++e) { segL[e] = acc * 256; acc += (totL[e] + 255) >> 8; }
                if (g == 0) { tab[0] = acc; int pm = 0; for (int e = 0; e < 8; ++e) { const int n = (totL[e] + 255) >> 8; for (int q = 0; q < n; ++q) tab[64 + pm++] = e; } } }
            __syncthreads();
            for (int i = 0; i < 4; ++i) { const int token = 32 * g + 4 * wave + i;
                const v4u* src = (const v4u*)((const unsigned char*)wA + (size_t)token * DM) + lane; v4u r4[2];
#pragma unroll
                for (int j = 0; j < 2; ++j) r4[j] = src[64 * j];
#pragma unroll
                for (int k = 0; k < 2; ++k) { const int e = tokE[2 * token + k], r = tokR[2 * token + k]; const int slot = segL[e] + befL[e] + r;
                    v4u* dst = (v4u*)(ws + WS_AS + (size_t)slot * DM) + lane;
#pragma unroll
                    for (int j = 0; j < 2; ++j) dst[64 * j] = r4[j];
                    if (lane == 0) tokS[2 * token + k] = slot; } }
            __syncthreads();
        }
    }
    SEAM(12);
    if (IN(13)) {
        if (cvb13) {
            for (int t = (bx - GW13) * NWAVES + wave; t < NTD; t += NCV13 * NWAVES) conv8_task(args.in[I_WDNX], FFX, DM, ws + WS_WDNX, nullptr, 0, SC_WDN, t, lane);
        } else {
        const int Gw = cvsplit ? GW13 : G;
        const int MT = __builtin_amdgcn_readfirstlane(tab[0]);
        pg8::Gemm g{(const bf16*)(ws + WS_AS), (const bf16*)(ws + WS_WGUX), DM / 2, 0, DM / 2}; pg8::MoeOrder8 S; S.init(MT < MAXTILES ? MT : MAXTILES, 2 * FFX / 256, Gw, bx, tab + 64, DM);
        pg8::EpiSwiGLU8 E{ws + WS_ACT2, FFX, 1.0f / SC_WGU, SC_ACT};
        pg8::gemm_phase_f8<pg8::EpiSwiGLU8, pg8::MoeOrder8>(lds + RING_OFF, g, S, E);
        }
    }
    SEAM(13);
    if (IN(14)) {
        const int MT0 = __builtin_amdgcn_readfirstlane(tab[0]); const int MT = MT0 < MAXTILES ? MT0 : MAXTILES; const int tail0 = (MT >> 5) << 5;
        {   pg8::Gemm g{(const bf16*)(ws + WS_ACT2), (const bf16*)(ws + WS_WDNX), FFX / 2, 0, FFX / 2}; pg8::MoeOrder8 S; S.init(tail0, DM / 256, G, bx, tab + 64, FFX);
            pg8::EpiBf16Split E{(bf16*)(ws + WS_Y), DM, 1 << 30, 0, 1.0f, -1, 1.0f / (SC_ACT * SC_WDN), nullptr, nullptr, nullptr};
            pg8::gemm_phase_f8<pg8::EpiBf16Split, pg8::MoeOrder8>(lds + RING_OFF, g, S, E); }
        if (MT > tail0) {
            pg8::Gemm g{(const bf16*)(ws + WS_ACT2), (const bf16*)(ws + WS_WDNX), FFX / 2, 0, 512}; pg8::MoeTailOrder8 S; S.init(tail0, MT - tail0, DM / 256, G, bx, tab + 64, FFX);
            pg8::EpiBf16Split E{(bf16*)(ws + WS_YP), DM, 1 << 30, 0, 1.0f, -1, 1.0f / (SC_ACT * SC_WDN), nullptr, nullptr, nullptr};
            pg8::gemm_phase_f8<pg8::EpiBf16Split, pg8::MoeTailOrder8>(lds + RING_OFF, g, S, E); }
    }
    SEAM(14);
    if (IN(15)) {
        const bf16* Y = (const bf16*)(ws + WS_Y); const float* nf = args.in[I_NFIN]; const int MT15 = __builtin_amdgcn_readfirstlane(tab[0]); const int tail0 = ((MT15 < MAXTILES ? MT15 : MAXTILES) >> 5) << 5;
        for (int m = gw; m < T; m += NGW) {
            const int s0 = tokS[2 * m], s1 = tokS[2 * m + 1]; const float g0 = tokG[2 * m], g1 = tokG[2 * m + 1];
            const v2u* xr = (const v2u*)(H3 + (size_t)m * DM) + lane;
            f32x4 v[8];
#pragma unroll
            for (int j = 0; j < 8; ++j) { const v2u w_ = xr[64 * j]; v[j] = BF4_TO_F4(w_); }
#pragma unroll 1
            for (int k = 0; k < 2; ++k) { const int sk = k ? s1 : s0; const float gk = k ? g1 : g0;
#define Y4(w_) ((f32x4){__uint_as_float((w_).x << 16), __uint_as_float((w_).x & 0xffff0000u), __uint_as_float((w_).y << 16), __uint_as_float((w_).y & 0xffff0000u)})
                if ((sk >> 8) < tail0) { const v2u* y = (const v2u*)(Y + (size_t)sk * DM) + lane;
#pragma unroll
                    for (int j = 0; j < 8; ++j) { const v2u w = y[64 * j]; v[j] += gk * Y4(w); } }
                else { const bf16* YP = (const bf16*)(ws + WS_YP);
#pragma unroll 1
                    for (int kq = 0; kq < 7; ++kq) { const v2u* y = (const v2u*)(YP + ((size_t)(kq * 8 + (sk >> 8) - tail0) * 256 + (sk & 255)) * DM) + lane;
#pragma unroll
                        for (int j = 0; j < 8; ++j) { const v2u w = y[64 * j]; v[j] += gk * Y4(w); } } } }
#undef Y4
            float s = 0.f;
#pragma unroll
            for (int j = 0; j < 8; ++j) s += (v[j].x * v[j].x + v[j].y * v[j].y) + (v[j].z * v[j].z + v[j].w * v[j].w);
            const float rstd = 1.0f / sqrtf(wave_sum(s) * (1.f / DM) + RMS_EPS);
            f32x4* orow = (f32x4*)(args.out + (size_t)m * DM) + lane; const f32x4* nfr = (const f32x4*)nf + lane;
#pragma unroll
            for (int j = 0; j < 8; ++j) orow[64 * j] = v[j] * rstd * nfr[64 * j];
        }
    }
#undef IN
#undef SEAM
}

extern "C" void kernel_launch(void* const* d_in, const int* in_sizes, int n_in, void* d_out, int out_size, void* d_ws, size_t ws_size, hipStream_t stream) {
    static int grid = 0;
    if (grid == 0) {
        if (n_in != 16 || out_size != T * DM || ws_size < WS_END) { fprintf(stderr, "kernel_launch: unexpected shapes (n_in %d out %d ws %zu)\n", n_in, out_size, ws_size); grid = -1; return; }
        int dev = 0, cus = 0, per_cu = 0;
        if (hipGetDevice(&dev) != hipSuccess || hipDeviceGetAttribute(&cus, hipDeviceAttributeMultiprocessorCount, dev) != hipSuccess) { grid = -1; return; }
        if (hipFuncSetAttribute((const void*)yoco_fwd, hipFuncAttributeMaxDynamicSharedMemorySize, LDS_BYTES) != hipSuccess) { fprintf(stderr, "kernel_launch: hipFuncSetAttribute failed\n"); grid = -1; return; }
        if (hipOccupancyMaxActiveBlocksPerMultiprocessor(&per_cu, (const void*)yoco_fwd, NTHR, LDS_BYTES) != hipSuccess || per_cu < 1) fprintf(stderr, "kernel_launch: occupancy query reports %d\n", per_cu);
        (void)hipGetLastError();
        grid = cus;
    }
    if (grid < 0) return;
    (void)hipMemsetAsync((char*)d_ws + WS_CTL, 0, CTL_ZERO_BYTES, stream);
    Args a{};
    for (int i = 0; i < 16; ++i) a.in[i] = (const float*)d_in[i];
    a.out = (float*)d_out; a.ws = (unsigned char*)d_ws;
    if (ONE_LAUNCH) { a.ph_lo = 0; a.ph_hi = NPHASES; hipLaunchKernelGGL(yoco_fwd, dim3(grid), dim3(NTHR), LDS_BYTES, stream, a); }
    else for (int p = 0; p < NPHASES; ++p) { a.ph_lo = p; a.ph_hi = p + 1; hipLaunchKernelGGL(yoco_fwd, dim3(grid), dim3(NTHR), LDS_BYTES, stream, a); }
}
```

```cpp
#include <hip/hip_runtime.h>
#include <cstdio>
#include <cstdint>
#define C_NCV1 64
#define C_X1 0
#define C_HH2 4096
#define C_HH9 8192
namespace pg8 {
#define PG8_LAS __attribute__((address_space(3)))
typedef unsigned short bf16_t;
typedef short bf16x8 __attribute__((ext_vector_type(8)));
typedef float f32x4 __attribute__((ext_vector_type(4)));
typedef float f32x2 __attribute__((ext_vector_type(2)));
typedef unsigned u32x4 __attribute__((ext_vector_type(4)));
typedef short s16x4 __attribute__((ext_vector_type(4)));
typedef unsigned u32x2 __attribute__((ext_vector_type(2)));
constexpr int BM = 256, BK = 64, HALF = 128, HTB = HALF * BK * 2  , STAGE_BYTES = 8 * HTB, NXCD = 8, WGM = 8;

__host__ __device__ __forceinline__ int lds_byte(int r, int c) { const int st = (r >> 4) * 2 + (c >> 5), rr = r & 15, cc = c & 31, ob = rr * 64 + cc * 2; return st * 1024 + (ob ^ (((ob >> 9) & 1) << 5)); }
__host__ __device__ __forceinline__ void stage_rc(int b, int& R, int& C) { const int st = b / 1024, sb = b % 1024, swz = sb ^ (((sb >> 9) & 1) << 5); R = (st >> 1) * 16 + swz / 64; C = (st & 1) * 32 + (swz % 64) / 2; }
__host__ __device__ __forceinline__ int perm32(int rho) { const int n = rho >> 4, i = rho & 15; return 8 * (i >> 2) + 4 * n + (i & 3); }

struct Unit { int pm, pn, crow; size_t bofs, aofs; };
struct Gemm { const bf16_t* A; const bf16_t* Bm; int K, Np, Kloop; };

struct StaticOrder {
    int nM, nN, nwg, G, c;
    __device__ void init(int M, int N, int G_, int c_) { nM = M / BM; nN = N / BM; nwg = nM * nN; G = G_; c = c_; }
    __device__ __forceinline__ bool next(int i, Unit& u) const {
        const long L = (long)i * G + c; if (L >= nwg) return false;
        int wgid = (int)L; { const int q = nwg / NXCD, r = nwg % NXCD, xcd = wgid % NXCD, off = wgid / NXCD; wgid = (xcd < r ? xcd * (q + 1) : r * (q + 1) + (xcd - r) * q) + off; }
        const int nig = WGM * nN, gid = wgid / nig, fm = gid * WGM, gsz = (nM - fm) < WGM ? (nM - fm) : WGM;
        u.pm = fm + ((wgid % nig) % gsz); u.pn = (wgid % nig) / gsz; u.bofs = (size_t)u.pn * 512; u.crow = u.pm; u.aofs = 0; return true;
    }
};
struct MoeOrder {
    int nM, nN, nwg, G, c; const int* tileExp; size_t estride;
    __device__ void init(int nM_, int nN_, int G_, int c_, const int* te, int K_) { nM = nM_; nN = nN_; nwg = nM * nN; G = G_; c = c_; tileExp = te; estride = (size_t)K_ * nN_ * 512; }
    __device__ __forceinline__ bool next(int i, Unit& u) const {
        const long L = (long)i * G + c; if (L >= nwg) return false;
        int wgid = (int)L; { const int q = nwg / NXCD, r = nwg % NXCD, xcd = wgid % NXCD, off = wgid / NXCD; wgid = (xcd < r ? xcd * (q + 1) : r * (q + 1) + (xcd - r) * q) + off; }
        const int nig = WGM * nN, gid = wgid / nig, fm = gid * WGM, gsz = (nM - fm) < WGM ? (nM - fm) : WGM;
        u.pm = fm + ((wgid % nig) % gsz); u.pn = (wgid % nig) / gsz;
        const int e = __builtin_amdgcn_readfirstlane(tileExp[u.pm]); u.bofs = (size_t)e * estride + (size_t)u.pn * 512; u.crow = u.pm; u.aofs = 0; return true;
    }
};

struct MoeTailOrder {
    int tail0, nN, nwg, G, c; const int* tileExp; size_t estride; int Np;
    __device__ void init(int tail0_, int ntail, int nN_, int G_, int c_, const int* te, int K_, int Np_) { tail0 = tail0_; nN = nN_; nwg = ntail * nN_ * 8; G = G_; c = c_; tileExp = te; estride = (size_t)K_ * nN_ * 512; Np = Np_; }
    __device__ __forceinline__ bool next(int i, Unit& u) const {
        const long L = (long)i * G + c; if (L >= nwg) return false;
        const int kq = (int)L & 7, r = (int)L >> 3, pn = r % nN, tl = r / nN;
        u.pm = tail0 + tl; u.pn = pn; u.crow = kq * 8 + tl; u.aofs = (size_t)kq * 896 * 2;
        const int e = __builtin_amdgcn_readfirstlane(tileExp[u.pm]); u.bofs = (size_t)e * estride + (size_t)pn * 512 + (size_t)kq * 896 * Np * 2; return true;
    }
};

__device__ __forceinline__ unsigned cvt_pk_bf16(float lo, float hi) { unsigned r; asm volatile("v_cvt_pk_bf16_f32 %0, %1, %2" : "=v"(r) : "v"(lo), "v"(hi)); return r; }

struct EpiBf16Split {
    static constexpr bool PERM = true, ROWSCALE = true;
    bf16_t* O; int ldc; int split_cols; size_t split_stride; float scale; int scale_t; float gscale;
    const float* ssq; const PG8_LAS float* tab; float* rstd_out;
    __device__ __forceinline__ void operator()(const f32x4 (&acc)[2][2][4][2], const Unit& u, int wr, int wc, int fr, int fq) const {
        const int row0 = u.crow * BM + wr * 64 + fr; int colt = u.pn * BM; bf16_t* base = O;
        float sc = gscale; { const int t = colt / split_cols; base += (size_t)t * split_stride; colt -= t * split_cols; if (t == scale_t) sc *= scale; }
        const int col0 = colt + wc * 32 + 8 * fq;
#pragma unroll
        for (int ai = 0; ai < 2; ++ai)
#pragma unroll
            for (int m = 0; m < 4; ++m) { bf16_t* rowp = base + (size_t)(row0 + ai * HALF + m * 16) * ldc + col0;
#pragma unroll
                for (int bj = 0; bj < 2; ++bj) { const float sr = ssq ? sc * tab[ai * HALF + wr * 64 + m * 16 + fr] : sc; f32x4 v0 = acc[ai][bj][m][0] * sr, v1 = acc[ai][bj][m][1] * sr;
                    u32x4 w; w.x = cvt_pk_bf16(v0[0], v0[1]); w.y = cvt_pk_bf16(v0[2], v0[3]); w.z = cvt_pk_bf16(v1[0], v1[1]); w.w = cvt_pk_bf16(v1[2], v1[3]);
                    *(u32x4*)(rowp + bj * HALF) = w; } }
    }
};
struct EpiResBf16 {
    static constexpr bool PERM = true, ROWSCALE = false;
    bf16_t* O; int ldc; const float* basef; const bf16_t* baseh; float* ssq;
    __device__ __forceinline__ void operator()(const f32x4 (&acc)[2][2][4][2], const Unit& u, int wr, int wc, int fr, int fq) const {
        const int row0 = u.crow * BM + wr * 64 + fr, col0 = u.pn * BM + wc * 32 + 8 * fq;
#pragma unroll
        for (int ai = 0; ai < 2; ++ai)
#pragma unroll
            for (int m = 0; m < 4; ++m) { const size_t off = (size_t)(row0 + ai * HALF + m * 16) * ldc + col0; float sq = 0.f;
#pragma unroll
                for (int bj = 0; bj < 2; ++bj) { f32x4 v0 = acc[ai][bj][m][0], v1 = acc[ai][bj][m][1];
                    if (basef) { v0 += *(const f32x4*)(basef + off + bj * HALF); v1 += *(const f32x4*)(basef + off + bj * HALF + 4); }
                    else { const u32x4 b = *(const u32x4*)(baseh + off + bj * HALF);
                        v0 += (f32x4){__uint_as_float(b.x << 16), __uint_as_float(b.x & 0xffff0000u), __uint_as_float(b.y << 16), __uint_as_float(b.y & 0xffff0000u)};
                        v1 += (f32x4){__uint_as_float(b.z << 16), __uint_as_float(b.z & 0xffff0000u), __uint_as_float(b.w << 16), __uint_as_float(b.w & 0xffff0000u)}; }
                    u32x4 w; w.x = cvt_pk_bf16(v0[0], v0[1]); w.y = cvt_pk_bf16(v0[2], v0[3]); w.z = cvt_pk_bf16(v1[0], v1[1]); w.w = cvt_pk_bf16(v1[2], v1[3]);
                    *(u32x4*)(O + off + bj * HALF) = w;
                    if (ssq) {
                        const f32x4 r0 = {__uint_as_float(w.x << 16), __uint_as_float(w.x & 0xffff0000u), __uint_as_float(w.y << 16), __uint_as_float(w.y & 0xffff0000u)};
                        const f32x4 r1 = {__uint_as_float(w.z << 16), __uint_as_float(w.z & 0xffff0000u), __uint_as_float(w.w << 16), __uint_as_float(w.w & 0xffff0000u)};
                        sq += ((r0[0] * r0[0] + r0[1] * r0[1]) + (r0[2] * r0[2] + r0[3] * r0[3])) + ((r1[0] * r1[0] + r1[1] * r1[1]) + (r1[2] * r1[2] + r1[3] * r1[3])); } }
                if (ssq) { sq += __shfl_xor(sq, 16); sq += __shfl_xor(sq, 32); if (fq == 0) ssq[(size_t)(row0 + ai * HALF + m * 16) * 32 + 4 * u.pn + wc] = sq; } }
    }
};
struct EpiF32 {
    static constexpr bool PERM = false, ROWSCALE = false;
    float* C; int ldc; const float* base;
    __device__ __forceinline__ void operator()(const f32x4 (&acc)[2][2][4][2], const Unit& u, int wr, int wc, int fr, int fq) const {
        const int row0 = u.crow * BM + wr * 64 + fr, col0 = u.pn * BM + wc * 32 + 4 * fq;
#pragma unroll
        for (int ai = 0; ai < 2; ++ai)
#pragma unroll
            for (int m = 0; m < 4; ++m) { const size_t off = (size_t)(row0 + ai * HALF + m * 16) * ldc + col0;
#pragma unroll
                for (int bj = 0; bj < 2; ++bj)
#pragma unroll
                    for (int n = 0; n < 2; ++n) { f32x4 v = acc[ai][bj][m][n]; if (base) v += *(const f32x4*)(base + off + bj * HALF + n * 16); *(f32x4*)(C + off + bj * HALF + n * 16) = v; } }
    }
};
struct EpiSwiGLU {
    static constexpr bool PERM = true, ROWSCALE = true;
    bf16_t* O; int ldc; const float* ssq; const PG8_LAS float* tab; float* rstd_out;
    __device__ __forceinline__ static float act(float g, float u) { return g * __builtin_amdgcn_rcpf(1.0f + __builtin_amdgcn_exp2f(g * -1.4426950408889634f)) * u; }
    __device__ __forceinline__ void operator()(const f32x4 (&acc)[2][2][4][2], const Unit& u, int wr, int wc, int fr, int fq) const {
        const int row0 = u.crow * BM + wr * 64 + fr, col0 = u.pn * HALF + wc * 32 + 8 * fq;
#pragma unroll
        for (int ai = 0; ai < 2; ++ai)
#pragma unroll
            for (int m = 0; m < 4; ++m) { bf16_t* rowp = O + (size_t)(row0 + ai * HALF + m * 16) * ldc + col0;
                const float sr = ssq ? tab[ai * HALF + wr * 64 + m * 16 + fr] : 1.0f;
                const f32x4 g0 = acc[ai][0][m][0] * sr, g1 = acc[ai][0][m][1] * sr, u0 = acc[ai][1][m][0] * sr, u1 = acc[ai][1][m][1] * sr;
                u32x4 w; w.x = cvt_pk_bf16(act(g0[0], u0[0]), act(g0[1], u0[1])); w.y = cvt_pk_bf16(act(g0[2], u0[2]), act(g0[3], u0[3]));
                w.z = cvt_pk_bf16(act(g1[0], u1[0]), act(g1[1], u1[1])); w.w = cvt_pk_bf16(act(g1[2], u1[2]), act(g1[3], u1[3]));
                *(u32x4*)rowp = w; }
    }
};
template <class Epi> __device__ __forceinline__ void rowscale_prepare(const Epi& E, const Unit& u, int tid) {
    if (E.ssq) { const int row = tid >> 1, half = tid & 1; const f32x4* p = (const f32x4*)(E.ssq + ((size_t)u.pm * BM + row) * 32 + 16 * half);
        const f32x4 a = p[0], b = p[1], c = p[2], d = p[3]; float s = ((a[0] + a[1]) + (a[2] + a[3])) + ((b[0] + b[1]) + (b[2] + b[3])) + ((c[0] + c[1]) + (c[2] + c[3])) + ((d[0] + d[1]) + (d[2] + d[3]));
        s += __shfl_xor(s, 1); const float r = 1.0f / sqrtf(s * (1.0f / 2048.0f) + 1e-6f);
        if (half == 0) { ((PG8_LAS float*)E.tab)[row] = r; if (E.rstd_out && u.pn == 0) E.rstd_out[(size_t)u.pm * BM + row] = r; } }
}

struct NoBg { static constexpr bool ON = false; };
template <class Epi, class Sched, class BG = NoBg, bool ALIGN_EPI = true>
__device__ __forceinline__ void gemm_phase(PG8_LAS unsigned char* lds, const Gemm g, const Sched& S, const Epi& E, BG& bg) {
    constexpr bool HB = BG::ON;
    const int tid = threadIdx.x, wid = __builtin_amdgcn_readfirstlane(tid >> 6), lane = tid & 63, wr = wid >> 2, wc = wid & 3, fr = lane & 15, fq = lane >> 4;
    const int K = g.K, nt = g.Kloop / BK;
    unsigned voffA[2], voffB[2];
#pragma unroll
    for (int i = 0; i < 2; ++i) { int R, C; stage_rc(tid * 16 + i * 8192, R, C); voffA[i] = (unsigned)(R * K + C) * 2u;
        const int kk = 4 * wid + 32 * i + (lane >> 4), ch = (lane & 15) ^ (((kk & 3) << 2) | ((kk >> 2) & 3)); voffB[i] = (unsigned)(kk * g.Np + 8 * ch) * 2u; }
    const size_t kstep = (size_t)(BK * 2);
    const size_t hstep = (size_t)HALF * K * 2;
    const size_t tstep = 2 * hstep;
    const size_t kstepB = (size_t)BK * g.Np * 2, hstepB = 256;
    const unsigned ldsw = (unsigned)wid * 1024u;
    const int aoff = lds_byte(wr * 64 + fr, fq * 8);
    int bo[2][2];
    { const int q = fr >> 2, p = fr & 3;
#pragma unroll
      for (int n = 0; n < 2; ++n)
#pragma unroll
        for (int t = 0; t < 2; ++t) bo[n][t] = (int)(unsigned)(size_t)lds + 4 * HTB + 256 * (8 * fq + 4 * t + q) + 16 * (((wc ^ q) << 2) | ((n ^ (fq & 1)) << 1) | ((p >> 1) ^ t)) + 8 * (p & 1); }
#define PG8_SA(b, h) (((b) * 2 + (h)) * HTB)
#define PG8_SB(b, h) ((4 + (b) * 2 + (h)) * HTB)
#define PG8_STAGE(bufoff, gbase, voff) do { _Pragma("unroll") for (int _i = 0; _i < 2; ++_i) \
        __builtin_amdgcn_global_load_lds((const unsigned*)((const char*)(gbase) + (voff)[_i]), (PG8_LAS unsigned*)(lds + (bufoff) + ldsw + _i * 8192), 16, 0, 0); } while (0)
#define PG8_LDA(dst, b, h) do { _Pragma("unroll") for (int m = 0; m < 4; ++m) _Pragma("unroll") for (int k = 0; k < 2; ++k) dst[m][k] = *(const PG8_LAS bf16x8*)(lds + PG8_SA(b, h) + aoff + m * 2048 + k * 1024); } while (0)
#define PG8_TR(dst, addr, off) asm volatile("ds_read_b64_tr_b16 %0, %1 offset:%2" : "=&v"(dst) : "v"(addr), "i"(off) : "memory")
#define PG8_LDB(dst, b, h) do { _Pragma("unroll") for (int n = 0; n < 2; ++n) _Pragma("unroll") for (int k = 0; k < 2; ++k) { s16x4 t0_, t1_; \
        PG8_TR(t0_, bo[n][0], ((b) * 2 + (h)) * HTB + k * 8192); PG8_TR(t1_, bo[n][1], ((b) * 2 + (h)) * HTB + k * 8192); \
        dst[n][k] = (bf16x8){t0_[0], t0_[1], t0_[2], t0_[3], t1_[0], t1_[1], t1_[2], t1_[3]}; } } while (0)
#define PG8_MMA(ai, bj, At, Bt) do { __builtin_amdgcn_s_setprio(1); _Pragma("unroll") for (int m = 0; m < 4; ++m) _Pragma("unroll") for (int n = 0; n < 2; ++n) _Pragma("unroll") for (int k = 0; k < 2; ++k) \
        acc[ai][bj][m][n] = __builtin_amdgcn_mfma_f32_16x16x32_bf16(Bt[n][k], At[m][k], acc[ai][bj][m][n], 0, 0, 0); __builtin_amdgcn_s_setprio(0); } while (0)
#define PG8_WAIT_V(n) asm volatile("s_waitcnt vmcnt(" #n ")" ::: "memory")
#define PG8_WAIT_L(n) asm volatile("s_waitcnt lgkmcnt(" #n ")" ::: "memory")
#define PG8_BAR __builtin_amdgcn_s_barrier()
#define PG8_SCHED __builtin_amdgcn_sched_barrier(0)
    Unit cur, nxt; int ui = 0;
    if (!S.next(0, cur)) return;
    f32x4 acc[2][2][4][2];
#pragma unroll
    for (int a = 0; a < 2; ++a)
#pragma unroll
        for (int b = 0; b < 2; ++b)
#pragma unroll
            for (int m = 0; m < 4; ++m)
#pragma unroll
                for (int n = 0; n < 2; ++n) acc[a][b][m][n] = (f32x4){0.f, 0.f, 0.f, 0.f};
    bf16x8 At[4][2], B0[2][2], B1[2][2];
    const char* cA = (const char*)g.A + (size_t)cur.pm * tstep + cur.aofs; const char* cB = (const char*)g.Bm + cur.bofs;
    PG8_STAGE(PG8_SB(0, 0), cB, voffB); PG8_STAGE(PG8_SB(0, 1), cB + hstepB, voffB); PG8_STAGE(PG8_SA(0, 0), cA, voffA); PG8_STAGE(PG8_SA(0, 1), cA + hstep, voffA);
    if (wr == 1) PG8_BAR;
    PG8_WAIT_V(2); PG8_BAR;
    PG8_STAGE(PG8_SB(1, 0), cB + kstepB, voffB); PG8_STAGE(PG8_SA(1, 0), cA + kstep, voffA); PG8_STAGE(PG8_SB(1, 1), cB + hstepB + kstepB, voffB);
    PG8_WAIT_V(6); PG8_BAR;
    for (;;) {
        const bool has_next = S.next(ui + 1, nxt);
        const char* nA = has_next ? (const char*)g.A + (size_t)nxt.pm * tstep + nxt.aofs : cA; const char* nB = has_next ? (const char*)g.Bm + nxt.bofs : cB;
        for (int t = 0; t < nt; t += 2) {
            const bool last = (t == nt - 2);
            const char* a1 = cA + (size_t)(t + 1) * kstep;
            const char* a2 = last ? nA : cA + (size_t)(t + 2) * kstep; const char* b2 = last ? nB : cB + (size_t)(t + 2) * kstepB;
            const char* a3 = a2 + kstep; const char* b3 = b2 + kstepB;
            PG8_LDB(B0, 0, 0); PG8_LDB(B1, 0, 1); PG8_SCHED; PG8_LDA(At, 0, 0); PG8_STAGE(PG8_SA(1, 1), a1 + hstep, voffA);
            PG8_WAIT_V(8); PG8_WAIT_L(0); PG8_BAR; PG8_MMA(0, 0, At, B0); PG8_MMA(0, 1, At, B1); PG8_BAR; PG8_SCHED;
            PG8_LDA(At, 0, 1); PG8_STAGE(PG8_SB(0, 0), b2, voffB); PG8_STAGE(PG8_SB(0, 1), b2 + hstepB, voffB); PG8_STAGE(PG8_SA(0, 0), a2, voffA);
            PG8_WAIT_V(8); PG8_WAIT_L(0); PG8_BAR; PG8_MMA(1, 0, At, B0); PG8_MMA(1, 1, At, B1); PG8_BAR; PG8_SCHED;
            PG8_LDB(B0, 1, 0); PG8_LDB(B1, 1, 1); PG8_SCHED; PG8_LDA(At, 1, 0); PG8_STAGE(PG8_SA(0, 1), a2 + hstep, voffA);
            PG8_WAIT_V(8); PG8_WAIT_L(0); PG8_BAR; PG8_MMA(0, 0, At, B0); PG8_MMA(0, 1, At, B1); PG8_BAR; PG8_SCHED;
            PG8_LDA(At, 1, 1); PG8_STAGE(PG8_SB(1, 0), b3, voffB); PG8_STAGE(PG8_SB(1, 1), b3 + hstepB, voffB); PG8_STAGE(PG8_SA(1, 0), a3, voffA);
            PG8_WAIT_V(8); PG8_WAIT_L(0); PG8_BAR; PG8_MMA(1, 0, At, B0); PG8_MMA(1, 1, At, B1); PG8_BAR; PG8_SCHED;
        }
        if constexpr (ALIGN_EPI) { if (wr == 0) PG8_BAR; }
        if constexpr (Epi::ROWSCALE) { rowscale_prepare(E, cur, tid); asm volatile("s_waitcnt lgkmcnt(0)" ::: "memory"); PG8_BAR; asm volatile("" ::: "memory"); }
        if constexpr (HB) {
            typename BG::Burst bb; f32x4 xb[16];
            (void)bg.burst_begin(bb);
#pragma unroll
            for (int i = 0; i < 16; ++i) xb[i] = bg.burst_load(bb, i);
            asm volatile("" ::: "memory");
            E(acc, cur, wr, wc, fr, fq);
            asm volatile("" ::: "memory");
            const typename BG::gain16 gg = bg.burst_gains(bb);
#pragma unroll
            for (int i = 0; i < 16; ++i) bg.burst_store(bb, i, xb[i], gg[i]);
        } else
        E(acc, cur, wr, wc, fr, fq);
        if (!has_next) break;
#pragma unroll
        for (int a = 0; a < 2; ++a)
#pragma unroll
            for (int b = 0; b < 2; ++b)
#pragma unroll
                for (int m = 0; m < 4; ++m)
#pragma unroll
                    for (int n = 0; n < 2; ++n) acc[a][b][m][n] = (f32x4){0.f, 0.f, 0.f, 0.f};
        cur = nxt; cA = nA; cB = nB; ++ui;
        if constexpr (ALIGN_EPI) { if (wr == 1) PG8_BAR; }
    }
    PG8_WAIT_V(0);
    if constexpr (!ALIGN_EPI) { if (wr == 0) PG8_BAR; }
    PG8_BAR;
#undef PG8_SA
#undef PG8_SB
#undef PG8_STAGE
#undef PG8_LDA
#undef PG8_LDB
#undef PG8_TR
#undef PG8_MMA
#undef PG8_WAIT_V
#undef PG8_WAIT_L
#undef PG8_BAR
#undef PG8_SCHED
}
typedef int i32x8 __attribute__((ext_vector_type(8)));
struct StaticOrder8 : StaticOrder {
    size_t tstride;
    __device__ void init8(int M, int N, int G_, int c_, int Kbytes) { init(M, N, G_, c_); tstride = (size_t)256 * Kbytes; }
    __device__ __forceinline__ bool next(int i, Unit& u) const { if (!StaticOrder::next(i, u)) return false; u.bofs = (size_t)u.pn * tstride; return true; }
};
struct MoeOrder8 {
    int nM, nN, nwg, G, c; const int* tileExp; size_t estride, tstride;
    __device__ void init(int nM_, int nN_, int G_, int c_, const int* te, int Kbytes) { nM = nM_; nN = nN_; nwg = nM * nN; G = G_; c = c_; tileExp = te; tstride = (size_t)256 * Kbytes; estride = (size_t)nN_ * tstride; }
    __device__ __forceinline__ bool next(int i, Unit& u) const {
        const long L = (long)i * G + c; if (L >= nwg) return false;
        int wgid = (int)L; { const int q = nwg / NXCD, r = nwg % NXCD, xcd = wgid % NXCD, off = wgid / NXCD; wgid = (xcd < r ? xcd * (q + 1) : r * (q + 1) + (xcd - r) * q) + off; }
        const int nig = WGM * nN, gid = wgid / nig, fm = gid * WGM, gsz = (nM - fm) < WGM ? (nM - fm) : WGM;
        u.pm = fm + ((wgid % nig) % gsz); u.pn = (wgid % nig) / gsz; u.crow = u.pm; u.aofs = 0;
        const int e = __builtin_amdgcn_readfirstlane(tileExp[u.pm]); u.bofs = (size_t)e * estride + (size_t)u.pn * tstride; return true;
    }
};
struct MoeTailOrder8 {
    int tail0, nN, nwg, G, c; const int* tileExp; size_t estride, tstride;
    __device__ void init(int tail0_, int ntail, int nN_, int G_, int c_, const int* te, int Kbytes) { tail0 = tail0_; nN = nN_; nwg = ntail * nN_ * 7; G = G_; c = c_; tileExp = te; tstride = (size_t)256 * Kbytes; estride = (size_t)nN_ * tstride; }
    __device__ __forceinline__ bool next(int i, Unit& u) const {
        const long L = (long)i * G + c; if (L >= nwg) return false;
        const int kq = (int)L % 7, r = (int)L / 7, pn = r % nN, tl = r / nN;
        u.pm = tail0 + tl; u.pn = pn; u.crow = kq * 8 + tl; u.aofs = (size_t)kq * 1024;
        const int e = __builtin_amdgcn_readfirstlane(tileExp[u.pm]); u.bofs = (size_t)e * estride + (size_t)pn * tstride + (size_t)kq * 1024; return true;
    }
};
__device__ __forceinline__ unsigned pk4_fp8(float a, float b, float c, float d) {
    a = __builtin_amdgcn_fmed3f(a, -448.f, 448.f); b = __builtin_amdgcn_fmed3f(b, -448.f, 448.f); c = __builtin_amdgcn_fmed3f(c, -448.f, 448.f); d = __builtin_amdgcn_fmed3f(d, -448.f, 448.f);
    int w = __builtin_amdgcn_cvt_pk_fp8_f32(a, b, 0, false); w = __builtin_amdgcn_cvt_pk_fp8_f32(c, d, w, true); return (unsigned)w; }
struct EpiSwiGLU8 {
    static constexpr bool PERM = true;
    unsigned char* O; int ldc; float sin, sout;
    __device__ __forceinline__ float act(float g, float u) const { g *= sin; return g * __builtin_amdgcn_rcpf(1.0f + __builtin_amdgcn_exp2f(g * -1.4426950408889634f)) * (u * (sin * sout)); }
    __device__ __forceinline__ void operator()(const f32x4 (&acc)[2][2][4][2], const Unit& u, int wr, int wc, int fr, int fq) const {
        const int row0 = u.crow * BM + wr * 64 + fr, col0 = u.pn * HALF + wc * 32 + 8 * fq;
#pragma unroll
        for (int ai = 0; ai < 2; ++ai)
#pragma unroll
            for (int m = 0; m < 4; ++m) { unsigned char* rowp = O + (size_t)(row0 + ai * HALF + m * 16) * ldc + col0;
                const f32x4 g0 = acc[ai][0][m][0], g1 = acc[ai][0][m][1], u0 = acc[ai][1][m][0], u1 = acc[ai][1][m][1];
                u32x2 w; w.x = pk4_fp8(act(g0[0], u0[0]), act(g0[1], u0[1]), act(g0[2], u0[2]), act(g0[3], u0[3])); w.y = pk4_fp8(act(g1[0], u1[0]), act(g1[1], u1[1]), act(g1[2], u1[2]), act(g1[3], u1[3]));
                *(u32x2*)rowp = w; }
    }
};
struct EpiF32s {
    static constexpr bool PERM = false;
    float* C; int ldc; float scale;
    __device__ __forceinline__ void operator()(const f32x4 (&acc)[2][2][4][2], const Unit& u, int wr, int wc, int fr, int fq) const {
        const int row0 = u.crow * BM + wr * 64 + fr, col0 = u.pn * BM + wc * 32 + 4 * fq;
#pragma unroll
        for (int ai = 0; ai < 2; ++ai)
#pragma unroll
            for (int m = 0; m < 4; ++m) { const size_t off = (size_t)(row0 + ai * HALF + m * 16) * ldc + col0;
#pragma unroll
                for (int bj = 0; bj < 2; ++bj)
#pragma unroll
                    for (int n = 0; n < 2; ++n) *(f32x4*)(C + off + bj * HALF + n * 16) = acc[ai][bj][m][n] * scale; }
    }
};
template <class Epi, class Sched, bool ALIGN_EPI = true>
__device__ __forceinline__ void gemm_phase_f8(PG8_LAS unsigned char* lds, const Gemm g, const Sched& S, const Epi& E) {
    int tid = threadIdx.x; asm volatile("" : "+v"(tid));
    const int wid = __builtin_amdgcn_readfirstlane(tid >> 6), lane = tid & 63, wr = wid >> 2, wc = wid & 3, fr = lane & 15, fq = lane >> 4;
    const int K = g.K; int nt = g.Kloop / BK; asm volatile("" : "+s"(nt));
    unsigned voffA[2], voffB[2];
#pragma unroll
    for (int i = 0; i < 2; ++i) { int R, C; stage_rc(tid * 16 + i * 8192, R, C); const int Rb = Epi::PERM ? ((R & ~31) + perm32(R & 31)) : R;
        voffA[i] = (unsigned)(R * K + C) * 2u; voffB[i] = (unsigned)(Rb * K + C) * 2u; }
    const size_t kstep = (size_t)(BK * 2);
    const size_t hstep = (size_t)HALF * K * 2;
    const size_t tstep = 2 * hstep;
    const unsigned ldsb = (unsigned)(size_t)lds + (unsigned)wid * 1024u;
    const int aoff = lds_byte(wr * 64 + fr, (fq >> 1) * 32 + (fq & 1) * 16), boff = lds_byte(wc * 32 + fr, (fq >> 1) * 32 + (fq & 1) * 16);
#define PG8_SA(b, h) (((b) * 2 + (h)) * HTB)
#define PG8_SB(b, h) ((4 + (b) * 2 + (h)) * HTB)
#define PG8_GLDS(off32, base64, ldsaddr) do { unsigned keep_; asm volatile("s_mov_b32 %0, m0\n\ts_mov_b32 m0, %3\n\ts_nop 1\n\tglobal_load_lds_dwordx4 %1, %2\n\ts_mov_b32 m0, %0" \
        : "=&s"(keep_) : "v"(off32), "s"(base64), "s"(ldsaddr) : "memory"); } while (0)
#define PG8_STAGE(bufoff, gbase, voff) do { _Pragma("unroll") for (int _i = 0; _i < 2; ++_i) PG8_GLDS((voff)[_i], (const char*)(gbase), ldsb + (unsigned)((bufoff) + _i * 8192)); } while (0)
#define PG8_LDA(dst, b, h) do { _Pragma("unroll") for (int m = 0; m < 4; ++m) { const u32x4 lo_ = *(const PG8_LAS u32x4*)(lds + PG8_SA(b, h) + aoff + m * 2048), hi_ = *(const PG8_LAS u32x4*)(lds + PG8_SA(b, h) + aoff + m * 2048 + 16); \
        dst[m] = (i32x8){(int)lo_[0], (int)lo_[1], (int)lo_[2], (int)lo_[3], (int)hi_[0], (int)hi_[1], (int)hi_[2], (int)hi_[3]}; } } while (0)
#define PG8_LDB(dst, b, h) do { _Pragma("unroll") for (int n = 0; n < 2; ++n) { const u32x4 lo_ = *(const PG8_LAS u32x4*)(lds + PG8_SB(b, h) + boff + n * 2048), hi_ = *(const PG8_LAS u32x4*)(lds + PG8_SB(b, h) + boff + n * 2048 + 16); \
        dst[n] = (i32x8){(int)lo_[0], (int)lo_[1], (int)lo_[2], (int)lo_[3], (int)hi_[0], (int)hi_[1], (int)hi_[2], (int)hi_[3]}; } } while (0)
#define PG8_MMA(ai, bj, At, Bt) do { __builtin_amdgcn_s_setprio(1); _Pragma("unroll") for (int m = 0; m < 4; ++m) _Pragma("unroll") for (int n = 0; n < 2; ++n) \
        asm volatile("v_mfma_f32_16x16x128_f8f6f4 %0, %1, %2, %0" : "+v"(acc[ai][bj][m][n]) : "v"(Bt[n]), "v"(At[m])); __builtin_amdgcn_s_setprio(0); } while (0)
#define PG8_WAIT_V(n) asm volatile("s_waitcnt vmcnt(" #n ")" ::: "memory")
#define PG8_WAIT_L(n) asm volatile("s_waitcnt lgkmcnt(" #n ")" ::: "memory")
#define PG8_BAR __builtin_amdgcn_s_barrier()
#define PG8_SCHED __builtin_amdgcn_sched_barrier(0)
    Unit cur, nxt; int ui = 0;
    if (!S.next(0, cur)) return;
    f32x4 acc[2][2][4][2];
#pragma unroll
    for (int a = 0; a < 2; ++a)
#pragma unroll
        for (int b = 0; b < 2; ++b)
#pragma unroll
            for (int m = 0; m < 4; ++m)
#pragma unroll
                for (int n = 0; n < 2; ++n) acc[a][b][m][n] = (f32x4){0.f, 0.f, 0.f, 0.f};
    i32x8 At[4], B0[2], B1[2];
    const char* cA = (const char*)g.A + (size_t)cur.pm * tstep + cur.aofs; const char* cB = (const char*)g.Bm + cur.bofs;
    PG8_STAGE(PG8_SB(0, 0), cB, voffB); PG8_STAGE(PG8_SB(0, 1), cB + hstep, voffB); PG8_STAGE(PG8_SA(0, 0), cA, voffA); PG8_STAGE(PG8_SA(0, 1), cA + hstep, voffA);
    if (wr == 1) PG8_BAR;
    PG8_WAIT_V(2); PG8_BAR;
    PG8_STAGE(PG8_SB(1, 0), cB + kstep, voffB); PG8_STAGE(PG8_SA(1, 0), cA + kstep, voffA); PG8_STAGE(PG8_SB(1, 1), cB + hstep + kstep, voffB);
    PG8_WAIT_V(6); PG8_BAR;
    for (;;) {
        const bool has_next = S.next(ui + 1, nxt);
        const char* nA = has_next ? (const char*)g.A + (size_t)nxt.pm * tstep + nxt.aofs : cA; const char* nB = has_next ? (const char*)g.Bm + nxt.bofs : cB;
        for (int t = 0; t < nt; t += 2) {
            const bool last = (t == nt - 2);
            const char* a1 = cA + (size_t)(t + 1) * kstep;
            const char* a2 = last ? nA : cA + (size_t)(t + 2) * kstep; const char* b2 = last ? nB : cB + (size_t)(t + 2) * kstep;
            const char* a3 = a2 + kstep; const char* b3 = b2 + kstep;
            PG8_LDB(B0, 0, 0); PG8_LDB(B1, 0, 1); PG8_SCHED; PG8_LDA(At, 0, 0); PG8_STAGE(PG8_SA(1, 1), a1 + hstep, voffA);
            PG8_WAIT_V(8); PG8_WAIT_L(0); PG8_BAR; PG8_MMA(0, 0, At, B0); PG8_MMA(0, 1, At, B1); PG8_BAR; PG8_SCHED;
            PG8_LDA(At, 0, 1); PG8_STAGE(PG8_SB(0, 0), b2, voffB); PG8_STAGE(PG8_SB(0, 1), b2 + hstep, voffB); PG8_STAGE(PG8_SA(0, 0), a2, voffA);
            PG8_WAIT_V(8); PG8_WAIT_L(0); PG8_BAR; PG8_MMA(1, 0, At, B0); PG8_MMA(1, 1, At, B1); PG8_BAR; PG8_SCHED;
            PG8_LDB(B0, 1, 0); PG8_LDB(B1, 1, 1); PG8_SCHED; PG8_LDA(At, 1, 0); PG8_STAGE(PG8_SA(0, 1), a2 + hstep, voffA);
            PG8_WAIT_V(8); PG8_WAIT_L(0); PG8_BAR; PG8_MMA(0, 0, At, B0); PG8_MMA(0, 1, At, B1); PG8_BAR; PG8_SCHED;
            PG8_LDA(At, 1, 1); PG8_STAGE(PG8_SB(1, 0), b3, voffB); PG8_STAGE(PG8_SB(1, 1), b3 + hstep, voffB); PG8_STAGE(PG8_SA(1, 0), a3, voffA);
            PG8_WAIT_V(8); PG8_WAIT_L(0); PG8_BAR; PG8_MMA(1, 0, At, B0); PG8_MMA(1, 1, At, B1); PG8_BAR; PG8_SCHED;
        }
        asm volatile("s_nop 15\n\ts_nop 15" ::: "memory");
        if constexpr (ALIGN_EPI) { if (wr == 0) PG8_BAR; }
        E(acc, cur, wr, wc, fr, fq);
        if (!has_next) break;
#pragma unroll
        for (int a = 0; a < 2; ++a)
#pragma unroll
            for (int b = 0; b < 2; ++b)
#pragma unroll
                for (int m = 0; m < 4; ++m)
#pragma unroll
                    for (int n = 0; n < 2; ++n) acc[a][b][m][n] = (f32x4){0.f, 0.f, 0.f, 0.f};
        cur = nxt; cA = nA; cB = nB; ++ui;
        if constexpr (ALIGN_EPI) { if (wr == 1) PG8_BAR; }
    }
    PG8_WAIT_V(0);
    if constexpr (!ALIGN_EPI) { if (wr == 0) PG8_BAR; }
    PG8_BAR;
#undef PG8_SA
#undef PG8_SB
#undef PG8_STAGE
#undef PG8_GLDS
#undef PG8_LDA
#undef PG8_LDB
#undef PG8_MMA
#undef PG8_WAIT_V
#undef PG8_WAIT_L
#undef PG8_BAR
#undef PG8_SCHED
}
}
namespace att {
#define ATT_LAS __attribute__((address_space(3)))
typedef unsigned short bf16_t;
typedef short bf16x8 __attribute__((ext_vector_type(8)));
typedef short s16x4 __attribute__((ext_vector_type(4)));
typedef float f32x16 __attribute__((ext_vector_type(16)));
typedef float f32x4 __attribute__((ext_vector_type(4)));
typedef unsigned u32x4 __attribute__((ext_vector_type(4)));
constexpr int S = 2048, PITCH = 2048, D = 128, NW = 8, QBLK = 32, KVBLK = 64, QB = NW * QBLK;
constexpr int SHM_V = KVBLK * D * 2, SHM_K = KVBLK * D * 2;
constexpr int NKB = 4;
constexpr int OFF_V = 0, OFF_K = NKB * SHM_V, OFF_WS = NKB * SHM_V + NKB * SHM_K, OFF_BIAS = OFF_WS + NW * 64 * 4, OFF_SCAN = OFF_BIAS + S * 4, LDS_BYTES = OFF_SCAN + 64;
#define KSWZ(row, colB) ((row) * 256 + ((colB) ^ (((row) & 7) << 4)))
#define SBAR() __builtin_amdgcn_sched_barrier(0)
__device__ __forceinline__ int v_st(int k, int c) { const int kk = (k & ~0xC) | ((k & 4) << 1) | ((k & 8) >> 1); return ((kk >> 3) * 4 + (c >> 5)) * 512 + ((kk & 7) * 32 + (c & 31)) * 2; }
__device__ __forceinline__ int v_rd_base(int lane) { return ((lane & 3) << 3) | (((lane >> 2) & 3) << 6) | (((lane >> 4) & 1) << 5) | (((lane >> 5) & 1) << 8); }
constexpr int v_rd_off(int d0, int ks, int half) { return d0 * 512 + ks * 4096 + half * 2048; }
__device__ __forceinline__ int crow(int r, int hi) { return (r & 3) + 8 * (r >> 2) + 4 * hi; }
__device__ __forceinline__ unsigned cvtpk(float lo, float hi) { unsigned r; asm volatile("v_cvt_pk_bf16_f32 %0, %1, %2" : "=v"(r) : "v"(lo), "v"(hi)); return r; }

__device__ __forceinline__ void qkt(f32x16& p0, f32x16& p1, const ATT_LAS char* Kt, int r32, int hi, const bf16x8* qr) {
    p0 = f32x16{}; p1 = f32x16{};
    const ATT_LAS char* kb[4];
#pragma unroll
    for (int dd = 0; dd < 4; ++dd) kb[dd] = Kt + KSWZ(r32, (dd * 16 + hi * 8) * 2);
#pragma unroll
    for (int d0 = 0; d0 < 8; ++d0) { const ATT_LAS char* a = kb[d0 & 3] + (d0 >> 2) * 128;
        bf16x8 b0 = *reinterpret_cast<const ATT_LAS bf16x8*>(a);
        bf16x8 b1 = *reinterpret_cast<const ATT_LAS bf16x8*>(a + 32 * 256);
        p0 = __builtin_amdgcn_mfma_f32_32x32x16_bf16(b0, qr[d0], p0, 0, 0, 0);
        p1 = __builtin_amdgcn_mfma_f32_32x32x16_bf16(b1, qr[d0], p1, 0, 0, 0); }
}
__device__ __forceinline__ void pv_tile(f32x16* o, int vb0, bf16x8 pa0, bf16x8 pa1, bf16x8 pa2, bf16x8 pa3) {
#define TRRD(dst, off) asm volatile("ds_read_b64_tr_b16 %0, %1 offset:%2" : "=&v"(dst) : "v"(vb0), "i"(off) : "memory")
#define PV_D0(d0) do { s16x4 l0, l1, l2, l3, h0, h1, h2, h3; constexpr int b_ = v_rd_off(d0, 0, 0); \
        TRRD(l0, b_); TRRD(h0, b_ + 2048); TRRD(l1, b_ + 4096); TRRD(h1, b_ + 6144); TRRD(l2, b_ + 8192); TRRD(h2, b_ + 10240); TRRD(l3, b_ + 12288); TRRD(h3, b_ + 14336); \
        asm volatile("s_waitcnt lgkmcnt(0)" ::: "memory"); SBAR(); \
        o[d0] = __builtin_amdgcn_mfma_f32_32x32x16_bf16(pa0, (bf16x8){l0[0], l0[1], l0[2], l0[3], h0[0], h0[1], h0[2], h0[3]}, o[d0], 0, 0, 0);   \
        o[d0] = __builtin_amdgcn_mfma_f32_32x32x16_bf16(pa1, (bf16x8){l1[0], l1[1], l1[2], l1[3], h1[0], h1[1], h1[2], h1[3]}, o[d0], 0, 0, 0);   \
        o[d0] = __builtin_amdgcn_mfma_f32_32x32x16_bf16(pa2, (bf16x8){l2[0], l2[1], l2[2], l2[3], h2[0], h2[1], h2[2], h2[3]}, o[d0], 0, 0, 0);   \
        o[d0] = __builtin_amdgcn_mfma_f32_32x32x16_bf16(pa3, (bf16x8){l3[0], l3[1], l3[2], l3[3], h3[0], h3[1], h3[2], h3[3]}, o[d0], 0, 0, 0); } while (0)
    PV_D0(0); PV_D0(1); PV_D0(2); PV_D0(3);
#undef PV_D0
#undef TRRD
}
#define ATT_PK4(P, B_, OUT) do { unsigned a0 = cvtpk(P[B_+0], P[B_+1]), a1 = cvtpk(P[B_+2], P[B_+3]);                          \
        unsigned b0 = cvtpk(P[B_+4], P[B_+5]), b1 = cvtpk(P[B_+6], P[B_+7]);                                             \
        auto r0 = __builtin_amdgcn_permlane32_swap(a0, b0, false, false); auto r1 = __builtin_amdgcn_permlane32_swap(a1, b1, false, false); \
        u32x4 w = {r0[0], r1[0], r0[1], r1[1]}; OUT = *reinterpret_cast<bf16x8*>(&w); } while (0)

constexpr int OFF_STAGE = OFF_SCAN + 64, STAGE_PER_WAVE = 0;
template <bool FOX, class BG, int NH = 1>
__device__ __forceinline__ void attn_block(ATT_LAS char* lds, const bf16_t* Qg, const bf16_t* Kg, const bf16_t* Vg, bf16_t* Og, int b, int h, int qb, BG& bg) {
    int tid = threadIdx.x; asm volatile("" : "+v"(tid));
    const int wid = __builtin_amdgcn_readfirstlane(tid >> 6), lane = tid & 63, r32 = lane & 31, hi = lane >> 5;
    const size_t hb = (size_t)b * S * PITCH + (size_t)h * D;
    const bf16_t* Qp = Qg + hb; const bf16_t* Kp = Kg + hb; const bf16_t* Vp = Vg + hb; bf16_t* Op = Og + hb;
    const int P0 = qb * QB, qlo = P0 + wid * QBLK, NT = 4 * (qb + 1);
    bf16x8 qr[8];
#pragma unroll
    for (int d0 = 0; d0 < 8; ++d0) qr[d0] = *(const bf16x8*)(Qp + (size_t)(qlo + r32) * PITCH + d0 * 16 + hi * 8);
    unsigned koff[2], voff[2];
#pragma unroll
    for (int i = 0; i < 2; ++i) { const int j = 2 * wid + i;
        { const int row = 4 * j + (lane >> 4), c = (lane & 15) ^ (row & 7); koff[i] = (unsigned)(row * PITCH + 8 * c) * 2u; }
        { const int sub = 2 * j + (lane >> 5), kk = 8 * (sub >> 2) + ((lane & 31) >> 2), c = 32 * (sub & 3) + 8 * (lane & 3), k = (kk & ~0xC) | ((kk & 4) << 1) | ((kk & 8) >> 1); voff[i] = (unsigned)(k * PITCH + c) * 2u; } }
    ATT_LAS char* V_lds = lds + OFF_V; ATT_LAS char* K_lds = lds + OFF_K;
    ATT_LAS float* wsf = (ATT_LAS float*)(lds + OFF_WS) + wid * 64; ATT_LAS float* li_l = wsf; ATT_LAS float* al_l = wsf + 32;
    const ATT_LAS float* biasL = (const ATT_LAS float*)(lds + OFF_BIAS);
    const int vbase = (int)(unsigned)(size_t)V_lds + v_rd_base(lane);
    float m_reg = -1e30f, l_reg = 0.f, R2 = 0.f; f32x16 o[4] = {};
    typename BG::Burst bbC, bbP; bg.burst_begin_n(bbC, 0); bbP = bbC; bool isC = false, isP = false; f32x4 hv[4] = {};
    typename BG::Burst bbD; bg.burst_begin_n(bbD, 0); bool isD = false; f32x4 hw[4] = {};
#define TILEJ(t) (FOX ? (t) : (NT - 1 - (t)))
#define LOADT(j, bf) do { const char* kt_ = (const char*)(Kp + (size_t)(j) * KVBLK * PITCH); const char* vt_ = (const char*)(Vp + (size_t)(j) * KVBLK * PITCH); \
        _Pragma("unroll") for (int i_ = 0; i_ < 2; ++i_) { \
            __builtin_amdgcn_global_load_lds((const unsigned*)(kt_ + koff[i_]), (ATT_LAS unsigned*)(K_lds + (bf) * SHM_K + (2 * wid + i_) * 1024), 16, 0, 0); \
            __builtin_amdgcn_global_load_lds((const unsigned*)(vt_ + voff[i_]), (ATT_LAS unsigned*)(V_lds + (bf) * SHM_V + (2 * wid + i_) * 1024), 16, 0, 0); } } while (0)
    static_assert(!BG::ON || BG::REG, "register-staged hosting only");
    bool wdone = false; ATT_LAS int* donef = (ATT_LAS int*)(lds + OFF_SCAN);
    LOADT(TILEJ(0), 0); LOADT(TILEJ(1), 1); asm volatile("s_waitcnt vmcnt(0)" ::: "memory"); __syncthreads();
    for (int t = 0; t < NT; ++t) {
        if ((t & 1) == 0 && t + 2 < NT) { LOADT(TILEJ(t + 2), (t + 2) & 3); LOADT(TILEJ(t + 3), (t + 3) & 3); }
        bbP = bbC; isP = isC; isC = bg.live;
        if (isC) { bg.burst_begin_n(bbC, 4);
            if constexpr (BG::REG) {
#pragma unroll
                for (int i = 0; i < 4; ++i) hv[i] = bg.burst_ld(bbC, i);
                if constexpr (NH == 2) { isD = bg.live; if (isD) { bg.burst_begin_n(bbD, 4);
#pragma unroll
                    for (int i = 0; i < 4; ++i) hw[i] = bg.burst_ld(bbD, i); } }
            } else {
#pragma unroll
            for (int i = 0; i < 4; ++i) bg.burst_dma(bbC, i, (ATT_LAS unsigned char*)(lds + OFF_STAGE + wid * STAGE_PER_WAVE + (t & 1) * 4096 + i * 1024)); } }
        const int bufi = t & 3, kb = TILEJ(t) * KVBLK;
        if (!wdone && kb <= qlo + QBLK - 1) {
            f32x16 p0, p1; bf16x8 pa0, pa1, pa2, pa3;
            qkt(p0, p1, K_lds + bufi * SHM_K, r32, hi, qr);
            const int dq = qlo + r32 - kb - 4 * hi;
            if constexpr (FOX) {
                const ATT_LAS float* bp = biasL + kb + 4 * hi;
#pragma unroll
                for (int i = 0; i < 4; ++i) { const f32x4 b0 = *(const ATT_LAS f32x4*)(bp + 8 * i), b1 = *(const ATT_LAS f32x4*)(bp + 32 + 8 * i);
#pragma unroll
                    for (int j = 0; j < 4; ++j) { p0[4 * i + j] += b0[j]; p1[4 * i + j] += b1[j]; } }
                if (kb + KVBLK - 1 > qlo) {
                    const float NEG = -__builtin_inff();
#pragma unroll
                    for (int r = 0; r < 16; ++r) { const int c = (r & 3) + 8 * (r >> 2); if (c > dq) p0[r] = NEG; if (c + 32 > dq) p1[r] = NEG; }
                }
                float pmax = p0[0];
#pragma unroll
                for (int r = 1; r < 16; ++r) pmax = fmaxf(pmax, p0[r]);
#pragma unroll
                for (int r = 0; r < 16; ++r) pmax = fmaxf(pmax, p1[r]);
                { auto rr = __builtin_amdgcn_permlane32_swap(__float_as_uint(pmax), __float_as_uint(pmax), false, false); pmax = fmaxf(__uint_as_float(rr[0]), __uint_as_float(rr[1])); }
                const float mn = fmaxf(m_reg, pmax), alpha = __builtin_amdgcn_exp2f(m_reg - mn); m_reg = mn;
                float ps = 0.f;
#pragma unroll
                for (int r = 0; r < 16; ++r) { p0[r] = __builtin_amdgcn_exp2f(p0[r] - mn); p1[r] = __builtin_amdgcn_exp2f(p1[r] - mn); ps += p0[r] + p1[r]; }
                { auto rr = __builtin_amdgcn_permlane32_swap(__float_as_uint(ps), __float_as_uint(ps), false, false); ps = __uint_as_float(rr[0]) + __uint_as_float(rr[1]); }
                l_reg = l_reg * alpha + ps;
                if (__any(alpha < 1.f)) { if (hi == 0) al_l[r32] = alpha; asm volatile("s_waitcnt lgkmcnt(0)" ::: "memory");
#pragma unroll
                    for (int r = 0; r < 16; ++r) { const float a = al_l[crow(r, hi)];
#pragma unroll
                        for (int d_ = 0; d_ < 4; ++d_) o[d_][r] *= a; }
                    asm volatile("s_waitcnt lgkmcnt(0)" ::: "memory"); }
            } else {
                const bool MSK = (kb + KVBLK - 1 >= qlo);
                f32x16 l0, l1;
#pragma unroll
                for (int r = 0; r < 16; ++r) {
                    const float y0 = p0[r], y1 = p1[r];
                    float L0 = -(fmaxf(y0, 0.f) + __builtin_amdgcn_logf(1.0f + __builtin_amdgcn_exp2f(-__builtin_fabsf(y0))));
                    float L1 = -(fmaxf(y1, 0.f) + __builtin_amdgcn_logf(1.0f + __builtin_amdgcn_exp2f(-__builtin_fabsf(y1))));
                    if (MSK) { const int c = (r & 3) + 8 * (r >> 2); if (!(c < dq)) L0 = 0.f; if (!(c + 32 < dq)) L1 = 0.f; }
                    l0[r] = L0; l1[r] = L1;
                }
                float T[8], HO[8];
#pragma unroll
                for (int i = 0; i < 8; ++i) { const float g = (i < 4) ? ((l0[4 * i] + l0[4 * i + 1]) + (l0[4 * i + 2] + l0[4 * i + 3])) : ((l1[4 * i - 16] + l1[4 * i - 15]) + (l1[4 * i - 14] + l1[4 * i - 13]));
                    auto rr = __builtin_amdgcn_permlane32_swap(__float_as_uint(g), __float_as_uint(g), false, false);
                    const float glo = __uint_as_float(rr[0]), ghi = __uint_as_float(rr[1]); T[i] = glo + ghi; HO[i] = hi ? 0.f : ghi; }
                float run = R2;
#pragma unroll
                for (int i = 7; i >= 0; --i) {
                    const float off = run + HO[i];
                    if (i < 4) { float s3 = l0[4 * i + 3] + off, s2 = l0[4 * i + 2] + s3, s1 = l0[4 * i + 1] + s2, s0 = l0[4 * i] + s1;
                        p0[4 * i + 3] = __builtin_amdgcn_exp2f(p0[4 * i + 3] + s3); p0[4 * i + 2] = __builtin_amdgcn_exp2f(p0[4 * i + 2] + s2);
                        p0[4 * i + 1] = __builtin_amdgcn_exp2f(p0[4 * i + 1] + s1); p0[4 * i] = __builtin_amdgcn_exp2f(p0[4 * i] + s0); }
                    else { const int q = 4 * i - 16; float s3 = l1[q + 3] + off, s2 = l1[q + 2] + s3, s1 = l1[q + 1] + s2, s0 = l1[q] + s1;
                        p1[q + 3] = __builtin_amdgcn_exp2f(p1[q + 3] + s3); p1[q + 2] = __builtin_amdgcn_exp2f(p1[q + 2] + s2);
                        p1[q + 1] = __builtin_amdgcn_exp2f(p1[q + 1] + s1); p1[q] = __builtin_amdgcn_exp2f(p1[q] + s0); }
                    run += T[i];
                }
                R2 = run; wdone = __all(R2 < -160.0f);
                if (MSK) {
#pragma unroll
                    for (int r = 0; r < 16; ++r) { const int c = (r & 3) + 8 * (r >> 2); if (!(c < dq)) p0[r] = 0.f; if (!(c + 32 < dq)) p1[r] = 0.f; }
                }
            }
            ATT_PK4(p0, 0, pa0); ATT_PK4(p0, 8, pa1); ATT_PK4(p1, 0, pa2); ATT_PK4(p1, 8, pa3);
            pv_tile(o, vbase + bufi * SHM_V, pa0, pa1, pa2, pa3);
        }
        asm volatile("s_waitcnt vmcnt(0)" ::: "memory");
        if constexpr (BG::REG) { if (isC) { bg.burst_finish_regs(bbC, hv, (ATT_LAS unsigned char*)(lds + OFF_STAGE + wid * STAGE_PER_WAVE)); if constexpr (NH == 2) { if (isD) bg.burst_finish_regs(bbD, hw, (ATT_LAS unsigned char*)(lds + OFF_STAGE + wid * STAGE_PER_WAVE + 4096)); isD = false; } } }
        else
        if (t > 0 && isP) { if (isC) asm volatile("s_waitcnt vmcnt(%0)" :: "n"(BG::HOST_VMCNT) : "memory"); else asm volatile("s_waitcnt vmcnt(0)" ::: "memory");
            bg.burst_finish4(bbP, (ATT_LAS unsigned char*)(lds + OFF_STAGE + wid * STAGE_PER_WAVE + ((t - 1) & 1) * 4096)); }
        if (t & 1) { if constexpr (!FOX) { if (lane == 0) donef[((t >> 1) & 1) * NW + wid] = wdone ? 1 : 0; }
            asm volatile("s_waitcnt lgkmcnt(0)" ::: "memory"); __builtin_amdgcn_s_barrier(); asm volatile("" ::: "memory");
            if constexpr (!FOX) { int all = 1;
#pragma unroll
                for (int w = 0; w < NW; ++w) all &= donef[((t >> 1) & 1) * NW + w];
                if (__builtin_amdgcn_readfirstlane(all)) break; } }
    }
    if constexpr (!BG::REG) if (isC) { asm volatile("s_waitcnt vmcnt(0)" ::: "memory"); bg.burst_finish4(bbC, (ATT_LAS unsigned char*)(lds + OFF_STAGE + wid * STAGE_PER_WAVE + ((NT - 1) & 1) * 4096)); }
    if (0) {
    }
    float rli[16];
    if constexpr (FOX) {
        if (hi == 0) li_l[r32] = l_reg; asm volatile("s_waitcnt lgkmcnt(0)" ::: "memory");
#pragma unroll
        for (int r = 0; r < 16; ++r) rli[r] = __builtin_amdgcn_rcpf(li_l[crow(r, hi)]);
        asm volatile("s_waitcnt lgkmcnt(0)" ::: "memory");
    } else {
#pragma unroll
        for (int r = 0; r < 16; ++r) rli[r] = 1.f;
    }
    bf16_t* Ow = Op + (size_t)qlo * PITCH;
#pragma unroll
    for (int r = 0; r < 16; ++r) { const int orow = crow(r, hi);
#pragma unroll
        for (int d0 = 0; d0 < 4; ++d0) { const float v = o[d0][r] * rli[r]; const float vn = __shfl_xor(v, 1);
            if ((r32 & 1) == 0) *(unsigned*)(Ow + (size_t)orow * PITCH + d0 * 32 + r32) = cvtpk(v, vn); } }
#undef TILEJ
#undef LOADT
#undef WRITET
}
}
#ifndef MK_ONE_LAUNCH
#define MK_ONE_LAUNCH 1
#endif
constexpr bool ONE_LAUNCH = (MK_ONE_LAUNCH != 0);
constexpr int NWAVES = 8, NTHR = NWAVES * 64;
constexpr int BATCH = 4, SEQ = 2048, DM = 2048, NH = 16, HD = 128, T = BATCH * SEQ;
constexpr int FF = 5632, NE = 8, FFX = 7168;
constexpr float RMS_EPS = 1e-6f;
constexpr float QSCALE = 0.08838834764831845f * 1.4426950408889634f;
constexpr int MAXTILES = 72;
constexpr int NPHASES = 16;
constexpr size_t MiB = 1u << 20;
constexpr size_t WS_CTL = 0, CTL_ZERO_BYTES = 1 * MiB;
constexpr size_t WS_WQKV = 2 * MiB;
constexpr size_t WS_WOA  = 26 * MiB;
constexpr size_t WS_WGU  = 34 * MiB;
constexpr size_t WS_WDN  = 78 * MiB;
constexpr size_t WS_WKVQ = 100 * MiB;
constexpr size_t WS_WF   = 124 * MiB;
constexpr size_t WS_WOB  = 125 * MiB;
constexpr size_t WS_WGUX = 134 * MiB;
constexpr size_t WS_WDNX = 582 * MiB;
constexpr size_t WS_A    = 806 * MiB;
constexpr size_t WS_Q    = 838 * MiB, WS_K = 870 * MiB, WS_V = 902 * MiB;
constexpr size_t WS_O    = 934 * MiB;
constexpr size_t WS_H1   = 966 * MiB;
constexpr size_t WS_ACT  = 1030 * MiB;
constexpr size_t WS_H2   = 1118 * MiB;
constexpr size_t WS_H3   = 1182 * MiB;
constexpr size_t WS_AS   = 1246 * MiB;
constexpr size_t WS_ACT2 = 1318 * MiB;
constexpr size_t WS_Y    = 1570 * MiB;
constexpr size_t WS_FP   = 1714 * MiB;
constexpr size_t WS_TOK  = 1716 * MiB;
constexpr size_t WS_CNT  = 1717 * MiB;
constexpr size_t WS_TAB  = 1718 * MiB;
constexpr size_t WS_YP   = 1720 * MiB;
constexpr size_t WS_SSQ1 = 1848 * MiB, WS_SSQ2 = 1850 * MiB, WS_RSTD = 1852 * MiB;
constexpr size_t WS_END  = 1854 * MiB;
constexpr int CW_BAR = 4096;
constexpr int RING_OFF = 0, RING_BYTES = 131072;
constexpr int LDS_BYTES = 163840;
constexpr int LDSCTL_OFF = LDS_BYTES - 2048, MISC_OFF = LDSCTL_OFF + 320;

#define GAS __attribute__((address_space(1)))
#define LAS __attribute__((address_space(3)))
typedef unsigned short bf16;
typedef unsigned v4u __attribute__((ext_vector_type(4)));
typedef unsigned v2u __attribute__((ext_vector_type(2)));
typedef float f32x4 __attribute__((ext_vector_type(4)));
typedef short bf16x8 __attribute__((ext_vector_type(8)));
typedef GAS unsigned gu32;
#define RLX_AGENT __ATOMIC_RELAXED, __HIP_MEMORY_SCOPE_AGENT
#define LDS_WAIT() asm volatile("s_waitcnt lgkmcnt(0)" ::: "memory")
#define VM_WAIT() asm volatile("s_waitcnt vmcnt(0)" ::: "memory")
__device__ __forceinline__ unsigned cvtpk2(float lo, float hi) { unsigned r; asm volatile("v_cvt_pk_bf16_f32 %0, %1, %2" : "=v"(r) : "v"(lo), "v"(hi)); return r; }

#define XB_TMO      128
#define XB_XCNT(j)  (256  + 64 * (j))
#define XB_XSUB(j)  (1280 + 64 * (j))
#define XB_XGEN(j)  (2304 + 64 * (j))
#define XB_TOP      3328
#define XB_TOPGEN   3392
#define XCD_BAR_WORDS 3456
#define XB_SPIN_CAP (1u << 18)
__device__ __forceinline__ unsigned xb_ld(unsigned* p)              { return __hip_atomic_load(p, __ATOMIC_RELAXED, __HIP_MEMORY_SCOPE_AGENT); }
__device__ __forceinline__ unsigned xb_add(unsigned* p, unsigned v) { return __hip_atomic_fetch_add(p, v, __ATOMIC_RELAXED, __HIP_MEMORY_SCOPE_AGENT); }
__device__ __forceinline__ unsigned xb_xcc_id() { return (unsigned)__builtin_amdgcn_s_getreg((3 << 11) | 20) & 0xFu; }
#define XB_SPIN(cond, bar) do { unsigned _sp = 0; while (cond) { __builtin_amdgcn_s_sleep(1); \
    if ((++_sp & 255u) == 0u) { if (xb_ld(&(bar)[XB_TMO])) break; if (_sp > XB_SPIN_CAP) { atomicAdd(&(bar)[XB_TMO], 1u); break; } } } } while (0)
struct XcdBarrier { unsigned* bar; unsigned x; volatile LAS unsigned* st; };
__device__ __forceinline__ XcdBarrier xcd_barrier_post(unsigned* bar, volatile LAS unsigned* st) {
    XcdBarrier b; b.bar = bar; b.x = xb_xcc_id(); b.st = st;
    if (threadIdx.x == 0) (void)xb_add(&bar[XB_XCNT(b.x)], 1u);
    return b;
}
__device__ __forceinline__ void xcd_barrier_complete(unsigned* bar, unsigned x, unsigned& nloc, unsigned& nx) {
    const unsigned G = gridDim.x * gridDim.y * gridDim.z;
    unsigned sum, cnt, mine, sp = 0u;
    for (;;) {
        sum = 0u; cnt = 0u; mine = 0u;
#pragma unroll
        for (unsigned j = 0; j < 16; ++j) { const unsigned c = xb_ld(&bar[XB_XCNT(j)]); sum += c; cnt += (c > 0u) ? 1u : 0u; mine = (j == x) ? c : mine; }
        if (sum == G) break;
        __builtin_amdgcn_s_sleep(1);
        if ((++sp & 255u) == 0u) { if (xb_ld(&bar[XB_TMO])) break; if (sp > XB_SPIN_CAP) { atomicAdd(&bar[XB_TMO], 1u); break; } }
    }
    nloc = mine > 0u ? mine : 1u; nx = cnt > 0u ? cnt : 1u;
}
__device__ __forceinline__ void xcd_barrier(const XcdBarrier& b) {
    asm volatile("s_waitcnt vmcnt(0)" ::: "memory");
    __syncthreads();
    if (threadIdx.x == 0) {
        unsigned* bar = b.bar;
        __builtin_amdgcn_s_waitcnt(0);
        unsigned nloc = b.st[0], nx = b.st[1];
        if (nloc == 0u) { xcd_barrier_complete(bar, b.x, nloc, nx); b.st[0] = nloc; b.st[1] = nx; }
        const unsigned old = xb_add(&bar[XB_XSUB(b.x)], 1u);
        const unsigned gen = old / nloc;
        if (old + 1u == (gen + 1u) * nloc) {
            __builtin_amdgcn_fence(__ATOMIC_RELEASE, "agent");
            asm volatile("s_waitcnt vmcnt(0)" ::: "memory");
            const unsigned og = xb_add(&bar[XB_TOP], 1u);
            const unsigned tg = og / nx;
            if (og + 1u == (tg + 1u) * nx) xb_add(&bar[XB_TOPGEN], 1u);
            else XB_SPIN(xb_ld(&bar[XB_TOPGEN]) == tg, bar);
            __builtin_amdgcn_fence(__ATOMIC_ACQUIRE, "agent");
            xb_add(&bar[XB_XGEN(b.x)], 1u);
            asm volatile("s_waitcnt vmcnt(0)" ::: "memory");
        } else {
            XB_SPIN(xb_ld(&bar[XB_XGEN(b.x)]) == gen, bar);
            __builtin_amdgcn_fence(__ATOMIC_ACQUIRE, "agent");
            asm volatile("s_waitcnt vmcnt(0)" ::: "memory");
        }
    }
    __syncthreads();
}

__device__ __forceinline__ float wave_sum(float v) {
#pragma unroll
    for (int o = 1; o < 64; o <<= 1) v += __shfl_xor(v, o);
    return v;
}

constexpr int CT_M0 = 0, CT_M1 = CT_M0 + 64 * 24, CT_M2 = CT_M1 + 64 * 8, CT_M3 = CT_M2 + 64 * 44, CT_M4 = CT_M3 + 176 * 8, CT_M5 = CT_M4 + 64 * 16, CT_M6 = CT_M5 + 64 * 8, CT_M7 = CT_M6 + 64 * 8,
              CT_M8 = CT_M7 + 8 * 64 * 56, CT_END = CT_M8 + 8 * 224 * 8;
static_assert(CT_END == 51328, "task count");
struct CDesc { const float* src; const float* gain; unsigned dst_off; int K, N, nblk, Np, dcol0, mode, F, base, pad; };
static_assert(sizeof(CDesc) == 56 || sizeof(CDesc) == 64, "CDesc");
constexpr int CDESC_OFF = LDSCTL_OFF + 1024;
__device__ __forceinline__ unsigned udiv_small(unsigned a, unsigned b) {
    unsigned q = (unsigned)__builtin_amdgcn_readfirstlane((int)(unsigned)((float)a * __builtin_amdgcn_rcpf((float)b))); if (q * b > a) --q; if ((q + 1) * b <= a) ++q; return q; }
#define CAS __attribute__((address_space(4)))
struct ConvJob { const GAS char* sp; const CAS float* gp; unsigned dp; unsigned sstride, dstride; };
__device__ __forceinline__ unsigned conv_slane(int mode, unsigned foff, int lane) {
    const int l = (mode == 2) ? (lane & 31) : lane;
    const unsigned pf = 32u * (l >> 3) + 4u * (2u * (l & 3) + ((l >> 2) & 1));
    return (mode == 0) ? 16u * lane : (4u * pf + ((mode == 2 && lane >= 32) ? foff : 0u));
}
__device__ __forceinline__ v2u conv_pack(f32x4 v, float g) { v2u o; o.x = cvtpk2(v.x * g, v.y * g); o.y = cvtpk2(v.z * g, v.w * g); return o; }
struct ConvStream {
    static constexpr bool ON = true, REG = false; static constexpr int HOST_VMCNT = 8;
    const LAS CDesc* tabL; unsigned char* ws; ConvJob j; int task, tstep, tend, rows_left; unsigned slane; int lane; bool live;
    __device__ __forceinline__ void decode(int t) {
        const int m = (t >= CT_M1) + (t >= CT_M2) + (t >= CT_M3) + (t >= CT_M4) + (t >= CT_M5) + (t >= CT_M6) + (t >= CT_M7) + (t >= CT_M8);
        const LAS CDesc* d = tabL + m;
#define RFL(x) __builtin_amdgcn_readfirstlane(x)
        const int K = RFL(d->K), N = RFL(d->N), nblk = RFL(d->nblk), Np = RFL(d->Np), mode = RFL(d->mode), F = RFL(d->F), base = RFL(d->base), dcol0 = RFL(d->dcol0); const unsigned dst_off = (unsigned)RFL((int)d->dst_off);
        const LAS unsigned* dw = (const LAS unsigned*)d;
        const GAS float* srcp = (const GAS float*)(((unsigned long long)(unsigned)RFL((int)dw[1]) << 32) | (unsigned)RFL((int)dw[0]));
        const CAS float* gn = (const CAS float*)(((unsigned long long)(unsigned)RFL((int)dw[3]) << 32) | (unsigned)RFL((int)dw[2]));
#undef RFL
        const unsigned r = (unsigned)(t - base), per = (unsigned)((K >> 5) * nblk), e = udiv_small(r, per), r2 = r - e * per, rc = udiv_small(r2, (unsigned)nblk), blk = r2 - rc * nblk;
        const size_t row0 = (size_t)e * K + (size_t)rc * 32; const unsigned sc = (mode == 2) ? blk * 128u : blk * 256u;
        j.sp = (const GAS char*)(srcp + row0 * N + sc); j.dp = dst_off + (unsigned)((row0 * Np + dcol0 + blk * 256u) * 2u);
        j.gp = gn ? gn + rc * 32 : nullptr; j.sstride = (unsigned)N * 4u; j.dstride = (unsigned)Np * 2u;
        slane = conv_slane(mode, (unsigned)F * 4u, lane); rows_left = 32;
    }
    __device__ __forceinline__ void start(const LAS CDesc* tabL_, unsigned char* ws_, int t0, int tstep_, int tend_, int lane_) { tabL = tabL_; ws = ws_; task = t0; tstep = tstep_; tend = tend_; lane = lane_; live = t0 < tend_;
        decode(live ? t0 : tend_ - 1); }
    __device__ __forceinline__ void advance() {
        if (rows_left > 1) { --rows_left; j.sp += j.sstride; j.dp += j.dstride; if (j.gp) ++j.gp; }
        else if (task + tstep < tend) { task += tstep; decode(task); }
        else live = false;
    }
    struct Burst { const GAS char* sp; const CAS float* gp; unsigned dp, sstride, dstride, slane; };
    __device__ __forceinline__ bool burst_begin(Burst& b) {
        b.sp = j.sp; b.gp = j.gp; b.dp = j.dp; b.sstride = j.sstride; b.dstride = j.dstride; b.slane = slane; const bool was = live;
        if (rows_left > 16) { rows_left -= 16; j.sp += 16 * j.sstride; j.dp += 16 * j.dstride; if (j.gp) j.gp += 16; }
        else if (task + tstep < tend) { task += tstep; decode(task); }
        else live = false;
        return was;
    }
    __device__ __forceinline__ bool burst_begin_n(Burst& b, int R) {
        b.sp = j.sp; b.gp = j.gp; b.dp = j.dp; b.sstride = j.sstride; b.dstride = j.dstride; b.slane = slane; const bool was = live;
        if (rows_left > R) { rows_left -= R; j.sp += R * j.sstride; j.dp += R * j.dstride; if (j.gp) j.gp += R; }
        else if (task + tstep < tend) { task += tstep; decode(task); }
        else live = false;
        return was;
    }
    __device__ __forceinline__ void burst_dma(const Burst& b, int i, LAS unsigned char* dst) const {
        __builtin_amdgcn_global_load_lds((const GAS unsigned*)(b.sp + (size_t)i * b.sstride + b.slane), (LAS unsigned*)dst, 16, 0, 0); }
    __device__ __forceinline__ void burst_finish4(const Burst& b, LAS unsigned char* src) const {
        typedef float gain4 __attribute__((ext_vector_type(4)));
        gain4 g = {1.f, 1.f, 1.f, 1.f}; if (b.gp) g = *(const CAS gain4*)b.gp;
#pragma unroll
        for (int i = 0; i < 4; ++i) { const f32x4 v = *(const LAS f32x4*)(src + i * 1024 + 16 * lane); store(b.dp + (unsigned)i * b.dstride, conv_pack(v, g[i])); }
    }
    __device__ __forceinline__ f32x4 burst_load(const Burst& b, int i) const { return __builtin_nontemporal_load((const GAS f32x4*)(b.sp + (size_t)i * b.sstride + b.slane)); }
    typedef float gain16 __attribute__((ext_vector_type(16)));
    __device__ __forceinline__ gain16 burst_gains(const Burst& b) const { gain16 g;
#pragma unroll
        for (int i = 0; i < 16; ++i) g[i] = 1.0f;
        if (b.gp) g = *(const CAS gain16*)b.gp;
        return g; }
    __device__ __forceinline__ void burst_store(const Burst& b, int i, f32x4 v, float g) const { store(b.dp + (unsigned)i * b.dstride, conv_pack(v, g)); }
    __device__ __forceinline__ f32x4 load() const { return __builtin_nontemporal_load((const GAS f32x4*)(j.sp + slane)); }
    __device__ __forceinline__ void load_asm(f32x4& x) const { const unsigned long long p = (unsigned long long)j.sp;
        const unsigned long long ps = ((unsigned long long)(unsigned)__builtin_amdgcn_readfirstlane((int)(unsigned)(p >> 32)) << 32) | (unsigned)__builtin_amdgcn_readfirstlane((int)(unsigned)p);
        asm volatile("s_nop 4\n\tglobal_load_dwordx4 %0, %1, %2 nt" : "=&v"(x) : "v"(slane), "s"(ps) : "memory"); }
    __device__ __forceinline__ float gain() const { return j.gp ? *j.gp : 1.0f; }
    __device__ __forceinline__ void store(unsigned dp, v2u y) const { *(GAS v2u*)((GAS unsigned char*)ws + (dp + 8u * (unsigned)lane)) = y; }
};
template <int NQ = 8> __device__ __forceinline__ void conv_drain(ConvStream& s) {
    while (s.live) {
        f32x4 v[NQ]; unsigned dp[NQ]; float g[NQ]; bool ok[NQ];
#pragma unroll
        for (int i = 0; i < NQ; ++i) { ok[i] = s.live; v[i] = s.load(); dp[i] = s.j.dp; g[i] = s.gain(); s.advance(); }
#pragma unroll
        for (int i = 0; i < NQ; ++i) if (ok[i]) s.store(dp[i], conv_pack(v[i], g[i]));
    }
}
__device__ __forceinline__ unsigned cvt4_fp8(float a, float b, float c, float d) { int w = __builtin_amdgcn_cvt_pk_fp8_f32(a, b, 0, false); w = __builtin_amdgcn_cvt_pk_fp8_f32(c, d, w, true); return (unsigned)w; }
__device__ __forceinline__ void conv8_task(const float* src, int K, int N, unsigned char* dst, const float* gain, int F, float scale, int t, int lane) {
    const int nstrip = N / 32, nkc = K / 512, per = nstrip * nkc;
    const int e = t / per, r = t - e * per, kc = r / nstrip, strip = r - kc * nstrip;
    src += (size_t)e * K * N; dst += (size_t)e * N * K;
    const int n = strip * 32 + 4 * (lane & 7), q = lane >> 3;
    int drow = n; if (F > 0) drow = (n < F) ? ((n >> 7) * 256 + (n & 127)) : (((n - F) >> 7) * 256 + 128 + ((n - F) & 127));
#pragma unroll 1
    for (int step = 0; step < 4; ++step) {
        const int k0 = kc * 512 + step * 128 + 16 * q;
        f32x4 v[16];
#pragma unroll
        for (int i = 0; i < 16; ++i) v[i] = __builtin_nontemporal_load((const f32x4*)(src + (size_t)(k0 + i) * N + n));
        float g[16];
#pragma unroll
        for (int i = 0; i < 4; ++i) { f32x4 gv = {scale, scale, scale, scale}; if (gain) gv = *(const f32x4*)(gain + k0 + 4 * i) * scale; g[4 * i] = gv.x; g[4 * i + 1] = gv.y; g[4 * i + 2] = gv.z; g[4 * i + 3] = gv.w; }
#pragma unroll
        for (int j = 0; j < 4; ++j) { v4u o;
            o.x = cvt4_fp8(v[0][j] * g[0], v[1][j] * g[1], v[2][j] * g[2], v[3][j] * g[3]); o.y = cvt4_fp8(v[4][j] * g[4], v[5][j] * g[5], v[6][j] * g[6], v[7][j] * g[7]);
            o.z = cvt4_fp8(v[8][j] * g[8], v[9][j] * g[9], v[10][j] * g[10], v[11][j] * g[11]); o.w = cvt4_fp8(v[12][j] * g[12], v[13][j] * g[13], v[14][j] * g[14], v[15][j] * g[15]);
            *(v4u*)(dst + (size_t)(drow + j) * K + k0) = o; }
    }
}
template <bool REG_, bool DIRECT_ = false> struct Conv8StreamT {
    static constexpr bool ON = true, REG = REG_; static constexpr int HOST_VMCNT = 4;
    struct Burst { const GAS char* sp; GAS unsigned char* dp; unsigned doff; };
    const float* src; unsigned char* dst; int task, tstep, tend, step; int lane; bool live; float scale;
    const GAS char* sp; GAS unsigned char* dp; unsigned doff;
    static constexpr int K = DM, N = 2 * FFX, F = FFX, NSTRIP = N / 32, PER = NSTRIP * (K / 512);
    __device__ __forceinline__ void decode(int t) {
        const int e = t / PER, r = t - e * PER, kc = r / NSTRIP, strip = r - kc * NSTRIP;
        const int n0 = strip * 32, k0 = kc * 512;
        sp = (const GAS char*)(src + ((size_t)e * K + k0) * N + n0); dp = (GAS unsigned char*)dst + (size_t)e * N * K + k0;
        const int n = DIRECT_ ? n0 + 4 * (lane & 7) : n0 + (lane & 31); const int drow = (n < F) ? ((n >> 7) * 256 + (n & 127)) : (((n - F) >> 7) * 256 + 128 + ((n - F) & 127));
        doff = DIRECT_ ? (unsigned)drow * (unsigned)K + 4u * (unsigned)(lane >> 3) : (unsigned)drow * (unsigned)K + 16u * (unsigned)(lane >> 5); step = 0;
    }
    __device__ __forceinline__ void start(const float* src_, unsigned char* dst_, float scale_, int t0, int tstep_, int tend_, int lane_) { src = src_; dst = dst_; scale = scale_; task = t0; tstep = tstep_; tend = tend_; lane = lane_;
        live = t0 < tend_; decode(live ? t0 : tend_ - 1); }
    __device__ __forceinline__ bool burst_begin_n(Burst& b, int R) {
        b.sp = sp; b.dp = dp; b.doff = doff; const bool was = live; if (R == 0) return was;
        if (step < 15) { ++step; sp += (size_t)32 * N * 4; dp += 32; }
        else if (task + tstep < tend) { task += tstep; decode(task); }
        else live = false;
        return was;
    }
    __device__ __forceinline__ void burst_dma(const Burst& b, int i, LAS unsigned char* dstl) const {
        __builtin_amdgcn_global_load_lds((const GAS unsigned*)(b.sp + ((size_t)((lane >> 3) + 8 * i) * N + 4 * (lane & 7)) * 4), (LAS unsigned*)dstl, 16, 0, 0); }
    __device__ __forceinline__ f32x4 burst_ld(const Burst& b, int i) const {
        const int row = DIRECT_ ? 4 * (lane >> 3) + i : (lane >> 3) + 8 * i;
        return __builtin_nontemporal_load((const GAS f32x4*)(b.sp + ((size_t)row * N + 4 * (lane & 7)) * 4)); }
    __device__ __forceinline__ void burst_finish_regs(const Burst& b, const f32x4 (&hv)[4], LAS unsigned char* stl) const {
        if constexpr (DIRECT_) {
#pragma unroll
            for (int j = 0; j < 4; ++j) *(GAS unsigned*)(b.dp + b.doff + (size_t)j * K) = cvt4_fp8(hv[0][j] * scale, hv[1][j] * scale, hv[2][j] * scale, hv[3][j] * scale);
            return; }
#pragma unroll
        for (int i = 0; i < 4; ++i) *(LAS f32x4*)(stl + i * 1024 + 16 * lane) = hv[i];
        asm volatile("s_waitcnt lgkmcnt(0)" ::: "memory");
        burst_finish4(b, stl);
        asm volatile("s_waitcnt lgkmcnt(0)" ::: "memory");
    }
    __device__ __forceinline__ void burst_finish4(const Burst& b, LAS unsigned char* srcl) const {
        const LAS float* p = (const LAS float*)srcl + 16 * (lane >> 5) * 32 + (lane & 31);
        float v[16];
#pragma unroll
        for (int j = 0; j < 16; ++j) v[j] = p[j * 32] * scale;
        v4u o; o.x = cvt4_fp8(v[0], v[1], v[2], v[3]); o.y = cvt4_fp8(v[4], v[5], v[6], v[7]); o.z = cvt4_fp8(v[8], v[9], v[10], v[11]); o.w = cvt4_fp8(v[12], v[13], v[14], v[15]);
        *(GAS v4u*)(b.dp + b.doff) = o;
    }
};
template <class S8> __device__ __forceinline__ void conv8_drain(S8& s) {
    while (s.live) { conv8_task(s.src, S8::K, S8::N, s.dst, nullptr, S8::F, s.scale, s.task, s.lane);
        if (s.task + s.tstep < s.tend) s.task += s.tstep; else s.live = false; }
}
typedef Conv8StreamT<false> Conv8Stream; typedef Conv8StreamT<true> Conv8StreamR; typedef Conv8StreamT<true, true> Conv8StreamD;
constexpr float SC_WGU = 64.f, SC_ACT = 8.f, SC_WDN = 128.f;
#define BF4_TO_F4(w_) ((f32x4){__uint_as_float((w_).x << 16), __uint_as_float((w_).x & 0xffff0000u), __uint_as_float((w_).y << 16), __uint_as_float((w_).y & 0xffff0000u)})
__device__ __forceinline__ void rms_rowh_to_bf16(const bf16* xrow, bf16* orow, int lane) {
    const v2u* xr = (const v2u*)xrow + lane;
    f32x4 v[8]; float s = 0.f;
#pragma unroll
    for (int j = 0; j < 8; ++j) { const v2u w = xr[64 * j]; v[j] = BF4_TO_F4(w); s += (v[j].x * v[j].x + v[j].y * v[j].y) + (v[j].z * v[j].z + v[j].w * v[j].w); }
    const float rstd = 1.0f / sqrtf(wave_sum(s) * (1.f / DM) + RMS_EPS);
    v2u* o8 = (v2u*)orow + lane;
#pragma unroll
    for (int j = 0; j < 8; ++j) { v2u w; w.x = cvtpk2(v[j].x * rstd, v[j].y * rstd); w.y = cvtpk2(v[j].z * rstd, v[j].w * rstd); o8[64 * j] = w; }
}
__device__ __forceinline__ void rms_row_to_bf16(const float* xrow, bf16* orow, int lane) {
    const f32x4* xr = (const f32x4*)xrow + lane;
    f32x4 v[8]; float s = 0.f;
#pragma unroll
    for (int j = 0; j < 8; ++j) { v[j] = xr[64 * j]; s += (v[j].x * v[j].x + v[j].y * v[j].y) + (v[j].z * v[j].z + v[j].w * v[j].w); }
    const float rstd = 1.0f / sqrtf(wave_sum(s) * (1.f / DM) + RMS_EPS);
    v2u* o8 = (v2u*)orow + lane;
#pragma unroll
    for (int j = 0; j < 8; ++j) { v2u w; w.x = cvtpk2(v[j].x * rstd, v[j].y * rstd); w.y = cvtpk2(v[j].z * rstd, v[j].w * rstd); o8[64 * j] = w; }
}
struct Args { const float* in[16]; float* out; unsigned char* ws; int ph_lo, ph_hi; };
enum { I_X = 0, I_NMIX, I_NFFN, I_WQKVA, I_WOA, I_NKV, I_WKVF, I_BF, I_WQB, I_WOB, I_WGU, I_WDN, I_WR, I_WGUX, I_WDNX, I_NFIN };

__global__ void __launch_bounds__(NTHR, 2) yoco_fwd(Args args) {
    extern __shared__ __attribute__((aligned(16))) unsigned char lds_raw[];
    LAS unsigned char* lds = (LAS unsigned char*)lds_raw;
    volatile LAS unsigned* MISC = (volatile LAS unsigned*)(lds + MISC_OFF);
    const int tid = threadIdx.x, lane = tid & 63, wave = __builtin_amdgcn_readfirstlane(tid >> 6);
    const int G = gridDim.x; const int bx = blockIdx.x; const int vcu = (G % 8 == 0) ? (bx % 8) * (G / 8) + bx / 8 : bx;
    const int gw = vcu * NWAVES + wave, NGW = G * NWAVES;
    unsigned char* ws = args.ws;
    gu32* ctl = (gu32*)(ws + WS_CTL);
    for (int u = tid; u < (LDS_BYTES - LDSCTL_OFF) / 4; u += NTHR) ((LAS unsigned*)(lds + LDSCTL_OFF))[u] = 0u;
    __syncthreads();
    if (tid == 0) {
        const float* nmix = args.in[I_NMIX]; const float* nffn = args.in[I_NFFN]; const float* nkv = args.in[I_NKV]; const float* nul = nullptr;
#define CD_SET(i_, SRC_, GAIN_, DST_, K_, N_, NBLK_, NP_, DCOL0_, MODE_, F_, BASE_) { LAS CDesc* d_ = (LAS CDesc*)(lds + CDESC_OFF) + (i_); d_->src = (SRC_); d_->gain = (GAIN_); d_->dst_off = (unsigned)(DST_); \
            d_->K = (K_); d_->N = (N_); d_->nblk = (NBLK_); d_->Np = (NP_); d_->dcol0 = (DCOL0_); d_->mode = (MODE_); d_->F = (F_); d_->base = (BASE_); d_->pad = 0; }
        CD_SET(0, args.in[I_WQKVA], nmix,        WS_WQKV, 2048, 6144,    24, 6144,    0,    1, 0,   CT_M0)
        CD_SET(1, args.in[I_WOA],   nul,         WS_WOA,  2048, 2048,    8,  2048,    0,    1, 0,   CT_M1)
        CD_SET(2, args.in[I_WGU],   nffn,        WS_WGU,  2048, 2 * FF,  44, 2 * FF,  0,    2, FF,  CT_M2)
        CD_SET(3, args.in[I_WDN],   nul,         WS_WDN,  FF,   2048,    8,  2048,    0,    1, 0,   CT_M3)
        CD_SET(4, args.in[I_WKVF],  nkv,         WS_WKVQ, 2048, 4112,    16, 6144,    2048, 1, 0,   CT_M4)
        CD_SET(5, args.in[I_WQB],   nmix + 2048, WS_WKVQ, 2048, 2048,    8,  6144,    0,    1, 0,   CT_M5)
        CD_SET(6, args.in[I_WOB],   nul,         WS_WOB,  2048, 2048,    8,  2048,    0,    1, 0,   CT_M6)
        CD_SET(7, args.in[I_WGUX],  nffn + 2048, WS_WGUX, 2048, 2 * FFX, 56, 2 * FFX, 0,    2, FFX, CT_M7)
        CD_SET(8, args.in[I_WDNX],  nul,         WS_WDNX, FFX,  2048,    8,  2048,    0,    0, 0,   CT_M8)
#undef CD_SET
    }
    __syncthreads();
    XcdBarrier bar; bar.bar = (unsigned*)(ctl + CW_BAR); bar.x = 0; bar.st = nullptr;
    if (ONE_LAUNCH) bar = xcd_barrier_post((unsigned*)(ctl + CW_BAR), MISC + 8);
    const int lo = args.ph_lo, hi = args.ph_hi;
#define IN(k) (lo <= (k) && (k) < hi)
#define SEAM(k) do { if (IN(k) && IN((k) + 1)) xcd_barrier(bar); } while (0)

    bf16* const wA = (bf16*)(ws + WS_A); bf16* const wQ = (bf16*)(ws + WS_Q); bf16* const wK = (bf16*)(ws + WS_K); bf16* const wV = (bf16*)(ws + WS_V); bf16* const wO = (bf16*)(ws + WS_O);
    bf16* const H1 = (bf16*)(ws + WS_H1); bf16* const H2 = (bf16*)(ws + WS_H2); bf16* const H3 = (bf16*)(ws + WS_H3);
    int* const tokE = (int*)(ws + WS_TOK); float* const tokG = (float*)(ws + WS_TOK + 65536); int* const tokR = (int*)(ws + WS_TOK + 2 * 65536); int* const tokS = (int*)(ws + WS_TOK + 3 * 65536);
    int* const cntG = (int*)(ws + WS_CNT); int* const tab = (int*)(ws + WS_TAB);
    constexpr int CL_P0A_LO = CT_M0, CL_P0A_HI = CT_M1;
    constexpr int CL_P1_LO = CT_M1, CL_P1_HI = CT_M7;
    constexpr int CL_P2_LO = CT_M3, CL_P2_HI = CT_M7;
    constexpr int CL_P9_LO = CT_M7, CL_P9_HI = CT_M7;
    constexpr int CL_P13_LO = CT_M8, CL_P13_HI = CT_END;
    constexpr int NTG = 8 * (2 * FFX / 32) * (DM / 512), NTD = 8 * (DM / 32) * (FFX / 512), NCV = 16, NCV13 = 32, NCV1 = C_NCV1, X1 = C_X1, X5 = 2048, HH2 = C_HH2, HH9 = C_HH9;
    const bool cvsplit = (G >= 128); const int GW = G - NCV, GW13 = G - NCV13; const bool cvb = cvsplit && (bx >= GW), cvb13 = cvsplit && (bx >= GW13); const int GW1 = G - NCV1; const bool cvb1 = cvsplit && (bx >= GW1);
    static_assert(X1 + HH2 + HH9 + X5 == NTG, "gate/up task split");
    const LAS CDesc* tabL = (const LAS CDesc*)(lds + CDESC_OFF);

    if (IN(0)) {
        const float* nmix = args.in[I_NMIX]; const float* nffn = args.in[I_NFFN]; const float* nkv = args.in[I_NKV];
        {   ConvStream cs; cs.start(tabL, ws, CL_P0A_LO + gw, NGW, CL_P0A_HI, lane); conv_drain(cs); }
        {
            const int n0 = cvsplit ? 0 : NTG + NTD;
            for (int t = gw; t < n0; t += NGW) {
                if (t < NTG) conv8_task(args.in[I_WGUX], DM, 2 * FFX, ws + WS_WGUX, nullptr, FFX, SC_WGU, t, lane);
                else conv8_task(args.in[I_WDNX], FFX, DM, ws + WS_WDNX, nullptr, 0, SC_WDN, t - NTG, lane); }
        }
        {
            const float* wkvf = args.in[I_WKVF]; bf16* WF = (bf16*)(ws + WS_WF);
            for (int idx = (vcu * NTHR + tid); idx < 16 * 2048; idx += G * NTHR) { const int k = idx >> 4, j = idx & 15;
                const float v = wkvf[(size_t)k * 4112 + 4096 + j] * nkv[k]; WF[j * 2048 + k] = (bf16)(cvtpk2(v, 0.f) & 0xffffu); }
        }
        for (int m = gw; m < T; m += NGW) rms_row_to_bf16(args.in[I_X] + (size_t)m * DM, wA + (size_t)m * DM, lane);
    }
    SEAM(0);
    if (IN(1)) {
        if (cvb1) {
            const int cw = (bx - GW1) * NWAVES + wave, ncw = NCV1 * NWAVES;
            ConvStream cs; cs.start(tabL, ws, CL_P1_LO + cw, ncw, CL_P1_HI, lane); conv_drain<16>(cs);
            for (int t = cw; t < X1; t += ncw) conv8_task(args.in[I_WGUX], DM, 2 * FFX, ws + WS_WGUX, nullptr, FFX, SC_WGU, t, lane);
        } else if (cvsplit) {
        pg8::Gemm g{wA, (const bf16*)(ws + WS_WQKV), DM, 3 * DM, DM}; pg8::StaticOrder S; S.init(T, 3 * DM, GW1, bx);
        pg8::EpiBf16Split E{wQ, DM, DM, (size_t)(WS_K - WS_Q) / 2, QSCALE, 0, 1.0f, nullptr, nullptr, nullptr};
        pg8::NoBg nobg; pg8::gemm_phase<pg8::EpiBf16Split, pg8::StaticOrder, pg8::NoBg>(lds + RING_OFF, g, S, E, nobg);
        } else {
        pg8::Gemm g{wA, (const bf16*)(ws + WS_WQKV), DM, 3 * DM, DM}; pg8::StaticOrder S; S.init(T, 3 * DM, G, bx);
        pg8::EpiBf16Split E{wQ, DM, DM, (size_t)(WS_K - WS_Q) / 2, QSCALE, 0, 1.0f, nullptr, nullptr, nullptr};
        ConvStream bg; bg.start(tabL, ws, CL_P1_LO + gw, NGW, CL_P1_HI, lane);
        pg8::gemm_phase<pg8::EpiBf16Split, pg8::StaticOrder, ConvStream>(lds + RING_OFF, g, S, E, bg); conv_drain(bg);
        }
    }
    SEAM(1);
    if (IN(2)) {
        Conv8StreamD bgA; { const int lo8 = cvsplit ? X1 : NTG; bgA.start(args.in[I_WGUX], ws + WS_WGUX, SC_WGU, lo8 + gw, NGW, lo8 + (cvsplit ? HH2 : 0), lane); }
        for (int it = vcu; it < 256; it += G) { const int bh = it >> 2, x = it & 3, b = bh >> 4, h = bh & 15;
            for (int pass = 0; pass < 2; ++pass) att::attn_block<false, Conv8StreamD, 2>((LAS char*)lds, wQ, wK, wV, wO, b, h, pass ? x : 7 - x, bgA); }
        conv8_drain(bgA);
    }
    SEAM(2);
    if (IN(3)) {
        pg8::Gemm g{wO, (const bf16*)(ws + WS_WOA), DM, DM, DM}; pg8::StaticOrder S; S.init(T, DM, G, bx);
        pg8::EpiResBf16 E{H1, DM, args.in[I_X], nullptr, (float*)(ws + WS_SSQ1)};
        pg8::NoBg nobg; pg8::gemm_phase<pg8::EpiResBf16, pg8::StaticOrder, pg8::NoBg>(lds + RING_OFF, g, S, E, nobg);
    }
    SEAM(3);
    if (IN(5)) {
        if (cvb) { const float* nffn = args.in[I_NFFN];
            for (int t = NTG - X5 + (bx - GW) * NWAVES + wave; t < NTG; t += NCV * NWAVES) conv8_task(args.in[I_WGUX], DM, 2 * FFX, ws + WS_WGUX, nullptr, FFX, SC_WGU, t, lane);
        } else {
        const int Gw = cvsplit ? GW : G;
        pg8::Gemm g{H1, (const bf16*)(ws + WS_WGU), DM, 2 * FF, DM}; pg8::StaticOrder S; S.init(T, 2 * FF, Gw, bx);
        pg8::EpiSwiGLU E{(bf16*)(ws + WS_ACT), FF, (const float*)(ws + WS_SSQ1), (const LAS float*)(lds + RING_BYTES), nullptr};
        pg8::NoBg nobg; pg8::gemm_phase<pg8::EpiSwiGLU, pg8::StaticOrder, pg8::NoBg>(lds + RING_OFF, g, S, E, nobg);
        }
    }
    SEAM(5);
    if (IN(6)) {
        pg8::Gemm g{(const bf16*)(ws + WS_ACT), (const bf16*)(ws + WS_WDN), FF, DM, FF}; pg8::StaticOrder S; S.init(T, DM, G, bx);
        pg8::EpiResBf16 E{H2, DM, nullptr, H1, (float*)(ws + WS_SSQ2)};
        pg8::NoBg nobg; pg8::gemm_phase<pg8::EpiResBf16, pg8::StaticOrder, pg8::NoBg>(lds + RING_OFF, g, S, E, nobg);
    }
    SEAM(6);
    if (IN(8)) {
        {   const bf16* WF = (const bf16*)(ws + WS_WF); float* FP = (float*)(ws + WS_FP); const int fr = lane & 15, fq = lane >> 4;
            for (int task = gw; task < 2048; task += NGW) { const int rt = task >> 2, kq = task & 3;
                const bf16* Ap = H2 + (size_t)(16 * rt + fr) * DM + 512 * kq + 8 * fq; const bf16* Bp = WF + (size_t)fr * DM + 512 * kq + 8 * fq;
                f32x4 acc = {0.f, 0.f, 0.f, 0.f};
#pragma unroll
                for (int s = 0; s < 16; ++s) { const bf16x8 a = *(const bf16x8*)(Ap + 32 * s), bb = *(const bf16x8*)(Bp + 32 * s); acc = __builtin_amdgcn_mfma_f32_16x16x32_bf16(bb, a, acc, 0, 0, 0); }
                *(f32x4*)(FP + ((size_t)kq * T + 16 * rt + fr) * 16 + 4 * fq) = acc; }
        }
        pg8::Gemm g{H2, (const bf16*)(ws + WS_WKVQ), DM, 3 * DM, DM}; pg8::StaticOrder S; S.init(T, 3 * DM, G, bx);
        pg8::EpiBf16Split E{wQ, DM, DM, (size_t)(WS_K - WS_Q) / 2, QSCALE, 0, 1.0f, (const float*)(ws + WS_SSQ2), (const LAS float*)(lds + RING_BYTES), (float*)(ws + WS_RSTD)};
        pg8::NoBg nobg; pg8::gemm_phase<pg8::EpiBf16Split, pg8::StaticOrder, pg8::NoBg>(lds + RING_OFF, g, S, E, nobg);
    }
    SEAM(8);
    if (IN(9)) {
        Conv8StreamD bgA; { const int lo8 = cvsplit ? NTG - X5 - HH9 : NTG; bgA.start(args.in[I_WGUX], ws + WS_WGUX, SC_WGU, lo8 + gw, NGW, lo8 + (cvsplit ? HH9 : 0), lane); }
        const float* FP = (const float*)(ws + WS_FP); const float* bfp = args.in[I_BF];
        LAS float* biasL = (LAS float*)(lds + att::OFF_BIAS); LAS float* scanL = (LAS float*)(lds + att::OFF_SCAN);
        for (int it = vcu; it < 256; it += G) { const int bh = it >> 2, x = it & 3, b = bh >> 4, h = bh & 15;
            {
                float c[4]; float run = 0.f; const float bfh = bfp[h];
#pragma unroll
                for (int j = 0; j < 4; ++j) { const size_t row = (size_t)b * SEQ + 4 * tid + j; float f = 0.f;
#pragma unroll
                    for (int kq = 0; kq < 4; ++kq) f += FP[((size_t)kq * T + row) * 16 + h];
                    f = bfh + f * ((const float*)(ws + WS_RSTD))[row];
                    const float lf = fminf(f, 0.f) - __logf(1.0f + __expf(-fabsf(f))); run += lf; c[j] = run; }
                float incl = run;
#pragma unroll
                for (int o = 1; o < 64; o <<= 1) { const float n = __shfl_up(incl, o); if (lane >= o) incl += n; }
                if (lane == 63) scanL[wave] = incl;
                __syncthreads();
                float wpre = 0.f;
#pragma unroll
                for (int w = 0; w < 8; ++w) { const float tw = scanL[w]; if (w < wave) wpre += tw; }
                const float base = wpre + (incl - run);
#pragma unroll
                for (int j = 0; j < 4; ++j) biasL[4 * tid + j] = -(base + c[j]) * 1.4426950408889634f;
                __syncthreads();
            }
            for (int pass = 0; pass < 2; ++pass) att::attn_block<true, Conv8StreamD, 2>((LAS char*)lds, wQ, wK, wV, wO, b, h, pass ? x : 7 - x, bgA); }
        conv8_drain(bgA);
    }
    SEAM(9);
    if (IN(10)) {
        pg8::Gemm g{wO, (const bf16*)(ws + WS_WOB), DM, DM, DM}; pg8::StaticOrder S; S.init(T, DM, G, bx);
        pg8::EpiResBf16 E{H3, DM, nullptr, H2, nullptr};
        pg8::NoBg nobg; pg8::gemm_phase<pg8::EpiResBf16, pg8::StaticOrder, pg8::NoBg>(lds + RING_OFF, g, S, E, nobg);
    }
    SEAM(10);
    if (IN(11)) {
        LAS float* wrL = (LAS float*)lds;
        LAS int* eL = (LAS int*)(lds + 65536);
        const float* wr = args.in[I_WR]; const float* gn = args.in[I_NFFN] + 2048;
        for (int idx = tid; idx < 8 * 2048; idx += NTHR) { const int c = idx >> 3, e = idx & 7; wrL[e * 2048 + c] = wr[idx]; }
        __syncthreads();
        for (int g = vcu; g < 256; g += G) {
            for (int i = 0; i < 4; ++i) { const int tl = 4 * wave + i, token = 32 * g + tl;
                const v2u* xr = (const v2u*)(H3 + (size_t)token * DM) + lane;
                f32x4 v[8]; float s = 0.f;
#pragma unroll
                for (int j = 0; j < 8; ++j) { const v2u w_ = xr[64 * j]; v[j] = BF4_TO_F4(w_); s += (v[j].x * v[j].x + v[j].y * v[j].y) + (v[j].z * v[j].z + v[j].w * v[j].w); }
                const float rstd = 1.0f / sqrtf(wave_sum(s) * (1.f / DM) + RMS_EPS);
                unsigned* o4 = (unsigned*)((unsigned char*)wA + (size_t)token * DM) + lane;
#pragma unroll
                for (int j = 0; j < 8; ++j) { v[j] = v[j] * rstd * ((const f32x4*)gn)[lane + 64 * j]; o4[64 * j] = pg8::pk4_fp8(v[j].x, v[j].y, v[j].z, v[j].w); }
                float lg[8];
#pragma unroll
                for (int e = 0; e < 8; ++e) { float a = 0.f;
#pragma unroll
                    for (int j = 0; j < 8; ++j) { const f32x4 w4 = *(const LAS f32x4*)(wrL + e * 2048 + 256 * j + 4 * lane); a += (v[j].x * w4.x + v[j].y * w4.y) + (v[j].z * w4.z + v[j].w * w4.w); }
                    lg[e] = wave_sum(a); }
                int e1 = 0; float v1 = lg[0];
#pragma unroll
                for (int e = 1; e < 8; ++e) if (lg[e] > v1) { v1 = lg[e]; e1 = e; }
                int e2 = -1; float v2 = -__builtin_inff();
#pragma unroll
                for (int e = 0; e < 8; ++e) if (e != e1 && lg[e] > v2) { v2 = lg[e]; e2 = e; }
                const float g1 = 1.0f / (1.0f + __expf(v2 - v1)), g2 = 1.0f - g1;
                if (lane == 0) { eL[2 * tl] = e1; eL[2 * tl + 1] = e2; tokE[2 * token] = e1; tokE[2 * token + 1] = e2; tokG[2 * token] = g1; tokG[2 * token + 1] = g2; }
            }
            __syncthreads();
            if (tid == 0) { int cnt[8];
#pragma unroll
                for (int e = 0; e < 8; ++e) cnt[e] = 0;
                for (int q = 0; q < 64; ++q) { const int e = eL[q]; int r = 0;
#pragma unroll
                    for (int k = 0; k < 8; ++k) if (k == e) { r = cnt[k]; cnt[k] = r + 1; }
                    tokR[64 * g + q] = r; }
#pragma unroll
                for (int e = 0; e < 8; ++e) cntG[8 * g + e] = cnt[e]; }
            __syncthreads();
        }
    }
    SEAM(11);
    if (IN(12)) {
        LAS int* totL = (LAS int*)lds; LAS int* befL = totL + 8; LAS int* segL = totL + 16;
        for (int g = vcu; g < 256; g += G) {
            {   const int e = wave; int tot = 0, bef = 0;
#pragma unroll
                for (int i = 0; i < 4; ++i) { const int bb = lane + 64 * i; const int c = cntG[8 * bb + e]; tot += c; bef += (bb < g) ? c : 0; }
#pragma unroll
                for (int o = 1; o < 64; o <<= 1) { tot += __shfl_xor(tot, o); bef += __shfl_xor(bef, o); }
                if (lane == 0) { totL[e] = tot; befL[e] = bef; } }
            __syncthreads();
            if (tid == 0) { int acc = 0;
                for (int e = 0; e < 8; ++e) { segL[e] = acc * 256; acc += (totL[e] + 255) >> 8; }
                if (g == 0) { tab[0] = acc; int pm = 0; for (int e = 0; e < 8; ++e) { const int n = (totL[e] + 255) >> 8; for (int q = 0; q < n; ++q) tab[64 + pm++] = e; } } }
            __syncthreads();
            for (int i = 0; i < 4; ++i) { const int token = 32 * g + 4 * wave + i;
                const v4u* src = (const v4u*)((const unsigned char*)wA + (size_t)token * DM) + lane; v4u r4[2];
#pragma unroll
                for (int j = 0; j < 2; ++j) r4[j] = src[64 * j];
#pragma unroll
                for (int k = 0; k < 2; ++k) { const int e = tokE[2 * token + k], r = tokR[2 * token + k]; const int slot = segL[e] + befL[e] + r;
                    v4u* dst = (v4u*)(ws + WS_AS + (size_t)slot * DM) + lane;
#pragma unroll
                    for (int j = 0; j < 2; ++j) dst[64 * j] = r4[j];
                    if (lane == 0) tokS[2 * token + k] = slot; } }
            __syncthreads();
        }
    }
    SEAM(12);
    if (IN(13)) {
        if (cvb13) {
            for (int t = (bx - GW13) * NWAVES + wave; t < NTD; t += NCV13 * NWAVES) conv8_task(args.in[I_WDNX], FFX, DM, ws + WS_WDNX, nullptr, 0, SC_WDN, t, lane);
        } else {
        const int Gw = cvsplit ? GW13 : G;
        const int MT = __builtin_amdgcn_readfirstlane(tab[0]);
        pg8::Gemm g{(const bf16*)(ws + WS_AS), (const bf16*)(ws + WS_WGUX), DM / 2, 0, DM / 2}; pg8::MoeOrder8 S; S.init(MT < MAXTILES ? MT : MAXTILES, 2 * FFX / 256, Gw, bx, tab + 64, DM);
        pg8::EpiSwiGLU8 E{ws + WS_ACT2, FFX, 1.0f / SC_WGU, SC_ACT};
        pg8::gemm_phase_f8<pg8::EpiSwiGLU8, pg8::MoeOrder8>(lds + RING_OFF, g, S, E);
        }
    }
    SEAM(13);
    if (IN(14)) {
        const int MT0 = __builtin_amdgcn_readfirstlane(tab[0]); const int MT = MT0 < MAXTILES ? MT0 : MAXTILES; const int tail0 = (MT >> 5) << 5;
        {   pg8::Gemm g{(const bf16*)(ws + WS_ACT2), (const bf16*)(ws + WS_WDNX), FFX / 2, 0, FFX / 2}; pg8::MoeOrder8 S; S.init(tail0, DM / 256, G, bx, tab + 64, FFX);
            pg8::EpiBf16Split E{(bf16*)(ws + WS_Y), DM, 1 << 30, 0, 1.0f, -1, 1.0f / (SC_ACT * SC_WDN), nullptr, nullptr, nullptr};
            pg8::gemm_phase_f8<pg8::EpiBf16Split, pg8::MoeOrder8>(lds + RING_OFF, g, S, E); }
        if (MT > tail0) {
            pg8::Gemm g{(const bf16*)(ws + WS_ACT2), (const bf16*)(ws + WS_WDNX), FFX / 2, 0, 512}; pg8::MoeTailOrder8 S; S.init(tail0, MT - tail0, DM / 256, G, bx, tab + 64, FFX);
            pg8::EpiBf16Split E{(bf16*)(ws + WS_YP), DM, 1 << 30, 0, 1.0f, -1, 1.0f / (SC_ACT * SC_WDN), nullptr, nullptr, nullptr};
            pg8::gemm_phase_f8<pg8::EpiBf16Split, pg8::MoeTailOrder8>(lds + RING_OFF, g, S, E); }
    }
    SEAM(14);
    if (IN(15)) {
        const bf16* Y = (const bf16*)(ws + WS_Y); const float* nf = args.in[I_NFIN]; const int MT15 = __builtin_amdgcn_readfirstlane(tab[0]); const int tail0 = ((MT15 < MAXTILES ? MT15 : MAXTILES) >> 5) << 5;
        for (int m = gw; m < T; m += NGW) {
            const int s0 = tokS[2 * m], s1 = tokS[2 * m + 1]; const float g0 = tokG[2 * m], g1 = tokG[2 * m + 1];
            const v2u* xr = (const v2u*)(H3 + (size_t)m * DM) + lane;
            f32x4 v[8];
#pragma unroll
            for (int j = 0; j < 8; ++j) { const v2u w_ = xr[64 * j]; v[j] = BF4_TO_F4(w_); }
#pragma unroll 1
            for (int k = 0; k < 2; ++k) { const int sk = k ? s1 : s0; const float gk = k ? g1 : g0;
#define Y4(w_) ((f32x4){__uint_as_float((w_).x << 16), __uint_as_float((w_).x & 0xffff0000u), __uint_as_float((w_).y << 16), __uint_as_float((w_).y & 0xffff0000u)})
                if ((sk >> 8) < tail0) { const v2u* y = (const v2u*)(Y + (size_t)sk * DM) + lane;
#pragma unroll
                    for (int j = 0; j < 8; ++j) { const v2u w = y[64 * j]; v[j] += gk * Y4(w); } }
                else { const bf16* YP = (const bf16*)(ws + WS_YP);
#pragma unroll 1
                    for (int kq = 0; kq < 7; ++kq) { const v2u* y = (const v2u*)(YP + ((size_t)(kq * 8 + (sk >> 8) - tail0) * 256 + (sk & 255)) * DM) + lane;
#pragma unroll
                        for (int j = 0; j < 8; ++j) { const v2u w = y[64 * j]; v[j] += gk * Y4(w); } } } }
#undef Y4
            float s = 0.f;
#pragma unroll
            for (int j = 0; j < 8; ++j) s += (v[j].x * v[j].x + v[j].y * v[j].y) + (v[j].z * v[j].z + v[j].w * v[j].w);
            const float rstd = 1.0f / sqrtf(wave_sum(s) * (1.f / DM) + RMS_EPS);
            f32x4* orow = (f32x4*)(args.out + (size_t)m * DM) + lane; const f32x4* nfr = (const f32x4*)nf + lane;
#pragma unroll
            for (int j = 0; j < 8; ++j) orow[64 * j] = v[j] * rstd * nfr[64 * j];
        }
    }
#undef IN
#undef SEAM
}

extern "C" void kernel_launch(void* const* d_in, const int* in_sizes, int n_in, void* d_out, int out_size, void* d_ws, size_t ws_size, hipStream_t stream) {
    static int grid = 0;
    if (grid == 0) {
        if (n_in != 16 || out_size != T * DM || ws_size < WS_END) { fprintf(stderr, "kernel_launch: unexpected shapes (n_in %d out %d ws %zu)\n", n_in, out_size, ws_size); grid = -1; return; }
        int dev = 0, cus = 0, per_cu = 0;
        if (hipGetDevice(&dev) != hipSuccess || hipDeviceGetAttribute(&cus, hipDeviceAttributeMultiprocessorCount, dev) != hipSuccess) { grid = -1; return; }
        if (hipFuncSetAttribute((const void*)yoco_fwd, hipFuncAttributeMaxDynamicSharedMemorySize, LDS_BYTES) != hipSuccess) { fprintf(stderr, "kernel_launch: hipFuncSetAttribute failed\n"); grid = -1; return; }
        if (hipOccupancyMaxActiveBlocksPerMultiprocessor(&per_cu, (const void*)yoco_fwd, NTHR, LDS_BYTES) != hipSuccess || per_cu < 1) fprintf(stderr, "kernel_launch: occupancy query reports %d\n", per_cu);
        (void)hipGetLastError();
        grid = cus;
    }
    if (grid < 0) return;
    (void)hipMemsetAsync((char*)d_ws + WS_CTL, 0, CTL_ZERO_BYTES, stream);
    Args a{};
    for (int i = 0; i < 16; ++i) a.in[i] = (const float*)d_in[i];
    a.out = (float*)d_out; a.ws = (unsigned char*)d_ws;
    if (ONE_LAUNCH) { a.ph_lo = 0; a.ph_hi = NPHASES; hipLaunchKernelGGL(yoco_fwd, dim3(grid), dim3(NTHR), LDS_BYTES, stream, a); }
    else for (int p = 0; p < NPHASES; ++p) { a.ph_lo = p; a.ph_hi = p + 1; hipLaunchKernelGGL(yoco_fwd, dim3(grid), dim3(NTHR), LDS_BYTES, stream, a); }
}
```
